# Optimizing an MI355X kernel written in HIP

```python
import math
import jax
import jax.numpy as jnp
from jax import lax
import numpy as np

D_MODEL = 1024
BATCH = 4
SEQ = 4096
DEPTH = 4

CTX_LEN = 256
GRID_W = 64
ATTN_WIDTH = D_MODEL // 2
SSM_WIDTH = D_MODEL - ATTN_WIDTH
HEAD_DIM = 64
N_HEADS = ATTN_WIDTH // HEAD_DIM
N_KV_HEADS = 2
GQA_GROUP = N_HEADS // N_KV_HEADS
KV_WIDTH = N_KV_HEADS * HEAD_DIM
IN_COLS = ATTN_WIDTH + 2 * KV_WIDTH + SSM_WIDTH
SSM_P = 16
SSM_G = SSM_WIDTH // SSM_P
SSM_N = 64
DT_MIN = 0.001
DT_MAX = 0.1
D_FF = 2816
CONV_W = 3
Q_BLOCK = 128
ROPE_THETA = 10000.0
NORM_EPS = 1e-6

kernel_name = 'hybrid_gqa_s5_convffn_prefix_trunk'


def _rms_norm(x, g):
    xf = x.astype(jnp.float32)
    y = xf * lax.rsqrt(jnp.mean(xf * xf, axis=-1, keepdims=True) + NORM_EPS)
    return y.astype(x.dtype) * g


def _modulate(h, shift, scale):
    return h * (1 + scale) + shift


def _heads(t, n):
    return t.reshape(t.shape[:-1] + (n, HEAD_DIM))


def _axial_rope_tables(n_tokens):
    rows = n_tokens // GRID_W
    r, col = jnp.meshgrid(jnp.arange(rows), jnp.arange(GRID_W), indexing='ij')
    pos = jnp.stack([r.reshape(-1), col.reshape(-1)], axis=-1).astype(jnp.float32)
    n_freq = HEAD_DIM // 4
    freqs = ROPE_THETA ** (-jnp.arange(n_freq, dtype=jnp.float32) / n_freq)
    ang = pos[:, :, None] * freqs
    return jnp.cos(ang), jnp.sin(ang)


def _apply_rope(t, cos, sin):
    b, s, h, _ = t.shape
    tr = t.reshape(b, s, h, 2, 2, HEAD_DIM // 4)
    t1, t2 = tr[..., 0, :], tr[..., 1, :]
    cs = cos[None, :, None].astype(t.dtype)
    sn = sin[None, :, None].astype(t.dtype)
    out = jnp.stack([t1 * cs - t2 * sn, t2 * cs + t1 * sn], axis=-2)
    return out.reshape(t.shape)


def _softmax_attend(q, k, v):
    s = jnp.einsum('bqkgd,bskd->bkgqs', q, k).astype(jnp.float32) * (HEAD_DIM ** -0.5)
    p = jax.nn.softmax(s, axis=-1).astype(v.dtype)
    return jnp.einsum('bkgqs,bskd->bqkgd', p, v)


def _latent_attention(q, k_lat, v_lat, k_ctx, v_ctx):
    b, s, _, _ = q.shape
    k_all = jnp.concatenate([k_ctx, k_lat], axis=1)
    v_all = jnp.concatenate([v_ctx, v_lat], axis=1)
    n_blk = s // Q_BLOCK
    qb = q.reshape(b, n_blk, Q_BLOCK, N_KV_HEADS, GQA_GROUP, HEAD_DIM).transpose(1, 0, 2, 3, 4, 5)
    o = lax.map(lambda qblk: _softmax_attend(qblk, k_all, v_all), qb)
    return o.transpose(1, 0, 2, 3, 4, 5).reshape(b, s, ATTN_WIDTH)


def _context_attention(q, k, v):
    b, n, _, _ = q.shape
    o = _softmax_attend(q.reshape(b, n, N_KV_HEADS, GQA_GROUP, HEAD_DIM), k, v)
    return o.reshape(b, n, ATTN_WIDTH)


def _zoh(lam_re, lam_im, log_step, b_re, b_im):
    dt = jnp.exp(log_step.astype(jnp.float32))[:, None]
    lr = lam_re.astype(jnp.float32)
    li = lam_im.astype(jnp.float32)
    mag = jnp.exp(lr * dt)
    a_re = mag * jnp.cos(li * dt)
    a_im = mag * jnp.sin(li * dt)
    den = lr * lr + li * li
    f_re = ((a_re - 1) * lr + a_im * li) / den
    f_im = (a_im * lr - (a_re - 1) * li) / den
    br = b_re.astype(jnp.float32)
    bi = b_im.astype(jnp.float32)
    bb_re = f_re[..., None] * br - f_im[..., None] * bi
    bb_im = f_re[..., None] * bi + f_im[..., None] * br
    return a_re, a_im, bb_re, bb_im


def _complex_affine_combine(e1, e2):
    a1r, a1i, b1r, b1i = e1
    a2r, a2i, b2r, b2i = e2
    return (a2r * a1r - a2i * a1i, a2r * a1i + a2i * a1r,
            a2r * b1r - a2i * b1i + b2r, a2r * b1i + a2i * b1r + b2i)


def _ssm_states(u, a_re, a_im, bb_re, bb_im, h0, reverse):
    bu_re = jnp.einsum('blgp,gnp->lbgn', u, bb_re)
    bu_im = jnp.einsum('blgp,gnp->lbgn', u, bb_im)
    if h0 is not None:
        h0_re, h0_im = h0
        first = -1 if reverse else 0
        bu_re = bu_re.at[first].add(a_re * h0_re - a_im * h0_im)
        bu_im = bu_im.at[first].add(a_re * h0_im + a_im * h0_re)
    n = u.shape[1]
    ar = jnp.broadcast_to(a_re, (n, 1) + a_re.shape)
    ai = jnp.broadcast_to(a_im, (n, 1) + a_im.shape)
    _, _, h_re, h_im = lax.associative_scan(_complex_affine_combine, (ar, ai, bu_re, bu_im),
                                            reverse=reverse, axis=0)
    return h_re, h_im


def _ssm_readout(h_re, h_im, c_re, c_im):
    return (jnp.einsum('lbgn,gpn->blgp', h_re, c_re.astype(jnp.float32))
            - jnp.einsum('lbgn,gpn->blgp', h_im, c_im.astype(jnp.float32)))


def _ssm_glu(y, w_glu, b_glu):
    z = jax.nn.gelu(y)
    return z * jax.nn.sigmoid(z @ w_glu + b_glu)


def _s5_mixer(u_lat, u_ctx, p, need_ctx_out):
    b, s, _ = u_lat.shape
    n_c = u_ctx.shape[1]
    ul = u_lat.astype(jnp.float32).reshape(b, s, SSM_G, SSM_P)
    uc = u_ctx.astype(jnp.float32).reshape(b, n_c, SSM_G, SSM_P)
    d = p['ssm_d'].astype(jnp.float32)
    y_lat = d * ul
    y_ctx = d * uc if need_ctx_out else None
    for direction, reverse in ((0, False), (1, True)):
        a_re, a_im, bb_re, bb_im = _zoh(p['ssm_lambda_re'][direction], p['ssm_lambda_im'][direction],
                                        p['ssm_log_step'][direction], p['ssm_b_re'][direction],
                                        p['ssm_b_im'][direction])
        hc_re, hc_im = _ssm_states(uc, a_re, a_im, bb_re, bb_im, None, reverse)
        last = 0 if reverse else -1
        hl_re, hl_im = _ssm_states(ul, a_re, a_im, bb_re, bb_im, (hc_re[last], hc_im[last]), reverse)
        y_lat = y_lat + _ssm_readout(hl_re, hl_im, p['ssm_c_re'][direction], p['ssm_c_im'][direction])
        if need_ctx_out:
            y_ctx = y_ctx + _ssm_readout(hc_re, hc_im, p['ssm_c_re'][direction], p['ssm_c_im'][direction])
    out_lat = _ssm_glu(y_lat.reshape(b, s, SSM_WIDTH).astype(u_lat.dtype), p['w_glu'], p['b_glu'])
    out_ctx = None
    if need_ctx_out:
        out_ctx = _ssm_glu(y_ctx.reshape(b, n_c, SSM_WIDTH).astype(u_ctx.dtype), p['w_glu'], p['b_glu'])
    return out_lat, out_ctx


def _split_in(proj):
    o1 = ATTN_WIDTH
    o2 = o1 + KV_WIDTH
    o3 = o2 + KV_WIDTH
    return proj[..., :o1], proj[..., o1:o2], proj[..., o2:o3], proj[..., o3:]


def _merge_groups(attn, ssm, out_norm_g, w_out):
    a = _rms_norm(attn, out_norm_g[:ATTN_WIDTH])
    s = _rms_norm(ssm, out_norm_g[ATTN_WIDTH:])
    return jnp.concatenate([a, s], axis=-1) @ w_out


def _conv_ffn(h, w_up, conv_w, conv_b, w_down):
    ag = h @ w_up
    pad = jnp.pad(ag, ((0, 0), (1, 1), (0, 0)))
    ag = pad[:, :-2] * conv_w[0] + pad[:, 1:-1] * conv_w[1] + pad[:, 2:] * conv_w[2] + conv_b
    a, g = jnp.split(ag, 2, axis=-1)
    return (jax.nn.silu(g) * a) @ w_down


def _layer(x, ctx, c, c_ctx, cos, sin, p, need_ctx_out):
    mod_lat = (jax.nn.silu(c) @ p['w_ada'] + p['b_ada'])[:, None, :]
    mod_ctx = jax.nn.silu(c_ctx) @ p['w_ada'] + p['b_ada']
    sh1, sc1, g1, sh2, sc2, g2 = jnp.split(mod_lat, 6, axis=-1)
    csh1, csc1, cg1, csh2, csc2, cg2 = jnp.split(mod_ctx, 6, axis=-1)

    h_lat = _modulate(_rms_norm(x, p['norm1_g']), sh1, sc1)
    h_ctx = _modulate(_rms_norm(ctx, p['norm1_g']), csh1, csc1)
    q_l, k_l, v_l, u_l = _split_in(h_lat @ p['w_in'])
    q_c, k_c, v_c, u_c = _split_in(h_ctx @ p['w_in'])

    q_l = _apply_rope(_rms_norm(_heads(q_l, N_HEADS), p['q_norm_g']), cos, sin)
    k_l = _apply_rope(_rms_norm(_heads(k_l, N_KV_HEADS), p['k_norm_g']), cos, sin)
    v_l = _heads(v_l, N_KV_HEADS)
    k_c = _rms_norm(_heads(k_c, N_KV_HEADS), p['k_norm_g'])
    v_c = _heads(v_c, N_KV_HEADS)

    attn_lat = _latent_attention(q_l, k_l, v_l, k_c, v_c)
    ssm_lat, ssm_ctx = _s5_mixer(u_l, u_c, p, need_ctx_out)

    x = x + g1 * _merge_groups(attn_lat, ssm_lat, p['out_norm_g'], p['w_out'])
    h2 = _modulate(_rms_norm(x, p['norm2_g']), sh2, sc2)
    x = x + g2 * _conv_ffn(h2, p['w_up'], p['conv_w'], p['conv_b'], p['w_down'])

    if need_ctx_out:
        q_c = _rms_norm(_heads(q_c, N_HEADS), p['q_norm_g'])
        attn_ctx = _context_attention(q_c, k_c, v_c)
        ctx = ctx + cg1 * _merge_groups(attn_ctx, ssm_ctx, p['out_norm_g'], p['w_out'])
        hc2 = _modulate(_rms_norm(ctx, p['norm2_g']), csh2, csc2)
        ctx = ctx + cg2 * _conv_ffn(hc2, p['w_up'], p['conv_w'], p['conv_b'], p['w_down'])
    return x, ctx


def setup_inputs(seed: int = 0) -> dict:
    key = jax.random.key(seed)
    ks = jax.random.split(key, 32)
    f32 = jnp.float32

    def nrm(k, shape, std):
        return std * jax.random.normal(k, shape, f32)

    lam_im_base = jnp.pi * jnp.arange(SSM_N, dtype=f32)
    return {
        'x': nrm(ks[0], (BATCH, SEQ, D_MODEL), 1.0),
        'c': nrm(ks[1], (BATCH, D_MODEL), 1.0),
        'ctx': nrm(ks[2], (BATCH, CTX_LEN, D_MODEL), 1.0),
        'c_ctx': nrm(ks[3], (D_MODEL,), 1.0),
        'w_ada': nrm(ks[4], (DEPTH, D_MODEL, 6 * D_MODEL), D_MODEL ** -0.5),
        'b_ada': nrm(ks[5], (DEPTH, 6 * D_MODEL), 0.02),
        'norm1_g': 1.0 + nrm(ks[6], (DEPTH, D_MODEL), 0.02),
        'w_in': nrm(ks[7], (DEPTH, D_MODEL, IN_COLS), D_MODEL ** -0.5),
        'q_norm_g': 1.0 + nrm(ks[8], (DEPTH, HEAD_DIM), 0.02),
        'k_norm_g': 1.0 + nrm(ks[9], (DEPTH, HEAD_DIM), 0.02),
        'ssm_lambda_re': -0.5 + nrm(ks[10], (DEPTH, 2, SSM_G, SSM_N), 0.01),
        'ssm_lambda_im': lam_im_base + nrm(ks[11], (DEPTH, 2, SSM_G, SSM_N), 0.01),
        'ssm_log_step': jax.random.uniform(ks[12], (DEPTH, 2, SSM_G), f32,
                                           minval=math.log(DT_MIN), maxval=math.log(DT_MAX)),
        'ssm_b_re': nrm(ks[13], (DEPTH, 2, SSM_G, SSM_N, SSM_P), (2 * SSM_P) ** -0.5),
        'ssm_b_im': nrm(ks[14], (DEPTH, 2, SSM_G, SSM_N, SSM_P), (2 * SSM_P) ** -0.5),
        'ssm_c_re': nrm(ks[15], (DEPTH, 2, SSM_G, SSM_P, SSM_N), (2 * SSM_N) ** -0.5),
        'ssm_c_im': nrm(ks[16], (DEPTH, 2, SSM_G, SSM_P, SSM_N), (2 * SSM_N) ** -0.5),
        'ssm_d': nrm(ks[17], (DEPTH, SSM_G, SSM_P), 0.3),
        'w_glu': nrm(ks[18], (DEPTH, SSM_WIDTH, SSM_WIDTH), SSM_WIDTH ** -0.5),
        'b_glu': nrm(ks[19], (DEPTH, SSM_WIDTH), 0.02),
        'out_norm_g': 1.0 + nrm(ks[20], (DEPTH, D_MODEL), 0.02),
        'w_out': nrm(ks[21], (DEPTH, D_MODEL, D_MODEL), D_MODEL ** -0.5),
        'norm2_g': 1.0 + nrm(ks[22], (DEPTH, D_MODEL), 0.02),
        'w_up': nrm(ks[23], (DEPTH, D_MODEL, 2 * D_FF), D_MODEL ** -0.5),
        'conv_w': nrm(ks[24], (DEPTH, CONV_W, 2 * D_FF), CONV_W ** -0.5),
        'conv_b': nrm(ks[25], (DEPTH, 2 * D_FF), 0.02),
        'w_down': nrm(ks[26], (DEPTH, D_FF, D_MODEL), D_FF ** -0.5),
    }


def reference(x, c, ctx, c_ctx, w_ada, b_ada, norm1_g, w_in, q_norm_g, k_norm_g,
              ssm_lambda_re, ssm_lambda_im, ssm_log_step, ssm_b_re, ssm_b_im, ssm_c_re, ssm_c_im,
              ssm_d, w_glu, b_glu, out_norm_g, w_out, norm2_g, w_up, conv_w, conv_b, w_down):
    cos, sin = _axial_rope_tables(x.shape[1])
    for layer in range(DEPTH):
        p = {
            'w_ada': w_ada[layer], 'b_ada': b_ada[layer], 'norm1_g': norm1_g[layer],
            'w_in': w_in[layer], 'q_norm_g': q_norm_g[layer], 'k_norm_g': k_norm_g[layer],
            'ssm_lambda_re': ssm_lambda_re[layer], 'ssm_lambda_im': ssm_lambda_im[layer],
            'ssm_log_step': ssm_log_step[layer], 'ssm_b_re': ssm_b_re[layer], 'ssm_b_im': ssm_b_im[layer],
            'ssm_c_re': ssm_c_re[layer], 'ssm_c_im': ssm_c_im[layer], 'ssm_d': ssm_d[layer],
            'w_glu': w_glu[layer], 'b_glu': b_glu[layer], 'out_norm_g': out_norm_g[layer],
            'w_out': w_out[layer], 'norm2_g': norm2_g[layer], 'w_up': w_up[layer],
            'conv_w': conv_w[layer], 'conv_b': conv_b[layer], 'w_down': w_down[layer],
        }
        x, ctx = _layer(x, ctx, c, c_ctx, cos, sin, p, layer < DEPTH - 1)
    return x
```

```cpp
#include <hip/hip_runtime.h>
#include <hip/hip_cooperative_groups.h>
#include <hip/hip_bf16.h>
#include <cstdio>
#include <cstdint>
#include <cmath>
namespace cg = cooperative_groups;
__device__ __forceinline__ int olane() { unsigned z = 0u; asm volatile("" : "+v"(z)); return (int)__builtin_amdgcn_mbcnt_hi(~0u, __builtin_amdgcn_mbcnt_lo(~0u, z)); }
extern __shared__ __attribute__((aligned(16))) unsigned char lds_dyn[];
constexpr int WTAB_OFF = 135168 + 256;
__device__ __forceinline__ int hw_slot() { return (int)__builtin_amdgcn_s_getreg((5 << 11) | (0 << 6) | 4); }
__device__ __forceinline__ int otid() {
    const int w = __builtin_amdgcn_readfirstlane(((volatile __attribute__((address_space(3))) int*)((__attribute__((address_space(3))) unsigned char*)lds_dyn + WTAB_OFF))[hw_slot()]);
    int t = w * 64 + olane(); asm volatile("" : "+v"(t)); return t;
}
template <int M> __device__ __forceinline__ float shx(float v) {
    if constexpr (M == 32) { auto rr = __builtin_amdgcn_permlane32_swap(__builtin_bit_cast(unsigned, v), __builtin_bit_cast(unsigned, v), false, false);
        const bool hi = (olane() & 32) != 0; return __builtin_bit_cast(float, hi ? rr[0] : rr[1]); }
    else return __builtin_bit_cast(float, __builtin_amdgcn_ds_swizzle(__builtin_bit_cast(int, v), (M << 10) | 0x1f));
}
__device__ __forceinline__ int obid() { int t = blockIdx.x; asm volatile("" : "+s"(t)); return t; }
__device__ __forceinline__ int ogrid() { int t = gridDim.x; asm volatile("" : "+s"(t)); return t; }
namespace pg8 {
#define PG8_LAS __attribute__((address_space(3)))
typedef unsigned short bf16_t;
typedef short bf16x8 __attribute__((ext_vector_type(8)));
typedef float f32x4 __attribute__((ext_vector_type(4)));
typedef unsigned u32x4 __attribute__((ext_vector_type(4)));
typedef unsigned u32x2 __attribute__((ext_vector_type(2)));
constexpr int BM = 256, BK = 64, HALF = 128, HTB = HALF * BK * 2  , STAGE_BYTES = 8 * HTB, NXCD = 8, WGM = 8;

__host__ __device__ __forceinline__ int lds_byte(int r, int c) { const int st = (r >> 4) * 2 + (c >> 5), rr = r & 15, cc = c & 31, ob = rr * 64 + cc * 2; return st * 1024 + (ob ^ (((ob >> 9) & 1) << 5)); }
__host__ __device__ __forceinline__ void stage_rc(int b, int& R, int& C) { const int st = b / 1024, sb = b % 1024, swz = sb ^ (((sb >> 9) & 1) << 5); R = (st >> 1) * 16 + swz / 64; C = (st & 1) * 32 + (swz % 64) / 2; }
__host__ __device__ __forceinline__ int perm32(int rho) { const int n = rho >> 4, i = rho & 15; return 8 * (i >> 2) + 4 * n + (i & 3); }

struct Unit { int pm, pn, kofs, ks; };
struct Gemm { const bf16_t* A; const bf16_t* Bt; int M, N, K, ld; };

struct StaticOrder {
    int nM, nN, nwg, G, c;
    __host__ __device__ void init(int M, int N, int G_, int c_) { nM = M / BM; nN = N / BM; nwg = nM * nN; G = G_; c = c_; }
    __host__ __device__ bool next(int i, Unit& u) const {
        const long L = (long)i * G + c; if (L >= nwg) return false;
        int wgid = (int)L; { const int q = nwg / NXCD, r = nwg % NXCD, xcd = wgid % NXCD, off = wgid / NXCD; wgid = (xcd < r ? xcd * (q + 1) : r * (q + 1) + (xcd - r) * q) + off; }
        const int nig = WGM * nN, gid = wgid / nig, fm = gid * WGM, gsz = (nM - fm) < WGM ? (nM - fm) : WGM;
        u.pm = fm + ((wgid % nig) % gsz); u.pn = (wgid % nig) / gsz; u.kofs = 0; u.ks = 0; return true;
    }
    __device__ __forceinline__ void a_ready(const Unit&) const {}
    __device__ __forceinline__ void done(const Unit&) const {}
};

__device__ __forceinline__ unsigned cvt_pk_bf16(float lo, float hi) { unsigned r; asm volatile("v_cvt_pk_bf16_f32 %0, %1, %2" : "=v"(r) : "v"(lo), "v"(hi)); return r; }
typedef float f32x2 __attribute__((ext_vector_type(2)));
struct EpiStore { static constexpr bool ROWPERM = false;
    static constexpr bool PERM = true, AFTER_DRAIN = false;
    bf16_t* O; int ldc;
    __device__ __forceinline__ void operator()(const f32x4 (&acc)[2][2][4][2], const Unit& u, int wr, int wc, int fr, int fq) const {
        const int row0 = u.pm * BM + wr * 64 + fr; const int col0 = u.pn * BM + wc * 32 + 8 * fq;
#pragma unroll
        for (int ai = 0; ai < 2; ++ai)
#pragma unroll
            for (int m = 0; m < 4; ++m) { bf16_t* rowp = O + (size_t)(row0 + ai * HALF + m * 16) * ldc + col0;
#pragma unroll
                for (int bj = 0; bj < 2; ++bj) { const f32x4 v0 = acc[ai][bj][m][0], v1 = acc[ai][bj][m][1];
                    u32x4 w; w.x = cvt_pk_bf16(v0[0], v0[1]); w.y = cvt_pk_bf16(v0[2], v0[3]); w.z = cvt_pk_bf16(v1[0], v1[1]); w.w = cvt_pk_bf16(v1[2], v1[3]);
                    *(u32x4*)(rowp + bj * HALF) = w; } }
    }
};
__device__ __forceinline__ float bf_lo(unsigned w) { return __uint_as_float(w << 16); }
__device__ __forceinline__ float bf_hi(unsigned w) { return __uint_as_float(w & 0xffff0000u); }
__device__ __forceinline__ float sigm(float x) { return __builtin_amdgcn_rcpf(1.0f + __builtin_amdgcn_exp2f(-1.4426950408889634f * x)); }
struct EpiGlu { static constexpr bool ROWPERM = false;
    static constexpr bool PERM = true, AFTER_DRAIN = false;
    const bf16_t* Z; bf16_t* O; const float* bias;
    __device__ __forceinline__ void operator()(const f32x4 (&acc)[2][2][4][2], const Unit& u, int wr, int wc, int fr, int fq) const {
        const int row0 = u.pm * BM + wr * 64 + fr; const int col0 = u.pn * BM + wc * 32 + 8 * fq;
        f32x4 bv[2][2];
#pragma unroll
        for (int bj = 0; bj < 2; ++bj)
#pragma unroll
            for (int n = 0; n < 2; ++n) bv[bj][n] = *(const f32x4*)(bias + col0 + bj * HALF + 4 * n);
#pragma unroll
        for (int ai = 0; ai < 2; ++ai) {
            u32x4 zv[4][2];
#pragma unroll
            for (int m = 0; m < 4; ++m)
#pragma unroll
                for (int bj = 0; bj < 2; ++bj) zv[m][bj] = *(const u32x4*)(Z + (size_t)(row0 + ai * HALF + m * 16) * 512 + col0 + bj * HALF);
            asm volatile("" ::: "memory");
#pragma unroll
            for (int m = 0; m < 4; ++m) { const size_t off = (size_t)(row0 + ai * HALF + m * 16) * 512 + col0;
#pragma unroll
                for (int bj = 0; bj < 2; ++bj) { const u32x4 zz = zv[m][bj];
                    const f32x4 v0 = acc[ai][bj][m][0] + bv[bj][0], v1 = acc[ai][bj][m][1] + bv[bj][1];
                    u32x4 w;
                    w.x = cvt_pk_bf16(bf_lo(zz.x) * sigm(v0[0]), bf_hi(zz.x) * sigm(v0[1])); w.y = cvt_pk_bf16(bf_lo(zz.y) * sigm(v0[2]), bf_hi(zz.y) * sigm(v0[3]));
                    w.z = cvt_pk_bf16(bf_lo(zz.z) * sigm(v1[0]), bf_hi(zz.z) * sigm(v1[1])); w.w = cvt_pk_bf16(bf_lo(zz.w) * sigm(v1[2]), bf_hi(zz.w) * sigm(v1[3]));
                    *(u32x4*)(O + off + bj * HALF) = w; } }
            asm volatile("" ::: "memory"); }
    }
};
struct EpiRes { static constexpr bool ROWPERM = false;
    static constexpr bool PERM = true, AFTER_DRAIN = false;
    float* xlat; float* xctx; const float* gate; bf16_t* xt; const float* cscale; float* ssq;
    __device__ __forceinline__ void operator()(const f32x4 (&acc)[2][2][4][2], const Unit& u, int wr, int wc, int fr, int fq) const {
        const int rowt = u.pm * BM;
        float* xb = rowt < 16384 ? xlat + (size_t)rowt * 1024 : xctx + (size_t)(rowt - 16384) * 1024;
        const int v = rowt < 16384 ? (rowt >> 12) : 4;
        const int col0 = u.pn * BM + wc * 32 + 8 * fq;
        f32x4 gv[2][2], cv[2][2];
#pragma unroll
        for (int bj = 0; bj < 2; ++bj)
#pragma unroll
            for (int n = 0; n < 2; ++n) { gv[bj][n] = *(const f32x4*)(gate + v * 6144 + col0 + bj * HALF + n * 4); cv[bj][n] = xt ? *(const f32x4*)(cscale + v * 1024 + col0 + bj * HALF + n * 4) : (f32x4){0.f, 0.f, 0.f, 0.f}; }
#pragma unroll
        for (int hb = 0; hb < 4; ++hb) { const int ai = hb >> 1, m0 = (hb & 1) * 2;
            f32x4 xv[2][2][2];
#pragma unroll
            for (int mm = 0; mm < 2; ++mm)
#pragma unroll
                for (int bj = 0; bj < 2; ++bj)
#pragma unroll
                    for (int n = 0; n < 2; ++n) xv[mm][bj][n] = *(const f32x4*)(xb + (size_t)(ai * HALF + wr * 64 + (m0 + mm) * 16 + fr) * 1024 + col0 + bj * HALF + n * 4);
            asm volatile("" ::: "memory");
#pragma unroll
            for (int mm = 0; mm < 2; ++mm) { const int m = m0 + mm; const int rl = ai * HALF + wr * 64 + m * 16 + fr; float* rp = xb + (size_t)rl * 1024 + col0; float ss = 0.f;
#pragma unroll
                for (int bj = 0; bj < 2; ++bj)
#pragma unroll
                    for (int n = 0; n < 2; ++n) { f32x4 x = xv[mm][bj][n] + gv[bj][n] * acc[ai][bj][m][n]; *(f32x4*)(rp + bj * HALF + n * 4) = x;
                        if (xt) { ss += (x[0] * x[0] + x[1] * x[1]) + (x[2] * x[2] + x[3] * x[3]); const f32x4 y = x * cv[bj][n];
                            u32x2 w; w.x = cvt_pk_bf16(y[0], y[1]); w.y = cvt_pk_bf16(y[2], y[3]); *(u32x2*)(xt + (size_t)(rowt + rl) * 1024 + col0 + bj * HALF + n * 4) = w; } }
                if (xt) { ss += shx<16>(ss); ss += shx<32>(ss); if (fq == 0) ssq[(size_t)(rowt + rl) * 16 + u.pn * 4 + wc] = ss; } }
            asm volatile("" ::: "memory"); }
    }
};
__device__ __forceinline__ float row_rstd(const float* ssq, int row, int fq) {
    const f32x4 a = ((const f32x4*)(ssq + (size_t)row * 16))[fq];
    float s = (a[0] + a[1]) + (a[2] + a[3]); s += shx<16>(s); s += shx<32>(s);
    return __builtin_amdgcn_rsqf(s * (1.f / 1024.f) + 1e-6f);
}
__device__ __forceinline__ float dpp_shr1(float v) { return __builtin_bit_cast(float, __builtin_amdgcn_update_dpp(0, __builtin_bit_cast(int, v), 0x111, 0xf, 0xf, true)); }
__device__ __forceinline__ float dpp_shl1(float v) { return __builtin_bit_cast(float, __builtin_amdgcn_update_dpp(0, __builtin_bit_cast(int, v), 0x101, 0xf, 0xf, true)); }
__device__ __forceinline__ float silu_e(float x) { return x * __builtin_amdgcn_rcpf(1.0f + __builtin_amdgcn_exp2f(-1.4426950408889634f * x)); }
struct EpiConv { static constexpr bool ROWPERM = true;
    static constexpr bool PERM = true, AFTER_DRAIN = false;
    bf16_t* H; const float* cw; const float* cb; float* side; PG8_LAS float* xl; const float* ssq; const float* bias;
    __device__ __forceinline__ void operator()(f32x4 (&acc)[2][2][4][2], const Unit& u, int wr, int wc, int fr, int fq) const {
        { const int rowt = u.pm * BM; const int v = rowt < 16384 ? (rowt >> 12) : 4; const int cc = 128 * u.pn + 32 * wc + 8 * fq;
          f32x4 bv[2][2];
#pragma unroll
          for (int bj = 0; bj < 2; ++bj)
#pragma unroll
              for (int n = 0; n < 2; ++n) bv[bj][n] = *(const f32x4*)(bias + v * 5632 + bj * 2816 + cc + 4 * n);
#pragma unroll
          for (int ai = 0; ai < 2; ++ai)
#pragma unroll
              for (int m = 0; m < 4; ++m) { const float rs = row_rstd(ssq, rowt + 128 * wr + 8 * fr + 4 * ai + m, fq);
#pragma unroll
                  for (int bj = 0; bj < 2; ++bj)
#pragma unroll
                      for (int n = 0; n < 2; ++n) acc[ai][bj][m][n] = acc[ai][bj][m][n] * rs + bv[bj][n]; } }
        const int xb = ((wr * 4 + wc) * 4 + fq) * 16;
        if (fr == 0) {
#pragma unroll
            for (int bj = 0; bj < 2; ++bj)
#pragma unroll
                for (int n = 0; n < 2; ++n) *(PG8_LAS f32x4*)(xl + xb + bj * 8 + n * 4) = acc[0][bj][0][n]; }
        if (fr == 15) {
#pragma unroll
            for (int bj = 0; bj < 2; ++bj)
#pragma unroll
                for (int n = 0; n < 2; ++n) *(PG8_LAS f32x4*)(xl + 512 + xb + bj * 8 + n * 4) = acc[1][bj][3][n]; }
        asm volatile("s_waitcnt lgkmcnt(0)" ::: "memory"); __builtin_amdgcn_s_barrier(); asm volatile("" ::: "memory");
        const int ch0 = 128 * u.pn + 32 * wc + 8 * fq;
        const size_t t0 = (size_t)u.pm * BM + 128 * wr + 8 * fr;
        const bool sfirst = (fr == 0 && wr == 0), slast = (fr == 15 && wr == 1);
        float* sd = side + (size_t)u.pm * 4 * 5632;
#pragma unroll
        for (int n = 0; n < 2; ++n) {
            f32x4 prv[2], nxt[2];
#pragma unroll
            for (int bj = 0; bj < 2; ++bj) {
#pragma unroll
                for (int j = 0; j < 4; ++j) { prv[bj][j] = dpp_shr1(acc[1][bj][3][n][j]); nxt[bj][j] = dpp_shl1(acc[0][bj][0][n][j]); }
                if (fr == 0 && wr == 1) prv[bj] = *(const PG8_LAS f32x4*)(xl + 512 + ((0 * 4 + wc) * 4 + fq) * 16 + bj * 8 + n * 4);
                if (fr == 15 && wr == 0) nxt[bj] = *(const PG8_LAS f32x4*)(xl + ((1 * 4 + wc) * 4 + fq) * 16 + bj * 8 + n * 4); }
            const int c = ch0 + 4 * n;
            const f32x4 w0a = *(const f32x4*)(cw + c), w1a = *(const f32x4*)(cw + 5632 + c), w2a = *(const f32x4*)(cw + 2 * 5632 + c), ba = *(const f32x4*)(cb + c);
            const f32x4 w0g = *(const f32x4*)(cw + 2816 + c), w1g = *(const f32x4*)(cw + 5632 + 2816 + c), w2g = *(const f32x4*)(cw + 2 * 5632 + 2816 + c), bg = *(const f32x4*)(cb + 2816 + c);
#pragma unroll
            for (int k = 0; k < 8; ++k) {
                const f32x4 ap = k == 0 ? prv[0] : acc[(k - 1) >> 2][0][(k - 1) & 3][n], ac = acc[k >> 2][0][k & 3][n], an = k == 7 ? nxt[0] : acc[(k + 1) >> 2][0][(k + 1) & 3][n];
                const f32x4 gp = k == 0 ? prv[1] : acc[(k - 1) >> 2][1][(k - 1) & 3][n], gc = acc[k >> 2][1][k & 3][n], gn = k == 7 ? nxt[1] : acc[(k + 1) >> 2][1][(k + 1) & 3][n];
                const f32x4 oa = w0a * ap + w1a * ac + w2a * an + ba, og = w0g * gp + w1g * gc + w2g * gn + bg;
                u32x2 w; w.x = cvt_pk_bf16(silu_e(og[0]) * oa[0], silu_e(og[1]) * oa[1]); w.y = cvt_pk_bf16(silu_e(og[2]) * oa[2], silu_e(og[3]) * oa[3]);
                *(u32x2*)(H + (t0 + k) * 2816 + c) = w;
                if (k == 0 && sfirst) { *(f32x4*)(sd + 0 * 5632 + c) = ac; *(f32x4*)(sd + 0 * 5632 + 2816 + c) = gc; *(f32x4*)(sd + 1 * 5632 + c) = oa; *(f32x4*)(sd + 1 * 5632 + 2816 + c) = og; }
                if (k == 7 && slast) { *(f32x4*)(sd + 2 * 5632 + c) = ac; *(f32x4*)(sd + 2 * 5632 + 2816 + c) = gc; *(f32x4*)(sd + 3 * 5632 + c) = oa; *(f32x4*)(sd + 3 * 5632 + 2816 + c) = og; }
            }
        }
    }
};
struct EpiIn { static constexpr bool ROWPERM = false;
    static constexpr bool PERM = false, AFTER_DRAIN = false;
    bf16_t* QO; bf16_t* KA; bf16_t* VA; bf16_t* UB; const float* qg; const float* kg; const float* rt; const float* ssq; const float* bias;
    __device__ __forceinline__ void operator()(const f32x4 (&acc)[2][2][4][2], const Unit& u, int wr, int wc, int fr, int fq) const {
        const int rowt = u.pm * BM + wr * 64 + fr;
        const int vb = (u.pm * BM) < 16384 ? ((u.pm * BM) >> 12) : 4;
        const int sbase = u.pn >= 3 ? 768 + (u.pn - 3) * 256 + 32 * wc : (u.pn < 2 ? (4 * u.pn + wc) * 64 : (wc < 2 ? 512 + wc * 64 : 640 + (wc - 2) * 64));
        const int sbj = u.pn >= 3 ? 128 : 32;
        f32x4 bsv[2][2];
#pragma unroll
        for (int bj = 0; bj < 2; ++bj)
#pragma unroll
            for (int n = 0; n < 2; ++n) bsv[bj][n] = *(const f32x4*)(bias + vb * 1280 + sbase + sbj * bj + 16 * n + 4 * fq);
        float rsv[2][4];
#pragma unroll
        for (int ai = 0; ai < 2; ++ai)
#pragma unroll
            for (int m = 0; m < 4; ++m) rsv[ai][m] = row_rstd(ssq, rowt + ai * HALF + m * 16, fq);
        if (u.pn >= 3) {
#pragma unroll
            for (int ai = 0; ai < 2; ++ai)
#pragma unroll
                for (int m = 0; m < 4; ++m) { bf16_t* rp = UB + (size_t)(rowt + ai * HALF + m * 16) * 512 + (u.pn - 3) * 256 + wc * 32 + 4 * fq; const float rs = rsv[ai][m];
#pragma unroll
                    for (int bj = 0; bj < 2; ++bj)
#pragma unroll
                        for (int n = 0; n < 2; ++n) { const f32x4 v = acc[ai][bj][m][n] * rs + bsv[bj][n]; u32x2 w; w.x = cvt_pk_bf16(v[0], v[1]); w.y = cvt_pk_bf16(v[2], v[3]); *(u32x2*)(rp + bj * HALF + n * 16) = w; } }
            return;
        }
        const bool isv = (u.pn == 2 && wc >= 2), isq = u.pn < 2;
        const float* gsrc = isq ? qg : kg;
        f32x4 gn[2][2];
#pragma unroll
        for (int bj = 0; bj < 2; ++bj)
#pragma unroll
            for (int n = 0; n < 2; ++n) gn[bj][n] = *(const f32x4*)(gsrc + 32 * bj + 16 * n + 4 * fq);
        const float osc = isq ? 0.125f * 1.4426950408889634f : 1.0f;
#pragma unroll
        for (int ai = 0; ai < 2; ++ai)
#pragma unroll
            for (int m = 0; m < 4; ++m) {
                const int row = rowt + ai * HALF + m * 16; const bool lat = row < 16384; const int sidx = row & 4095;
                const size_t kvrow = lat ? (size_t)(row >> 12) * 4352 + 256 + sidx : (size_t)((row - 16384) >> 8) * 4352 + ((row - 16384) & 255);
                f32x4 y[2][2]; const float rs = rsv[ai][m];
#pragma unroll
                for (int bj = 0; bj < 2; ++bj)
#pragma unroll
                    for (int n = 0; n < 2; ++n) y[bj][n] = acc[ai][bj][m][n] * rs + bsv[bj][n];
                if (!isv) {
                    float ss = 0.f;
#pragma unroll
                    for (int bj = 0; bj < 2; ++bj)
#pragma unroll
                        for (int n = 0; n < 2; ++n) { const f32x4 v = y[bj][n]; ss += (v[0] * v[0] + v[1] * v[1]) + (v[2] * v[2] + v[3] * v[3]); }
                    ss += shx<16>(ss); ss += shx<32>(ss);
                    const float rstd = __builtin_amdgcn_rsqf(ss * (1.f / 64.f) + 1e-6f);
#pragma unroll
                    for (int bj = 0; bj < 2; ++bj) {
                        f32x4 t1 = y[bj][0] * rstd * gn[bj][0], t2 = y[bj][1] * rstd * gn[bj][1];
                        if (lat) { const int p = bj == 0 ? (sidx >> 6) : (sidx & 63);
                            const f32x4 cs = *(const f32x4*)(rt + p * 16 + 4 * fq), sn = *(const f32x4*)(rt + 1024 + p * 16 + 4 * fq);
                            const f32x4 o1 = t1 * cs - t2 * sn, o2 = t2 * cs + t1 * sn; t1 = o1; t2 = o2; }
                        y[bj][0] = t1 * osc; y[bj][1] = t2 * osc; }
                }
                bf16_t* dst = isq ? QO + (size_t)row * 512 + (4 * u.pn + wc) * 64 : (isv ? VA + kvrow * 128 + (wc - 2) * 64 : KA + kvrow * 128 + wc * 64);
#pragma unroll
                for (int bj = 0; bj < 2; ++bj)
#pragma unroll
                    for (int n = 0; n < 2; ++n) { const f32x4 v = y[bj][n]; u32x2 w; w.x = cvt_pk_bf16(v[0], v[1]); w.y = cvt_pk_bf16(v[2], v[3]); *(u32x2*)(dst + 32 * bj + 16 * n + 4 * fq) = w; }
            }
    }
};

struct SliceOrder {
    int G, c;
    __host__ __device__ bool next(int i, Unit& u) const { const int L = i * G + c; if (L >= 176) return false; u.ks = L >> 4; u.kofs = u.ks * 256; u.pm = (L >> 2) & 3; u.pn = L & 3; return true; }
    __device__ __forceinline__ void a_ready(const Unit&) const {}
    __device__ __forceinline__ void done(const Unit&) const {}
};
struct EpiPart { static constexpr bool ROWPERM = false;
    static constexpr bool PERM = true, AFTER_DRAIN = false;
    float* P;
    __device__ __forceinline__ void operator()(const f32x4 (&acc)[2][2][4][2], const Unit& u, int wr, int wc, int fr, int fq) const {
        float* base = P + ((size_t)u.ks * 1024 + u.pm * BM + wr * 64 + fr) * 1024 + u.pn * BM + wc * 32 + 8 * fq;
#pragma unroll
        for (int ai = 0; ai < 2; ++ai)
#pragma unroll
            for (int m = 0; m < 4; ++m)
#pragma unroll
                for (int bj = 0; bj < 2; ++bj)
#pragma unroll
                    for (int n = 0; n < 2; ++n) *(f32x4*)(base + (size_t)(ai * HALF + m * 16) * 1024 + bj * HALF + n * 4) = acc[ai][bj][m][n];
    }
};

struct OneUnit { int pm, pn;
    __host__ __device__ bool next(int i, Unit& u) const { if (i > 0) return false; u.pm = pm; u.pn = pn; u.kofs = 0; u.ks = 0; return true; }
    __device__ __forceinline__ void a_ready(const Unit&) const {}
    __device__ __forceinline__ void done(const Unit&) const {}
};
template <class Epi, class Sched, bool ALIGN_EPI = false, bool SP2 = false>
__device__ __forceinline__ void gemm_phase(PG8_LAS unsigned char* lds, const Gemm g, const Sched& S, const Epi& E) {
    const int tid = otid(), wid = __builtin_amdgcn_readfirstlane(tid >> 6), lane = tid & 63, wr = wid >> 2, wc = wid & 3, fr = lane & 15, fq = lane >> 4;
    const int K = g.ld, nt = g.K / BK;
    unsigned voffA[2], voffB[2];
#pragma unroll
    for (int i = 0; i < 2; ++i) { int R, C; stage_rc(tid * 16 + i * 8192, R, C); const int Rb = Epi::PERM ? ((R & ~31) + perm32(R & 31)) : R;
        const int Ra = Epi::ROWPERM ? (128 * (R >> 6) + 8 * (R & 15) + ((R >> 4) & 3)) : R;
        voffA[i] = (unsigned)(Ra * K + C) * 2u; voffB[i] = (unsigned)(Rb * K + C) * 2u; }
    const size_t hstepA = Epi::ROWPERM ? (size_t)4 * K * 2 : (size_t)HALF * K * 2;
    const size_t kstep = (size_t)(BK * 2);
    const size_t hstep = (size_t)HALF * K * 2;
    const size_t tstep = 2 * hstep;
    const unsigned ldsw = (unsigned)wid * 1024u;
    const int aoff = lds_byte(wr * 64 + fr, fq * 8), boff = lds_byte(wc * 32 + fr, fq * 8);
#define PG8_SA(b, h) (((b) * 2 + (h)) * HTB)
#define PG8_SB(b, h) ((4 + (b) * 2 + (h)) * HTB)
#define PG8_STAGE(bufoff, gbase, voff) do { _Pragma("unroll") for (int _i = 0; _i < 2; ++_i) \
        __builtin_amdgcn_global_load_lds((const unsigned*)((const char*)(gbase) + (voff)[_i]), (PG8_LAS unsigned*)(lds + (bufoff) + ldsw + _i * 8192), 16, 0, 0); } while (0)
#define PG8_LDA(dst, b, h) do { _Pragma("unroll") for (int m = 0; m < 4; ++m) _Pragma("unroll") for (int k = 0; k < 2; ++k) dst[m][k] = *(const PG8_LAS bf16x8*)(lds + PG8_SA(b, h) + aoff + m * 2048 + k * 1024); } while (0)
#define PG8_LDB(dst, b, h) do { _Pragma("unroll") for (int n = 0; n < 2; ++n) _Pragma("unroll") for (int k = 0; k < 2; ++k) dst[n][k] = *(const PG8_LAS bf16x8*)(lds + PG8_SB(b, h) + boff + n * 2048 + k * 1024); } while (0)
#define PG8_MMA(ai, bj, At, Bt) do { __builtin_amdgcn_s_setprio(1); _Pragma("unroll") for (int m = 0; m < 4; ++m) _Pragma("unroll") for (int n = 0; n < 2; ++n) _Pragma("unroll") for (int k = 0; k < 2; ++k) \
        acc[ai][bj][m][n] = __builtin_amdgcn_mfma_f32_16x16x32_bf16(Bt[n][k], At[m][k], acc[ai][bj][m][n], 0, 0, 0); __builtin_amdgcn_s_setprio(0); } while (0)
#define PG8_WAIT_V(n) asm volatile("s_waitcnt vmcnt(" #n ")" ::: "memory")
#define PG8_WAIT_L(n) asm volatile("s_waitcnt lgkmcnt(" #n ")" ::: "memory")
#define PG8_BAR __builtin_amdgcn_s_barrier()
#define PG8_SCHED __builtin_amdgcn_sched_barrier(0)
    Unit cur, nxt; int ui = 0;
    if (!S.next(0, cur)) return;
    f32x4 acc[2][2][4][2];
#pragma unroll
    for (int a = 0; a < 2; ++a)
#pragma unroll
        for (int b = 0; b < 2; ++b)
#pragma unroll
            for (int m = 0; m < 4; ++m)
#pragma unroll
                for (int n = 0; n < 2; ++n) acc[a][b][m][n] = (f32x4){0.f, 0.f, 0.f, 0.f};
    bf16x8 At[4][2], B0[2][2], B1[2][2];
    const char* cA = (const char*)g.A + (size_t)cur.pm * tstep + (size_t)cur.kofs * 2; const char* cB = (const char*)g.Bt + (size_t)cur.pn * tstep + (size_t)cur.kofs * 2;
    S.a_ready(cur);
    if constexpr (SP2) {
        PG8_STAGE(PG8_SB(0, 0), cB, voffB); PG8_STAGE(PG8_SB(0, 1), cB + hstep, voffB); PG8_STAGE(PG8_SA(0, 0), cA, voffA); PG8_STAGE(PG8_SA(0, 1), cA + hstepA, voffA);
        if (wr == 1) PG8_BAR;
        PG8_WAIT_V(2); PG8_BAR;
        PG8_STAGE(PG8_SB(1, 0), cB + kstep, voffB); PG8_STAGE(PG8_SA(1, 0), cA + kstep, voffA); PG8_STAGE(PG8_SB(1, 1), cB + hstep + kstep, voffB);
        PG8_WAIT_V(6); PG8_BAR;
    } else {
        PG8_STAGE(PG8_SB(0, 0), cB, voffB); PG8_STAGE(PG8_SA(0, 0), cA, voffA); PG8_STAGE(PG8_SB(0, 1), cB + hstep, voffB); PG8_STAGE(PG8_SA(0, 1), cA + hstepA, voffA);
        if (wr == 1) PG8_BAR;
        PG8_WAIT_V(4); PG8_BAR;
        PG8_STAGE(PG8_SB(1, 0), cB + kstep, voffB); PG8_STAGE(PG8_SA(1, 0), cA + kstep, voffA); PG8_STAGE(PG8_SB(1, 1), cB + hstep + kstep, voffB);
        PG8_WAIT_V(6); PG8_BAR;
    }
    for (;;) {
        const bool has_next = S.next(ui + 1, nxt);
        const char* nA = has_next ? (const char*)g.A + (size_t)nxt.pm * tstep + (size_t)nxt.kofs * 2 : cA; const char* nB = has_next ? (const char*)g.Bt + (size_t)nxt.pn * tstep + (size_t)nxt.kofs * 2 : cB;
        for (int t = 0; t < nt; t += 2) {
            const bool last = (t == nt - 2);
            const char* a1 = cA + (size_t)(t + 1) * kstep;
            const char* a2 = last ? nA : cA + (size_t)(t + 2) * kstep; const char* b2 = last ? nB : cB + (size_t)(t + 2) * kstep;
            const char* a3 = a2 + kstep; const char* b3 = b2 + kstep;
            if (last && has_next) S.a_ready(nxt);
            if constexpr (SP2) {
            PG8_LDB(B0, 0, 0); PG8_LDB(B1, 0, 1); PG8_SCHED; PG8_LDA(At, 0, 0); PG8_STAGE(PG8_SA(1, 1), a1 + hstepA, voffA);
            PG8_WAIT_V(8); PG8_WAIT_L(0); PG8_BAR; PG8_MMA(0, 0, At, B0); PG8_MMA(0, 1, At, B1); PG8_BAR; PG8_SCHED;
            PG8_LDA(At, 0, 1); PG8_STAGE(PG8_SB(0, 0), b2, voffB); PG8_STAGE(PG8_SB(0, 1), b2 + hstep, voffB); PG8_STAGE(PG8_SA(0, 0), a2, voffA);
            PG8_WAIT_V(8); PG8_WAIT_L(0); PG8_BAR; PG8_MMA(1, 0, At, B0); PG8_MMA(1, 1, At, B1); PG8_BAR; PG8_SCHED;
            PG8_LDB(B0, 1, 0); PG8_LDB(B1, 1, 1); PG8_SCHED; PG8_LDA(At, 1, 0); PG8_STAGE(PG8_SA(0, 1), a2 + hstepA, voffA);
            PG8_WAIT_V(8); PG8_WAIT_L(0); PG8_BAR; PG8_MMA(0, 0, At, B0); PG8_MMA(0, 1, At, B1); PG8_BAR; PG8_SCHED;
            PG8_LDA(At, 1, 1); PG8_STAGE(PG8_SB(1, 0), b3, voffB); PG8_STAGE(PG8_SB(1, 1), b3 + hstep, voffB); PG8_STAGE(PG8_SA(1, 0), a3, voffA);
            PG8_WAIT_V(8); PG8_WAIT_L(0); PG8_BAR; PG8_MMA(1, 0, At, B0); PG8_MMA(1, 1, At, B1); PG8_BAR; PG8_SCHED;
            } else {
            PG8_LDB(B0, 0, 0); PG8_SCHED; PG8_LDA(At, 0, 0); PG8_STAGE(PG8_SA(1, 1), a1 + hstepA, voffA);
            PG8_WAIT_L(8); PG8_BAR; PG8_WAIT_L(0); PG8_MMA(0, 0, At, B0); PG8_BAR; PG8_SCHED;
            PG8_LDB(B1, 0, 1); PG8_STAGE(PG8_SB(0, 0), b2, voffB);
            PG8_BAR; PG8_WAIT_L(0); PG8_MMA(0, 1, At, B1); PG8_BAR;
            PG8_LDA(At, 0, 1); PG8_STAGE(PG8_SA(0, 0), a2, voffA);
            PG8_BAR; PG8_WAIT_L(0); PG8_MMA(1, 0, At, B0); PG8_BAR; PG8_SCHED;
            PG8_STAGE(PG8_SB(0, 1), b2 + hstep, voffB);
            PG8_WAIT_V(6); PG8_BAR; PG8_MMA(1, 1, At, B1); PG8_BAR;
            PG8_LDB(B0, 1, 0); PG8_SCHED; PG8_LDA(At, 1, 0); PG8_STAGE(PG8_SA(0, 1), a2 + hstepA, voffA);
            PG8_WAIT_L(8); PG8_BAR; PG8_WAIT_L(0); PG8_MMA(0, 0, At, B0); PG8_BAR; PG8_SCHED;
            PG8_LDB(B1, 1, 1); PG8_STAGE(PG8_SB(1, 0), b3, voffB);
            PG8_BAR; PG8_WAIT_L(0); PG8_MMA(0, 1, At, B1); PG8_BAR;
            PG8_LDA(At, 1, 1); PG8_STAGE(PG8_SA(1, 0), a3, voffA);
            PG8_BAR; PG8_WAIT_L(0); PG8_MMA(1, 0, At, B0); PG8_BAR; PG8_SCHED;
            PG8_STAGE(PG8_SB(1, 1), b3 + hstep, voffB);
            PG8_WAIT_V(6); PG8_BAR; PG8_MMA(1, 1, At, B1); PG8_BAR;
            }
        }
        if constexpr (ALIGN_EPI) { if (wr == 0) PG8_BAR; }
        if constexpr (!Epi::AFTER_DRAIN) { int l2 = olane(); asm volatile("" : "+v"(l2)); const int fr2 = l2 & 15, fq2 = l2 >> 4; E(acc, cur, wr, wc, fr2, fq2); S.done(cur); }
        if (!has_next) break;
#pragma unroll
        for (int a = 0; a < 2; ++a)
#pragma unroll
            for (int b = 0; b < 2; ++b)
#pragma unroll
                for (int m = 0; m < 4; ++m)
#pragma unroll
                    for (int n = 0; n < 2; ++n) acc[a][b][m][n] = (f32x4){0.f, 0.f, 0.f, 0.f};
        cur = nxt; cA = nA; cB = nB; ++ui;
        if constexpr (ALIGN_EPI) { if (wr == 1) PG8_BAR; }
    }
    PG8_WAIT_V(0);
    if constexpr (!ALIGN_EPI) { if (wr == 0) PG8_BAR; }
    PG8_BAR;
    if constexpr (Epi::AFTER_DRAIN) { E.fused(acc, cur, wr, wc, fr, fq, lds, wid, lane); S.done(cur); }
#undef PG8_SA
#undef PG8_SB
#undef PG8_STAGE
#undef PG8_LDA
#undef PG8_LDB
#undef PG8_MMA
#undef PG8_WAIT_V
#undef PG8_WAIT_L
#undef PG8_BAR
#undef PG8_SCHED
}
}
#include <hip/hip_bf16.h>
namespace attn_body {
using bf16=__hip_bfloat16;
using bf16x8=__attribute__((ext_vector_type(8)))short;
using s16x4=__attribute__((ext_vector_type(4)))short;
using f32x16=__attribute__((ext_vector_type(16)))float;
using u32x4=__attribute__((ext_vector_type(4)))unsigned;
constexpr int D=64,QP=512,KP=128;
constexpr int NW=8,QBLK=32,QB=QBLK*NW,KVBLK=64;
__device__ __forceinline__ int crow(int r,int hi){return (r&3)+8*(r>>2)+4*hi;}
#define SBAR() __builtin_amdgcn_sched_barrier(0)
__device__ __forceinline__ void cmask(f32x16&p0,f32x16&p1,int jb,int qrel,int hi){
  const float NEG=-INFINITY; int kb=64*jb+4*hi;
  #pragma unroll
  for(int r=0;r<16;++r){int kv=kb+(r&3)+8*(r>>2); if(kv>qrel)p0[r]=NEG; if(kv+32>qrel)p1[r]=NEG;}
}

constexpr int NSLOT=3, SLOTB=8192;
constexpr int LDS_K=0, LDS_V=NSLOT*SLOTB, LDS_WS=2*NSLOT*SLOTB, LDS_OST=LDS_WS+NW*64*4, LDS_BYTES=LDS_OST+NW*4096;
constexpr float C2=0.125f*1.4426950408889634f;
__device__ __forceinline__ void glds16(const void*gsrc,unsigned lds_dst){unsigned keep;
  asm volatile("s_mov_b32 %0, m0\n\ts_mov_b32 m0, %2\n\ts_nop 0\n\tglobal_load_lds_dwordx4 %1, off\n\ts_mov_b32 m0, %0":"=&s"(keep):"v"(gsrc),"s"(lds_dst):"memory");}
__device__ __forceinline__ float max3f(float a,float b,float c){float r;asm("v_max3_f32 %0, %1, %2, %3":"=v"(r):"v"(a),"v"(b),"v"(c));return r;}
__device__ __forceinline__ float max2f(float a,float b){float r;asm("v_max_f32_e32 %0, %1, %2":"=v"(r):"v"(a),"v"(b));return r;}
__device__ __forceinline__ float fadd_s(float a,float b){float r;asm("v_add_f32_e32 %0, %1, %2":"=v"(r):"v"(a),"v"(b));return r;}
__device__ __forceinline__ float fsub_s(float a,float b){float r;asm("v_sub_f32_e32 %0, %1, %2":"=v"(r):"v"(a),"v"(b));return r;}
typedef float f32x2_t __attribute__((ext_vector_type(2))); typedef __bf16 bf16x2_t __attribute__((ext_vector_type(2)));
__device__ __forceinline__ unsigned cvtpk_s(float lo,float hi){f32x2_t v={lo,hi};bf16x2_t b=__builtin_convertvector(v,bf16x2_t);return __builtin_bit_cast(unsigned,b);}
#define WAIT_BAR(N) asm volatile("s_waitcnt vmcnt(" #N ") lgkmcnt(0)\n\ts_barrier":::"memory")

__device__ __forceinline__ void qkt(f32x16&p0,f32x16&p1,const char*Kslot,const bf16x8*qr,const f32x16&negm,int r32,int hi){
  const char*kb=Kslot+hi*1024+r32*16;
  #pragma unroll
  for(int d0=0;d0<4;++d0){
    const bf16x8 b0=*reinterpret_cast<const bf16x8*>(kb+d0*2048);
    const bf16x8 b1=*reinterpret_cast<const bf16x8*>(kb+d0*2048+512);
    if(d0==0){p0=__builtin_amdgcn_mfma_f32_32x32x16_bf16(b0,qr[0],negm,0,0,0);p1=__builtin_amdgcn_mfma_f32_32x32x16_bf16(b1,qr[0],negm,0,0,0);}
    else{p0=__builtin_amdgcn_mfma_f32_32x32x16_bf16(b0,qr[d0],p0,0,0,0);p1=__builtin_amdgcn_mfma_f32_32x32x16_bf16(b1,qr[d0],p1,0,0,0);}}
}
typedef __attribute__((address_space(3))) const char* lds_cptr;
typedef short v4i16_t __attribute__((ext_vector_type(4)));
__device__ __forceinline__ void kload8(bf16x8*kf,lds_cptr kp){
  kf[0]=*(const __attribute__((address_space(3))) bf16x8*)(kp);      kf[1]=*(const __attribute__((address_space(3))) bf16x8*)(kp+512);
  kf[2]=*(const __attribute__((address_space(3))) bf16x8*)(kp+2048); kf[3]=*(const __attribute__((address_space(3))) bf16x8*)(kp+2560);
  kf[4]=*(const __attribute__((address_space(3))) bf16x8*)(kp+4096); kf[5]=*(const __attribute__((address_space(3))) bf16x8*)(kp+4608);
  kf[6]=*(const __attribute__((address_space(3))) bf16x8*)(kp+6144); kf[7]=*(const __attribute__((address_space(3))) bf16x8*)(kp+6656);
}
__device__ __forceinline__ void kload2(bf16x8*kf,lds_cptr kp,int j){ kf[2*j]=*(const __attribute__((address_space(3))) bf16x8*)(kp+j*2048); kf[2*j+1]=*(const __attribute__((address_space(3))) bf16x8*)(kp+j*2048+512); }
__device__ __forceinline__ s16x4 vtr(lds_cptr p){ return __builtin_bit_cast(s16x4,__builtin_amdgcn_ds_read_tr16_b64_v4i16((__attribute__((address_space(3))) v4i16_t*)p)); }
__device__ __forceinline__ float rowmax(const f32x16&p0,const f32x16&p1){
  float a=max3f(p0[0],p0[1],p1[0]),b=max3f(p0[2],p0[3],p1[1]);a=max3f(a,p1[2],p1[3]);
  #pragma unroll
  for(int r=4;r<16;r+=4){a=max3f(a,p0[r],p0[r+1]);b=max3f(b,p0[r+2],p0[r+3]);a=max3f(a,p1[r],p1[r+1]);b=max3f(b,p1[r+2],p1[r+3]);}
  const float m=max2f(a,b);
  auto rr=__builtin_amdgcn_permlane32_swap(__float_as_uint(m),__float_as_uint(m),false,false);
  return max2f(__uint_as_float(rr[0]),__uint_as_float(rr[1]));
}
__device__ __forceinline__ void pv(f32x16*o,int vb,bf16x8 pa0,bf16x8 pa1,bf16x8 pa2,bf16x8 pa3){
  #pragma unroll
  for(int d0=0;d0<2;++d0){s16x4 lo[4],hi[4];
    #pragma unroll
    for(int ks=0;ks<4;++ks){
      asm volatile("ds_read_b64_tr_b16 %0,%1 offset:%c2":"=&v"(lo[ks]):"v"(vb),"i"(d0*4096+ks*1024):"memory");
      asm volatile("ds_read_b64_tr_b16 %0,%1 offset:%c2":"=&v"(hi[ks]):"v"(vb),"i"(d0*4096+ks*1024+512):"memory");}
    asm volatile("s_waitcnt lgkmcnt(0)":::"memory");SBAR();
    #define PK(k) (bf16x8){lo[k][0],lo[k][1],lo[k][2],lo[k][3],hi[k][0],hi[k][1],hi[k][2],hi[k][3]}
    o[d0]=__builtin_amdgcn_mfma_f32_32x32x16_bf16(pa0,PK(0),o[d0],0,0,0);
    o[d0]=__builtin_amdgcn_mfma_f32_32x32x16_bf16(pa1,PK(1),o[d0],0,0,0);
    o[d0]=__builtin_amdgcn_mfma_f32_32x32x16_bf16(pa2,PK(2),o[d0],0,0,0);
    o[d0]=__builtin_amdgcn_mfma_f32_32x32x16_bf16(pa3,PK(3),o[d0],0,0,0);
    #undef PK
  }
}

#ifndef ATTN_STORE16
#define ATTN_STORE16(p,v) do{ unsigned long long* p8_=(unsigned long long*)(p); const u32x4 v_=(v); __hip_atomic_store(p8_,(unsigned long long)v_.x|((unsigned long long)v_.y<<32),__ATOMIC_RELAXED,__HIP_MEMORY_SCOPE_AGENT); __hip_atomic_store(p8_+1,(unsigned long long)v_.z|((unsigned long long)v_.w<<32),__ATOMIC_RELAXED,__HIP_MEMORY_SCOPE_AGENT); }while(0)
#endif
template<int THRL> __device__ __forceinline__ void attn_unit(long qrow0,long kvrow0,int h,int NT,const bf16*Q,const bf16*__restrict__ K,const bf16*__restrict__ V,bf16*O,char*shm){
  const int tid=otid(),lane=tid&63,r32=lane&31,hi=lane>>5; const int wid=__builtin_amdgcn_readfirstlane(tid>>6);
  const bf16*Qw=Q+(qrow0+wid*QBLK)*QP+h*D;
  const bf16*Kh=K+kvrow0*KP+(h>>2)*D,*Vh=V+kvrow0*KP+(h>>2)*D;
  const unsigned lds0=(unsigned)(uintptr_t)shm;
  float*wsf=(float*)(shm+LDS_WS)+wid*64;
  const bf16*ksrc=Kh+(long)lane*KP+wid*8;
  const bf16*vsrc=Vh+(long)(16*(wid&3)+(lane>>2))*KP+(wid>>2)*32+(lane&3)*8;
  const unsigned kdst=lds0+LDS_K+wid*1024, vdst=lds0+LDS_V+wid*1024;
  #define DMA_K(t,slot) glds16(ksrc+(long)(t)*KVBLK*KP,(unsigned)__builtin_amdgcn_readfirstlane(kdst+(slot)))
  #define DMA_V(t,slot) glds16(vsrc+(long)(t)*KVBLK*KP,(unsigned)__builtin_amdgcn_readfirstlane(vdst+(slot)))
  const int vb0=(int)(lds0+LDS_V)+((lane>>4)&1)*32+(lane&3)*8+(4*hi+((lane&15)>>2))*64;
  const char*Kbase=shm+LDS_K; bf16x8 kf[8];
  const lds_cptr shm3=(lds_cptr)shm; const lds_cptr kp0=shm3+LDS_K+hi*1024+r32*16; const lds_cptr vp0=shm3+LDS_V+((lane>>4)&1)*32+(lane&3)*8+(4*hi+((lane&15)>>2))*64;
  DMA_K(0,0);DMA_V(0,0);DMA_K(1,SLOTB);
  bf16x8 qr[4];
  #pragma unroll
  for(int d0=0;d0<4;++d0)qr[d0]=*reinterpret_cast<const bf16x8*>(&Qw[(long)r32*QP+d0*16+hi*8]);
  float mhat=0.f,l_reg=0.f;f32x16 o[2];o[0]=f32x16{};o[1]=f32x16{};f32x16 negm=f32x16{};asm volatile("":"+v"(negm));
  #define CMASK(P0,P1,t) do{}while(0)
  bool resc=false;
  #define START(P0,P1) do{ const float rm=rowmax(P0,P1); resc=false; \
    { const float dl=rm; mhat=fadd_s(mhat,dl); \
      _Pragma("unroll") for(int r=0;r<16;++r){P0[r]=fsub_s(P0[r],dl);P1[r]=fsub_s(P1[r],dl);} \
      _Pragma("unroll") for(int r=0;r<16;++r)negm[r]=-mhat; asm volatile("":"+v"(negm)); } \
    _Pragma("unroll") for(int r=0;r<16;++r)P0[r]=__builtin_amdgcn_exp2f(P0[r]); }while(0)
  #define RESC() do{ if(resc){ asm volatile("s_waitcnt lgkmcnt(0)":::"memory"); \
      _Pragma("unroll") for(int d_=0;d_<2;++d_) _Pragma("unroll") for(int r=0;r<16;++r)o[d_][r]*=wsf[crow(r,hi)]; } }while(0)
  f32x16 pA0,pA1,pB0,pB1;
  int sl_prev=0,sl_cur=0,sl_next=SLOTB;
  #define ROT() do{sl_prev=sl_cur;sl_cur=sl_next;sl_next=(sl_next==(NSLOT-1)*SLOTB)?0:sl_next+SLOTB;}while(0)
  DMA_K(2,2*SLOTB);
  WAIT_BAR(3);
  qkt(pA0,pA1,Kbase,qr,negm,r32,hi);asm volatile("s_nop 15\n\ts_nop 7":"+v"(pA0),"+v"(pA1));CMASK(pA0,pA1,0);
  START(pA0,pA1);
  _Pragma("unroll") for(int r=0;r<16;++r)pA1[r]=__builtin_amdgcn_exp2f(pA1[r]);
  WAIT_BAR(0);
  DMA_K(3,0);DMA_V(1,SLOTB);
  ROT();
  kload8(kf,kp0+sl_cur);
  WAIT_BAR(2);
  s16x4 vlo[8],vhi[8]; u32x4 pw0,pw1,pw2,pw3;
  #define PKW(P,B) cvtpk_s(P[B],P[B+1])
  #define PAF(k) __builtin_bit_cast(bf16x8,pw##k)
  #define VFR(i) (bf16x8){vlo[i][0],vlo[i][1],vlo[i][2],vlo[i][3],vhi[i][0],vhi[i][1],vhi[i][2],vhi[i][3]}
  #define PIN(x) asm volatile("":"+v"(x))
  #define MX3(a,b,c) __builtin_fmaxf(__builtin_fmaxf((a),(b)),(c))
  #define GAPA(MF,A0,A1,A2,A3,W0,W1,PW) do{ MF; sacc+=A0; sacc+=A1; sacc+=A2; sacc+=A3; PIN(sacc); W0; W1; PIN(PW); SBAR(); }while(0)
  #define EX(v) __builtin_amdgcn_exp2f(v)
  #define GAPB(MF,X,B) do{ MF; X[B]=EX(X[B]); X[B+1]=EX(X[B+1]); X[B+2]=EX(X[B+2]); X[B+3]=EX(X[B+3]); PIN(X); SBAR(); }while(0)
  #define VRD(i) do{ vlo[i]=vtr(vp_+(((i)>>2)*4096+((i)&3)*1024)); vhi[i]=vtr(vp_+(((i)>>2)*4096+((i)&3)*1024+512)); }while(0)
  #define KRD(G,j) do{ if(G){ kload2(kf,kp0+sl_next,j); SBAR(); } }while(0)
  #define STEP(C0,C1,P0,P1,t,GK,GV,GL) do{ SBAR(); \
    const lds_cptr vp_=vp0+sl_prev; \
    VRD(0); SBAR(); float sacc=(P0[0]+P0[1]); \
    GAPA(C0=__builtin_amdgcn_mfma_f32_32x32x16_bf16(kf[0],qr[0],negm,0,0,0), P0[2],P0[3],P0[4],P0[5],     pw0[0]=PKW(P0,0), pw0[1]=PKW(P0,2), pw0); \
    VRD(4); SBAR(); GAPA(C1=__builtin_amdgcn_mfma_f32_32x32x16_bf16(kf[1],qr[0],negm,0,0,0), P0[6],P0[7],P0[8],P0[9],     pw0[2]=PKW(P0,4), pw0[3]=PKW(P0,6), pw0); \
    VRD(1); SBAR(); GAPA(C0=__builtin_amdgcn_mfma_f32_32x32x16_bf16(kf[2],qr[1],C0,0,0,0),   P0[10],P0[11],P0[12],P0[13], pw1[0]=PKW(P0,8), pw1[1]=PKW(P0,10), pw1); \
    VRD(5); SBAR(); GAPA(C1=__builtin_amdgcn_mfma_f32_32x32x16_bf16(kf[3],qr[1],C1,0,0,0),   P0[14],P0[15],P1[0],P1[1],   pw1[2]=PKW(P0,12),pw1[3]=PKW(P0,14), pw1); \
    VRD(2); SBAR(); GAPA(C0=__builtin_amdgcn_mfma_f32_32x32x16_bf16(kf[4],qr[2],C0,0,0,0),   P1[2],P1[3],P1[4],P1[5],     pw2[0]=PKW(P1,0), pw2[1]=PKW(P1,2), pw2); \
    VRD(6); SBAR(); GAPA(C1=__builtin_amdgcn_mfma_f32_32x32x16_bf16(kf[5],qr[2],C1,0,0,0),   P1[6],P1[7],P1[8],P1[9],     pw2[2]=PKW(P1,4), pw2[3]=PKW(P1,6), pw2); \
    VRD(3); SBAR(); GAPA(C0=__builtin_amdgcn_mfma_f32_32x32x16_bf16(kf[6],qr[3],C0,0,0,0),   P1[10],P1[11],P1[12],P1[13], pw3[0]=PKW(P1,8), pw3[1]=PKW(P1,10), pw3); \
    VRD(7); SBAR(); GAPA(C1=__builtin_amdgcn_mfma_f32_32x32x16_bf16(kf[7],qr[3],C1,0,0,0),   P1[14],P1[15],0.f,0.f,       pw3[2]=PKW(P1,12),pw3[3]=PKW(P1,14), pw3); \
    l_reg+=sacc; \
    if(GK){DMA_K((t)+3,sl_cur);} if(GV){DMA_V((t)+1,sl_next);} \
    CMASK(C0,C1,t); \
    { float a=MX3(C0[0],C0[1],C1[0]),b=MX3(C0[2],C0[3],C1[1]); a=MX3(a,C1[2],C1[3]); \
      _Pragma("unroll") for(int r=4;r<16;r+=4){a=MX3(a,C0[r],C0[r+1]);b=MX3(b,C0[r+2],C0[r+3]);a=MX3(a,C1[r],C1[r+1]);b=MX3(b,C1[r+2],C1[r+3]);} \
      float rm=__builtin_fmaxf(a,b); { auto rr=__builtin_amdgcn_permlane32_swap(__float_as_uint(rm),__float_as_uint(rm),false,false); rm=__builtin_fmaxf(__uint_as_float(rr[0]),__uint_as_float(rr[1])); } \
      resc=false; \
      if(__builtin_expect(__any(rm>(float)THRL),0)){ const float dl=__builtin_fmaxf(rm,0.f); mhat+=dl; \
        _Pragma("unroll") for(int r=0;r<16;++r){C0[r]-=dl;C1[r]-=dl;} \
        _Pragma("unroll") for(int r=0;r<16;++r)negm[r]=-mhat; asm volatile("":"+v"(negm)); \
        const float f=__builtin_amdgcn_exp2f(-dl); l_reg*=f; if(hi==0)wsf[r32]=f; resc=true; } } \
    SBAR(); \
    GAPB(o[0]=__builtin_amdgcn_mfma_f32_32x32x16_bf16(PAF(0),VFR(0),o[0],0,0,0), C0,0); \
    GAPB(o[1]=__builtin_amdgcn_mfma_f32_32x32x16_bf16(PAF(0),VFR(4),o[1],0,0,0), C0,4); \
    KRD(GL,0); GAPB(o[0]=__builtin_amdgcn_mfma_f32_32x32x16_bf16(PAF(1),VFR(1),o[0],0,0,0), C0,8); \
    KRD(GL,1); GAPB(o[1]=__builtin_amdgcn_mfma_f32_32x32x16_bf16(PAF(1),VFR(5),o[1],0,0,0), C0,12); \
    KRD(GL,2); GAPB(o[0]=__builtin_amdgcn_mfma_f32_32x32x16_bf16(PAF(2),VFR(2),o[0],0,0,0), C1,0); \
    KRD(GL,3); GAPB(o[1]=__builtin_amdgcn_mfma_f32_32x32x16_bf16(PAF(2),VFR(6),o[1],0,0,0), C1,4); \
    GAPB(o[0]=__builtin_amdgcn_mfma_f32_32x32x16_bf16(PAF(3),VFR(3),o[0],0,0,0), C1,8); \
    GAPB(o[1]=__builtin_amdgcn_mfma_f32_32x32x16_bf16(PAF(3),VFR(7),o[1],0,0,0), C1,12); \
    }while(0)
  int t=1;
  #undef CMASK
  #define CMASK(P0,P1,t) do{}while(0)
  for(;t+5<NT;t+=2){
    STEP(pB0,pB1,pA0,pA1,t,true,true,true);     WAIT_BAR(2); RESC(); ROT();
    STEP(pA0,pA1,pB0,pB1,t+1,true,true,true);   WAIT_BAR(2); RESC(); ROT();
  }
  #undef CMASK
  #define CMASK(P0,P1,t) do{}while(0)
  #define ENDW(tt) do{ if((tt)+3<NT){WAIT_BAR(2);} else if((tt)+2<NT){WAIT_BAR(1);} else {WAIT_BAR(0);} }while(0)
  for(;t+1<NT;t+=2){
    STEP(pB0,pB1,pA0,pA1,t,(t+3<NT),(t+1<NT),(t+1<NT));       ENDW(t);   RESC(); ROT();
    STEP(pA0,pA1,pB0,pB1,t+1,(t+4<NT),(t+2<NT),(t+2<NT));     ENDW(t+1); RESC(); ROT();
  }
  STEP(pB0,pB1,pA0,pA1,NT-1,false,false,false); RESC();
  { float sacc=pB0[0]+pB0[1]; _Pragma("unroll") for(int r=2;r<16;++r)sacc+=pB0[r]; _Pragma("unroll") for(int r=0;r<16;++r)sacc+=pB1[r]; l_reg+=sacc;
    pw0=(u32x4){PKW(pB0,0),PKW(pB0,2),PKW(pB0,4),PKW(pB0,6)};pw1=(u32x4){PKW(pB0,8),PKW(pB0,10),PKW(pB0,12),PKW(pB0,14)};pw2=(u32x4){PKW(pB1,0),PKW(pB1,2),PKW(pB1,4),PKW(pB1,6)};pw3=(u32x4){PKW(pB1,8),PKW(pB1,10),PKW(pB1,12),PKW(pB1,14)};
    SBAR(); pv(o,vb0+sl_cur,PAF(0),PAF(1),PAF(2),PAF(3)); }
  #undef PKW
  #undef PAF
  #undef VFR
  #undef PIN
  #undef MX3
  #undef GAPA
  #undef GAPB
  #undef EX
  #undef VRD
  #undef KRD
  #undef STEP
  #undef ENDW
  {auto rr=__builtin_amdgcn_permlane32_swap(__float_as_uint(l_reg),__float_as_uint(l_reg),false,false);l_reg=__uint_as_float(rr[0])+__uint_as_float(rr[1]);}
  if(hi==0)wsf[32+r32]=l_reg;asm volatile("s_waitcnt lgkmcnt(0)":::"memory");
  float rli[16];
  #pragma unroll
  for(int r=0;r<16;++r)rli[r]=__builtin_amdgcn_rcpf(wsf[32+crow(r,hi)]);
  bf16*Ow=O+(qrow0+wid*QBLK)*QP+h*D;
  { bf16*stg=(bf16*)(shm+LDS_OST)+wid*2048;
    #pragma unroll
    for(int r=0;r<16;++r){const int orow=crow(r,hi);
      #pragma unroll
      for(int d0=0;d0<2;++d0)stg[orow*64+d0*32+r32]=__float2bfloat16(o[d0][r]*rli[r]);}
    asm volatile("s_waitcnt lgkmcnt(0)":::"memory");
    #pragma unroll
    for(int i=0;i<4;++i){const int row=i*8+(lane>>3),ch=lane&7; const u32x4 v=*(const u32x4*)(stg+row*64+ch*8); ATTN_STORE16(Ow+(long)row*QP+ch*8,v);} }
  asm volatile("s_waitcnt lgkmcnt(0)\n\ts_barrier":::"memory");
  #undef DMA_K
  #undef DMA_V
  #undef CMASK
  #undef START
  #undef RESC
  #undef ROT
}
constexpr int ATTN_LDS_BYTES=LDS_BYTES;
#undef SBAR
#undef WAIT_BAR
}
#define GAS __attribute__((address_space(1)))
#define LAS __attribute__((address_space(3)))
typedef unsigned short bf16;
typedef unsigned v4u __attribute__((ext_vector_type(4)));
typedef unsigned v2u __attribute__((ext_vector_type(2)));
typedef float f32x4 __attribute__((ext_vector_type(4)));
typedef short bf16x8 __attribute__((ext_vector_type(8)));

constexpr int NTOK = 17408, NLAT = 16384, DMOD = 1024, INC = 1280, DFF = 2816, DFF2 = 5632, DEPTH = 4;
constexpr int NSTAGE = 3, NPHASE = 3 + DEPTH * NSTAGE;
constexpr size_t MiB = 1u << 20;
constexpr size_t WS_CTL = 0, WS_MOD = 1 * MiB, WS_XC = 2 * MiB, WS_ROPE = 6 * MiB, WS_A16 = 7 * MiB;
constexpr size_t WS_WIN = 8 * MiB, WS_WGLU = 11 * MiB, WS_WOUT = 12 * MiB, WS_WUP = 14 * MiB, WS_WDN = 25 * MiB;
constexpr size_t WS_PFPR = 31 * MiB, WS_MTOT = 47 * MiB, WS_XN = 79 * MiB, WS_R = 113 * MiB;
constexpr size_t WS_PROJ = WS_R, WS_QO = WS_R + 43 * MiB, WS_KALL = WS_R + 60 * MiB, WS_VALL = WS_R + 65 * MiB, WS_Z = WS_R + 70 * MiB,
                 WS_SSMO = WS_R + 87 * MiB, WS_SSCR = WS_R + 104 * MiB, WS_HIN = WS_R + 138 * MiB, WS_O = WS_R + 155 * MiB;
constexpr size_t WS_HFFN = WS_R, WS_SIDE = WS_R + 94 * MiB, WS_XT2 = WS_R + 172 * MiB, WS_SSQ1 = WS_R + 206 * MiB, WS_SSQ2 = WS_R + 208 * MiB, WS_END = WS_R + 210 * MiB, WS_PART = WS_R + 104 * MiB;
constexpr size_t WS_CS = 1 * MiB + 512 * 1024, WS_BIASIN = 7 * MiB + 256 * 1024, WS_BIASUP = 7 * MiB + 512 * 1024;
constexpr int LDS_BYTES = 147456, QS_OFF = 135168;
#ifndef PHM
#define PHM 0xffff
#endif
#define PHON(k) ((PHM >> (k)) & 1)
#ifndef REP_STAGE
#define REP_STAGE -1
#endif
#ifndef REP_SYNC
#define REP_SYNC 0
#endif
constexpr float C2Q = 0.125f * 1.4426950408889634f;

struct Args { const float* in[27]; float* out; unsigned char* ws; int ph_lo, ph_hi, coop, pad; };

__device__ __forceinline__ unsigned pk2(float lo, float hi) { return pg8::cvt_pk_bf16(lo, hi); }
__device__ __forceinline__ float bflo(unsigned w) { return __uint_as_float(w << 16); }
__device__ __forceinline__ float bfhi(unsigned w) { return __uint_as_float(w & 0xffff0000u); }
__device__ __forceinline__ float wave_sum(float v) {
    v += shx<1>(v); v += shx<2>(v); v += shx<4>(v); v += shx<8>(v); v += shx<16>(v); v += shx<32>(v);
    return v;
}
__device__ __forceinline__ float silu_f(float x) { return x * __builtin_amdgcn_rcpf(1.0f + __builtin_amdgcn_exp2f(-1.4426950408889634f * x)); }
__device__ __forceinline__ float gelu_tanh(float y) { const float u = 0.7978845608028654f * (y + 0.044715f * y * y * y); return y * __builtin_amdgcn_rcpf(1.0f + __builtin_amdgcn_exp2f(-2.8853900817779268f * u)); }

__device__ __forceinline__ void transpose_item(const float* W, int K, int N, bf16* WT, LAS float* scr, int item, int lane, int rmap = 0) {
    const int nblk = N / 32, kb = item / nblk, nb = item % nblk, k0 = 64 * kb, n0 = 32 * nb;
    const int r0 = rmap == 2 ? (n0 >= 768 ? n0 : ((n0 >> 6) < 8 ? ((n0 >> 6) >> 2) * 256 + ((n0 >> 6) & 3) * 32 : 512 + ((n0 >> 6) - 8) * 32) + 128 * ((n0 >> 5) & 1)) : rmap == 0 ? n0 : (n0 < 2816 ? (n0 >> 7) * 256 + (n0 & 127) : ((n0 - 2816) >> 7) * 256 + 128 + ((n0 - 2816) & 127));
#pragma unroll 8
    for (int i = 0; i < 32; ++i) { const int kk = 2 * i + (lane >> 5); scr[kk * 33 + (lane & 31)] = __builtin_nontemporal_load(W + (size_t)(k0 + kk) * N + n0 + (lane & 31)); }
    asm volatile("s_waitcnt lgkmcnt(0)" ::: "memory");
    const int c = lane & 7;
#pragma unroll
    for (int j = 0; j < 4; ++j) { const int n = (lane >> 3) + 8 * j; const LAS float* s = scr + (8 * c) * 33 + n;
        v4u o; o.x = pk2(s[0 * 33], s[1 * 33]); o.y = pk2(s[2 * 33], s[3 * 33]); o.z = pk2(s[4 * 33], s[5 * 33]); o.w = pk2(s[6 * 33], s[7 * 33]);
        *(v4u*)(WT + (size_t)(r0 + n) * K + k0 + 8 * c) = o; }
    asm volatile("s_waitcnt lgkmcnt(0)" ::: "memory");
}

__device__ __forceinline__ float* xrow(float* xlat, float* xctx, int row) { return row < NLAT ? xlat + (size_t)row * DMOD : xctx + (size_t)(row - NLAT) * DMOD; }
__device__ __forceinline__ int modv(int row) { return row < NLAT ? (row >> 12) : 4; }

__device__ __forceinline__ void norm_row(const float* src, float* dstcopy, bf16* xn, const float* g, const float* shift, const float* scale, int lane) {
    const f32x4* xr = (const f32x4*)src + lane;
    f32x4 v[4]; float s = 0.f;
#pragma unroll
    for (int j = 0; j < 4; ++j) { v[j] = xr[64 * j]; s += (v[j].x * v[j].x + v[j].y * v[j].y) + (v[j].z * v[j].z + v[j].w * v[j].w); }
    if (dstcopy) {
#pragma unroll
        for (int j = 0; j < 4; ++j) ((f32x4*)dstcopy + lane)[64 * j] = v[j];
    }
    const float rstd = __builtin_amdgcn_rsqf(wave_sum(s) * (1.f / DMOD) + 1e-6f);
    unsigned long long* o8 = (unsigned long long*)xn + lane;
#pragma unroll
    for (int j = 0; j < 4; ++j) {
        const f32x4 gg = ((const f32x4*)g + lane)[64 * j], sh = ((const f32x4*)shift + lane)[64 * j], sc = ((const f32x4*)scale + lane)[64 * j];
        const f32x4 y = (v[j] * rstd) * gg * (sc + 1.0f) + sh;
        o8[64 * j] = (unsigned long long)pk2(y.x, y.y) | ((unsigned long long)pk2(y.z, y.w) << 32);
    }
}
__device__ __forceinline__ void ssm_tables(const Args& a, LAS unsigned char* lds, int layer, int g, int tid) {
    LAS float* pw = (LAS float*)lds;
    LAS float* bbs = pw + 4352;
    LAS float* cs = bbs + 4096;
    LAS float* G = cs + 4096;
    if (tid < 128) {
        const int dir = tid >> 6, n = tid & 63; const int gi = (layer * 2 + dir) * 32 + g; const int idx = gi * 64 + n;
        const float lr = a.in[10][idx], li = a.in[11][idx], dt = expf(a.in[12][gi]);
        for (int e = 0; e <= 16; ++e) { const float mag = expf(lr * dt * (float)e), ang = li * dt * (float)e;
            pw[((dir * 17 + e) * 64 + n) * 2] = mag * cosf(ang); pw[((dir * 17 + e) * 64 + n) * 2 + 1] = mag * sinf(ang); }
        const float mag1 = expf(lr * dt); const float are = mag1 * cosf(li * dt), aim = mag1 * sinf(li * dt), den = lr * lr + li * li;
        const float fre = ((are - 1.f) * lr + aim * li) / den, fim = (aim * lr - (are - 1.f) * li) / den;
        for (int q = 0; q < 16; ++q) { const float br = a.in[13][(size_t)idx * 16 + q], bi = a.in[14][(size_t)idx * 16 + q];
            bbs[((dir * 64 + n) * 16 + q) * 2] = fre * br - fim * bi; bbs[((dir * 64 + n) * 16 + q) * 2 + 1] = fre * bi + fim * br; }
    }
    for (int i = tid; i < 2048; i += 512) { const int dir = i >> 10, p = (i >> 6) & 15, n = i & 63; const size_t src = ((size_t)((layer * 2 + dir) * 32 + g) * 16 + p) * 64 + n;
        cs[2 * i] = a.in[15][src]; cs[2 * i + 1] = a.in[16][src]; }
    __syncthreads();
    for (int i = tid; i < 8192; i += 512) { const int dir = i >> 12, l = (i >> 8) & 15, p = (i >> 4) & 15, q = i & 15; float sum = 0.f;
        for (int n = 0; n < 64; ++n) { const float cr = cs[((dir * 16 + p) * 64 + n) * 2], ci = cs[((dir * 16 + p) * 64 + n) * 2 + 1];
            const float ar = pw[((dir * 17 + l) * 64 + n) * 2], ai = pw[((dir * 17 + l) * 64 + n) * 2 + 1];
            const float br = bbs[((dir * 64 + n) * 16 + q) * 2], bi = bbs[((dir * 64 + n) * 16 + q) * 2 + 1];
            const float zr = cr * ar - ci * ai, zi = cr * ai + ci * ar; sum += zr * br - zi * bi; }
        G[i] = sum; }
    __syncthreads();
    bf16* Mt = (bf16*)(a.ws + WS_MTOT) + (size_t)(layer * 32 + g) * 256 * 512;
    for (int i = tid; i < 16384; i += 512) { const int row = i >> 6, k0 = (i & 63) * 8, t = row >> 4, p = row & 15; float v[8];
        if (k0 < 256) { const int sp = k0 >> 4, q0 = k0 & 15;
#pragma unroll
            for (int jj = 0; jj < 8; ++jj) { const int q = q0 + jj; float x = 0.f;
                if (sp <= t) x += G[((0 * 16 + (t - sp)) * 16 + p) * 16 + q];
                if (sp >= t) x += G[((1 * 16 + (sp - t)) * 16 + p) * 16 + q];
                if (sp == t && p == q) x += a.in[17][(layer * 32 + g) * 16 + p];
                v[jj] = x; }
        } else {
#pragma unroll
            for (int jj = 0; jj < 8; ++jj) { const int nn = k0 - 256 + jj, dir = nn >> 7, comp = (nn >> 6) & 1, n = nn & 63, e = dir == 0 ? t + 1 : 16 - t;
                const float cr = cs[((dir * 16 + p) * 64 + n) * 2], ci = cs[((dir * 16 + p) * 64 + n) * 2 + 1];
                const float ar = pw[((dir * 17 + e) * 64 + n) * 2], ai = pw[((dir * 17 + e) * 64 + n) * 2 + 1];
                v[jj] = comp == 0 ? (cr * ar - ci * ai) : -(cr * ai + ci * ar); }
        }
        v4u o; o.x = pk2(v[0], v[1]); o.y = pk2(v[2], v[3]); o.z = pk2(v[4], v[5]); o.w = pk2(v[6], v[7]);
        *(v4u*)(Mt + (size_t)row * 512 + k0) = o; }
    bf16* Pf = (bf16*)(a.ws + WS_PFPR) + (size_t)(layer * 32 + g) * 256 * 256;
    for (int i = tid; i < 8192; i += 512) { const int nn = i >> 5, k0 = (i & 31) * 8, sp = k0 >> 4, q0 = k0 & 15, dir = nn >> 7, comp = (nn >> 6) & 1, n = nn & 63, e = dir == 0 ? 15 - sp : sp;
        const float ar = pw[((dir * 17 + e) * 64 + n) * 2], ai = pw[((dir * 17 + e) * 64 + n) * 2 + 1]; float v[8];
#pragma unroll
        for (int jj = 0; jj < 8; ++jj) { const float br = bbs[((dir * 64 + n) * 16 + q0 + jj) * 2], bi = bbs[((dir * 64 + n) * 16 + q0 + jj) * 2 + 1];
            v[jj] = comp == 0 ? (ar * br - ai * bi) : (ar * bi + ai * br); }
        v4u o; o.x = pk2(v[0], v[1]); o.y = pk2(v[2], v[3]); o.z = pk2(v[4], v[5]); o.w = pk2(v[6], v[7]);
        *(v4u*)(Pf + (size_t)nn * 256 + k0) = o; }
    if (tid < 128) { const int dir = tid >> 6, n = tid & 63; float* A16 = (float*)(a.ws + WS_A16);
        A16[(((layer * 32 + g) * 2 + dir) * 64 + n) * 2] = pw[((dir * 17 + 16) * 64 + n) * 2]; A16[(((layer * 32 + g) * 2 + dir) * 64 + n) * 2 + 1] = pw[((dir * 17 + 16) * 64 + n) * 2 + 1]; }
    __syncthreads();
}

__device__ __forceinline__ void gemv_item(const float* W, int N, int n0, const LAS float* sv, LAS float* red, float* out, int ostride, const float* badd, int tid) {
    typedef float f32x2 __attribute__((ext_vector_type(2)));
    const int lane = tid & 63, wave = tid >> 6; const float* Wp = W + (size_t)(wave * 128) * N + n0 + 2 * lane;
    float acc[5][2];
#pragma unroll
    for (int v = 0; v < 5; ++v) { acc[v][0] = 0.f; acc[v][1] = 0.f; }
    for (int k0 = 0; k0 < 128; k0 += 16) {
        f32x2 w[16];
#pragma unroll
        for (int j = 0; j < 16; ++j) w[j] = __builtin_nontemporal_load((const f32x2*)(Wp + (size_t)(k0 + j) * N));
#pragma unroll
        for (int j = 0; j < 16; ++j)
#pragma unroll
            for (int v = 0; v < 5; ++v) { const float sx = sv[v * 1024 + wave * 128 + k0 + j]; acc[v][0] += sx * w[j].x; acc[v][1] += sx * w[j].y; }
    }
#pragma unroll
    for (int v = 0; v < 5; ++v) { red[(wave * 5 + v) * 128 + 2 * lane] = acc[v][0]; red[(wave * 5 + v) * 128 + 2 * lane + 1] = acc[v][1]; }
    __syncthreads();
    for (int i = tid; i < 5 * 128; i += 512) { const int v = i >> 7, c = i & 127; float sum = badd ? badd[n0 + c] : 0.f;
#pragma unroll
        for (int w8 = 0; w8 < 8; ++w8) sum += red[(w8 * 5 + v) * 128 + c];
        out[(size_t)v * ostride + n0 + c] = sum; }
    __syncthreads();
}
__device__ __forceinline__ void p0_phase(const Args& a, LAS unsigned char* lds, int tid) {
    LAS float* sv = (LAS float*)lds;
    LAS float* red = sv + 5 * 1024;
    for (int i = tid; i < 5 * 1024; i += 512) { const int v = i >> 10, k = i & 1023; const float x = v < 4 ? a.in[1][v * 1024 + k] : a.in[3][k]; sv[i] = silu_f(x); }
    __syncthreads();
    float* mod = (float*)(a.ws + WS_MOD);
    const int G0 = ogrid(), half0 = G0 >= 256 ? 128 : 0;
    if (obid() < half0 || half0 == 0) { for (int it = obid(); it < DEPTH * 32; it += (half0 ? half0 : G0)) ssm_tables(a, lds + 49152, it >> 5, it & 31, tid); }
    for (int it = (half0 ? obid() - half0 : obid()); it >= 0 && it < DEPTH * 48; it += (half0 ? G0 - half0 : G0)) {
        const int l = it / 48, n0 = (it % 48) * 128;
        gemv_item(a.in[4] + (size_t)l * 1024 * 6144, 6144, n0, sv, red, mod + (size_t)l * 5 * 6144, 6144, a.in[5] + l * 6144, tid);
    }
    if (obid() == ogrid() - 1) {
        float* rt = (float*)(a.ws + WS_ROPE);
        for (int i = tid; i < 1024; i += 512) { const int p = i >> 4, f = i & 15; const float fr = powf(10000.0f, -(float)f / 16.0f); const float ang = (float)p * fr;
            rt[i] = cosf(ang); rt[1024 + i] = sinf(ang); }
    }
}

__device__ __forceinline__ void p1_phase(const Args& a, LAS unsigned char* lds, int tid) {
    LAS float* sv = (LAS float*)lds;
    LAS float* red = sv + 5 * 1024;
    const float* mod = (const float*)(a.ws + WS_MOD); float* cs = (float*)(a.ws + WS_CS);
    for (int i = obid() * 512 + tid; i < DEPTH * 2 * 5 * 1024; i += ogrid() * 512) { const int k = i & 1023, v = (i >> 10) % 5, which = (i / 5120) & 1, l = i / 10240;
        const float g = which == 0 ? a.in[6][l * 1024 + k] : a.in[22][l * 1024 + k]; cs[i] = g * (1.0f + mod[((size_t)l * 5 + v) * 6144 + (which == 0 ? 1024 : 4096) + k]); }
    for (int it = obid(); it < DEPTH * 54; it += ogrid()) {
        const int l = it / 54, r = it % 54; const bool up = r >= 10; const int n0 = (up ? r - 10 : r) * 128, N = up ? 5632 : 1280;
        for (int i = tid; i < 5 * 1024; i += 512) sv[i] = mod[((size_t)l * 5 + (i >> 10)) * 6144 + (up ? 3072 : 0) + (i & 1023)];
        __syncthreads();
        float* bo = up ? (float*)(a.ws + WS_BIASUP) + (size_t)l * 5 * 5632 : (float*)(a.ws + WS_BIASIN) + (size_t)l * 5 * 1280;
        gemv_item(up ? a.in[23] + (size_t)l * 1024 * 5632 : a.in[7] + (size_t)l * 1024 * 1280, N, n0, sv, red, bo, N, nullptr, tid);
    }
}

__device__ __forceinline__ void prep_row(const float* src, float* dstcopy, bf16* xt, const float* gnorm, const float* scl, float* ssq, int lane) {
    const f32x4* xr = (const f32x4*)src + lane; f32x4 v[4]; float s = 0.f;
#pragma unroll
    for (int j = 0; j < 4; ++j) { v[j] = xr[64 * j]; s += (v[j].x * v[j].x + v[j].y * v[j].y) + (v[j].z * v[j].z + v[j].w * v[j].w); }
#pragma unroll
    for (int j = 0; j < 4; ++j) ((f32x4*)dstcopy + lane)[64 * j] = v[j];
    s = wave_sum(s);
    if (lane < 16) ssq[lane] = lane == 0 ? s : 0.f;
    unsigned long long* o8 = (unsigned long long*)xt + lane;
#pragma unroll
    for (int j = 0; j < 4; ++j) { const f32x4 y = v[j] * (((const f32x4*)gnorm + lane)[64 * j] * (((const f32x4*)scl + lane)[64 * j] + 1.0f)); o8[64 * j] = (unsigned long long)pk2(y.x, y.y) | ((unsigned long long)pk2(y.z, y.w) << 32); }
}
__device__ __forceinline__ void transposes_range(const Args& a, LAS unsigned char* lds, int layer, int lo, int hi, int gw, int NGW, int lane, int wave) {
    LAS float* scr = (LAS float*)(lds + wave * 16384);
    constexpr int I_IN = 16 * 40, I_GLU = 8 * 16, I_OUT = 16 * 32, I_UP = 16 * 176;
    for (int it = lo + gw; it < hi; it += NGW) {
        int r = it;
        if (r < I_IN) { transpose_item(a.in[7] + (size_t)layer * 1024 * 1280, 1024, 1280, (bf16*)(a.ws + WS_WIN), scr, r, lane, 2); continue; } r -= I_IN;
        if (r < I_GLU) { transpose_item(a.in[18] + (size_t)layer * 512 * 512, 512, 512, (bf16*)(a.ws + WS_WGLU), scr, r, lane); continue; } r -= I_GLU;
        if (r < I_OUT) { transpose_item(a.in[21] + (size_t)layer * 1024 * 1024, 1024, 1024, (bf16*)(a.ws + WS_WOUT), scr, r, lane); continue; } r -= I_OUT;
        if (r < I_UP) { transpose_item(a.in[23] + (size_t)layer * 1024 * 5632, 1024, 5632, (bf16*)(a.ws + WS_WUP), scr, r, lane, 1); continue; } r -= I_UP;
        transpose_item(a.in[26] + (size_t)layer * 2816 * 1024, 2816, 1024, (bf16*)(a.ws + WS_WDN), scr, r, lane);
    }
}
__device__ __forceinline__ void combine_row(const Args& a, int layer, int r, int lane) {
    float* xc = (float*)(a.ws + WS_XC); bf16* xn = (bf16*)(a.ws + WS_XN) + (size_t)NLAT * DMOD; float* ssq = (float*)(a.ws + WS_SSQ1) + (size_t)NLAT * 16;
    const float* csv = (const float*)(a.ws + WS_CS) + ((size_t)(layer * 2) * 5 + 4) * 1024; const float* gate = (const float*)(a.ws + WS_MOD) + ((size_t)(layer - 1) * 5 + 4) * 6144 + 5120;
    const float* P = (const float*)(a.ws + WS_PART);
    float s = 0.f;
#pragma unroll
    for (int j = 0; j < 4; ++j) { const int col = 4 * lane + 256 * j; f32x4 p = *(const f32x4*)(P + (size_t)r * 1024 + col);
#pragma unroll
        for (int ks = 1; ks < 11; ++ks) p = p + *(const f32x4*)(P + ((size_t)ks * 1024 + r) * 1024 + col);
        f32x4 x = *(const f32x4*)(xc + (size_t)r * 1024 + col) + *(const f32x4*)(gate + col) * p; *(f32x4*)(xc + (size_t)r * 1024 + col) = x;
        s += (x.x * x.x + x.y * x.y) + (x.z * x.z + x.w * x.w); const f32x4 y = x * *(const f32x4*)(csv + col);
        *(unsigned long long*)(xn + (size_t)r * 1024 + col) = (unsigned long long)pk2(y.x, y.y) | ((unsigned long long)pk2(y.z, y.w) << 32); }
    s = wave_sum(s);
    if (lane < 16) ssq[(size_t)r * 16 + lane] = lane == 0 ? s : 0.f;
}
__device__ __forceinline__ void prep_phase(const Args& a, LAS unsigned char* lds, int layer, int tid, int lane, int wave) {
    const int gw = obid() * 8 + wave, NGW = ogrid() * 8;
    transposes_range(a, lds, layer, 0, 5504, gw, NGW, lane, wave);
    float* xc = (float*)(a.ws + WS_XC); bf16* xn = (bf16*)(a.ws + WS_XN); float* ssq = (float*)(a.ws + WS_SSQ1);
    for (int row = gw; row < NTOK; row += NGW) {
        const float* src = row < NLAT ? a.in[0] + (size_t)row * DMOD : a.in[2] + (size_t)(row - NLAT) * DMOD;
        prep_row(src, xrow(a.out, xc, row), xn + (size_t)row * DMOD, a.in[6], (const float*)(a.ws + WS_MOD) + (size_t)modv(row) * 6144 + 1024, ssq + (size_t)row * 16, lane);
    }
}

__device__ __forceinline__ int tokrow(int b, int c) { return c < 16 ? NLAT + b * 256 + 16 * c : b * 4096 + 16 * (c - 16); }
__device__ __forceinline__ void ssm_unit(const Args& a, LAS unsigned char* lds3, int layer, int b, int g) {
    const int tid = otid(), lane = tid & 63, wave = __builtin_amdgcn_readfirstlane(tid >> 6);
    const bf16* proj = (const bf16*)(a.ws + WS_PROJ) + 16 * g;
    const bf16* Pf = (const bf16*)(a.ws + WS_PFPR) + (size_t)(layer * 32 + g) * 256 * 256;
    const bf16* Mt = (const bf16*)(a.ws + WS_MTOT) + (size_t)(layer * 32 + g) * 256 * 512;
    const int unit = b * 32 + g;
    float* Sscr = (float*)(a.ws + WS_SSCR) + (size_t)unit * 272 * 256;
    bf16* Hin = (bf16*)(a.ws + WS_HIN) + (size_t)unit * 272 * 256;
    bf16* Z = (bf16*)(a.ws + WS_Z);
    const int i = lane & 15, kb = lane >> 4, sp_lo = kb >> 1, q0 = 8 * (kb & 1);
    const int lr = tid >> 5, lp = tid & 31;
    LAS unsigned char* ubuf = lds3;
    LAS unsigned char* hbuf = lds3 + 2 * 8448;
    {
        bf16x8 pf[2][8];
#pragma unroll
        for (int j = 0; j < 2; ++j)
#pragma unroll
            for (int ks = 0; ks < 8; ++ks) pf[j][ks] = *(const bf16x8*)(Pf + (size_t)(32 * wave + 16 * j + i) * 256 + 32 * ks + 8 * kb);
        v4u nx = *(const v4u*)(proj + ((size_t)tokrow(b, lr) + (lp >> 1)) * 512 + 8 * (lp & 1));
        for (int mt = 0; mt < 17; ++mt) {
            LAS unsigned char* ub = ubuf + (mt & 1) * 8448;
            *(LAS v4u*)(ub + lr * 528 + lp * 16) = nx;
            { const int mtn = mt < 16 ? mt + 1 : 16; nx = *(const v4u*)(proj + ((size_t)tokrow(b, 16 * mtn + lr) + (lp >> 1)) * 512 + 8 * (lp & 1)); }
            __syncthreads();
            pg8::f32x4 acc0 = {0.f, 0.f, 0.f, 0.f}, acc1 = {0.f, 0.f, 0.f, 0.f};
#pragma unroll
            for (int ks = 0; ks < 8; ++ks) { const bf16x8 af = *(const LAS bf16x8*)(ub + i * 528 + (32 * ks + 8 * kb) * 2);
                acc0 = __builtin_amdgcn_mfma_f32_16x16x32_bf16(af, pf[0][ks], acc0, 0, 0, 0); acc1 = __builtin_amdgcn_mfma_f32_16x16x32_bf16(af, pf[1][ks], acc1, 0, 0, 0); }
#pragma unroll
            for (int r = 0; r < 4; ++r) { float* sp = Sscr + (size_t)(16 * mt + 4 * kb + r) * 256 + 32 * wave + i; sp[0] = acc0[r]; sp[16] = acc1[r]; }
        }
    }
    __syncthreads();
    if (wave < 2) {
        const int dir = wave, n = lane; const float* A16 = (const float*)(a.ws + WS_A16) + (((layer * 32 + g) * 2 + dir) * 64 + n) * 2;
        const float ar = A16[0], ai = A16[1]; float hr = 0.f, hi = 0.f;
        const float* sb = Sscr + dir * 128 + n; bf16* hb = Hin + dir * 128 + n;
        float sr[16], si[16], tr[16], ti[16];
#pragma unroll
        for (int j = 0; j < 16; ++j) { const int c = dir == 0 ? j : 15 - j; sr[j] = sb[(size_t)c * 256]; si[j] = sb[(size_t)c * 256 + 64]; }
        for (int s0 = 0; s0 < 272; s0 += 16) {
            const int s1 = s0 + 16 < 272 ? s0 + 16 : s0;
#pragma unroll
            for (int j = 0; j < 16; ++j) { const int st = s1 + j; const int c = dir == 0 ? st : (st < 16 ? 15 - st : 287 - st); tr[j] = sb[(size_t)c * 256]; ti[j] = sb[(size_t)c * 256 + 64]; }
#pragma unroll
            for (int j = 0; j < 16; ++j) { const int st = s0 + j; const int c = dir == 0 ? st : (st < 16 ? 15 - st : 287 - st);
                hb[(size_t)c * 256] = (bf16)(pk2(hr, 0.f) & 0xffffu); hb[(size_t)c * 256 + 64] = (bf16)(pk2(hi, 0.f) & 0xffffu);
                const float nr = ar * hr - ai * hi + sr[j], ni = ar * hi + ai * hr + si[j]; hr = nr; hi = ni; }
#pragma unroll
            for (int j = 0; j < 16; ++j) { sr[j] = tr[j]; si[j] = ti[j]; }
        }
    }
    __syncthreads();
    {
        bf16x8 mf[2][16];
#pragma unroll
        for (int j = 0; j < 2; ++j)
#pragma unroll
            for (int ks = 0; ks < 16; ++ks) mf[j][ks] = *(const bf16x8*)(Mt + (size_t)(32 * wave + 16 * j + i) * 512 + 32 * ks + 8 * kb);
        v4u nx = *(const v4u*)(proj + ((size_t)tokrow(b, lr) + (lp >> 1)) * 512 + 8 * (lp & 1));
        v4u nh = *(const v4u*)(Hin + (size_t)lr * 256 + 8 * lp);
        for (int mt = 0; mt < 17; ++mt) {
            LAS unsigned char* ub = ubuf + (mt & 1) * 8448; LAS unsigned char* hb2 = hbuf + (mt & 1) * 8448;
            *(LAS v4u*)(ub + lr * 528 + lp * 16) = nx; *(LAS v4u*)(hb2 + lr * 528 + lp * 16) = nh;
            { const int mtn = mt < 16 ? mt + 1 : 16; nx = *(const v4u*)(proj + ((size_t)tokrow(b, 16 * mtn + lr) + (lp >> 1)) * 512 + 8 * (lp & 1));
              nh = *(const v4u*)(Hin + (size_t)(16 * mtn + lr) * 256 + 8 * lp); }
            __syncthreads();
            const size_t rb = (size_t)tokrow(b, 16 * mt + i);
            pg8::f32x4 acc0 = {0.f, 0.f, 0.f, 0.f}, acc1 = {0.f, 0.f, 0.f, 0.f};
#pragma unroll
            for (int ks = 0; ks < 16; ++ks) { const bf16x8 af = ks < 8 ? *(const LAS bf16x8*)(ub + i * 528 + (32 * ks + 8 * kb) * 2) : *(const LAS bf16x8*)(hb2 + i * 528 + (32 * (ks - 8) + 8 * kb) * 2);
                acc0 = __builtin_amdgcn_mfma_f32_16x16x32_bf16(mf[0][ks], af, acc0, 0, 0, 0); acc1 = __builtin_amdgcn_mfma_f32_16x16x32_bf16(mf[1][ks], af, acc1, 0, 0, 0); }
            bf16* zp = Z + (rb + 2 * wave) * 512 + 16 * g + 4 * kb;
            { v2u o; o.x = pk2(gelu_tanh(acc0[0]), gelu_tanh(acc0[1])); o.y = pk2(gelu_tanh(acc0[2]), gelu_tanh(acc0[3])); *(v2u*)zp = o; }
            { v2u o; o.x = pk2(gelu_tanh(acc1[0]), gelu_tanh(acc1[1])); o.y = pk2(gelu_tanh(acc1[2]), gelu_tanh(acc1[3])); *(v2u*)(zp + 512) = o; }
        }
    }
    __syncthreads();
}

__device__ __forceinline__ void merge_rows(const Args& a, int layer, int lane, int gw, int NGW, int row_lo, int nrows) {
    const bf16* qo = (const bf16*)(a.ws + WS_O); const bf16* so = (const bf16*)(a.ws + WS_SSMO); bf16* xn = (bf16*)(a.ws + WS_XN);
    const float* gn = a.in[20] + layer * 1024;
    for (int row = row_lo + gw; row < nrows; row += NGW) {
#pragma unroll
        for (int h = 0; h < 2; ++h) {
            const v4u w = *(const v4u*)((h == 0 ? qo : so) + (size_t)row * 512 + 8 * lane);
            float v[8] = {bflo(w.x), bfhi(w.x), bflo(w.y), bfhi(w.y), bflo(w.z), bfhi(w.z), bflo(w.w), bfhi(w.w)};
            float s = 0.f;
#pragma unroll
            for (int k = 0; k < 8; ++k) s += v[k] * v[k];
            const float rstd = __builtin_amdgcn_rsqf(wave_sum(s) * (1.f / 512.f) + 1e-6f);
            const float* gp = gn + h * 512 + 8 * lane;
            v4u o; o.x = pk2(v[0] * rstd * gp[0], v[1] * rstd * gp[1]); o.y = pk2(v[2] * rstd * gp[2], v[3] * rstd * gp[3]);
            o.z = pk2(v[4] * rstd * gp[4], v[5] * rstd * gp[5]); o.w = pk2(v[6] * rstd * gp[6], v[7] * rstd * gp[7]);
            *(v4u*)(xn + (size_t)row * 1024 + h * 512 + 8 * lane) = o;
        }
    }
}

__device__ __forceinline__ void fix_phase(const Args& a, int layer, int tid) {
    bf16* hf = (bf16*)(a.ws + WS_HFFN); const float* side = (const float*)(a.ws + WS_SIDE);
    const float* cw = a.in[24] + (size_t)layer * 3 * DFF2;
    for (int it = obid() * 512 + tid; it < 60 * 2 * 704; it += ogrid() * 512) {
        const int c = (it % 704) * 4, r = it / 704, kind = r & 1, bi = r >> 1, pm = (bi / 15) * 16 + (bi % 15) + 1;
        pg8::f32x4 oa, og; size_t row;
        if (kind == 0) { const float* pf = side + ((size_t)pm * 4 + 1) * 5632; const float* rl = side + ((size_t)(pm - 1) * 4 + 2) * 5632; row = (size_t)pm * 256;
            oa = *(const pg8::f32x4*)(pf + c) + *(const pg8::f32x4*)(cw + c) * *(const pg8::f32x4*)(rl + c);
            og = *(const pg8::f32x4*)(pf + 2816 + c) + *(const pg8::f32x4*)(cw + 2816 + c) * *(const pg8::f32x4*)(rl + 2816 + c); }
        else { const float* pl = side + ((size_t)(pm - 1) * 4 + 3) * 5632; const float* rf = side + ((size_t)pm * 4 + 0) * 5632; row = (size_t)pm * 256 - 1;
            oa = *(const pg8::f32x4*)(pl + c) + *(const pg8::f32x4*)(cw + 2 * 5632 + c) * *(const pg8::f32x4*)(rf + c);
            og = *(const pg8::f32x4*)(pl + 2816 + c) + *(const pg8::f32x4*)(cw + 2 * 5632 + 2816 + c) * *(const pg8::f32x4*)(rf + 2816 + c); }
        v2u o; o.x = pk2(silu_f(og[0]) * oa[0], silu_f(og[1]) * oa[1]); o.y = pk2(silu_f(og[2]) * oa[2], silu_f(og[3]) * oa[3]);
        *(v2u*)(hf + row * DFF + c) = o;
    }
}

__device__ __forceinline__ void fix_tile(const Args& a, int layer, int pm, int tid) {
    bf16* hf = (bf16*)(a.ws + WS_HFFN); const float* side = (const float*)(a.ws + WS_SIDE);
    const float* cw = a.in[24] + (size_t)layer * 3 * DFF2;
    for (int it = tid; it < 2 * 704; it += 512) {
        const int c = (it % 704) * 4, kind = it / 704;
        if (kind == 0 ? (pm & 15) == 0 : (pm & 15) == 15) continue;
        pg8::f32x4 oa, og; size_t row;
        if (kind == 0) { const float* pf = side + ((size_t)pm * 4 + 1) * 5632; const float* rl = side + ((size_t)(pm - 1) * 4 + 2) * 5632; row = (size_t)pm * 256;
            oa = *(const pg8::f32x4*)(pf + c) + *(const pg8::f32x4*)(cw + c) * *(const pg8::f32x4*)(rl + c);
            og = *(const pg8::f32x4*)(pf + 2816 + c) + *(const pg8::f32x4*)(cw + 2816 + c) * *(const pg8::f32x4*)(rl + 2816 + c); }
        else { const float* pl = side + ((size_t)pm * 4 + 3) * 5632; const float* rf = side + ((size_t)(pm + 1) * 4 + 0) * 5632; row = (size_t)pm * 256 + 255;
            oa = *(const pg8::f32x4*)(pl + c) + *(const pg8::f32x4*)(cw + 2 * 5632 + c) * *(const pg8::f32x4*)(rf + c);
            og = *(const pg8::f32x4*)(pl + 2816 + c) + *(const pg8::f32x4*)(cw + 2 * 5632 + 2816 + c) * *(const pg8::f32x4*)(rf + 2816 + c); }
        v2u o; o.x = pk2(silu_f(og[0]) * oa[0], silu_f(og[1]) * oa[1]); o.y = pk2(silu_f(og[2]) * oa[2], silu_f(og[3]) * oa[3]);
        *(v2u*)(hf + row * DFF + c) = o;
    }
    asm volatile("s_waitcnt vmcnt(0)" ::: "memory"); __syncthreads();
}

#define RLX_AGENT __ATOMIC_RELAXED, __HIP_MEMORY_SCOPE_AGENT
#define XB_TMO      128
#define XB_XCNT(j)  (256  + 64 * (j))
#define XB_XSUB(j)  (1280 + 64 * (j))
#define XB_XGEN(j)  (2304 + 64 * (j))
#define XB_TOP      3328
#define XB_TOPGEN   3392
#define XCD_BAR_WORDS 3456
#define XB_SPIN_CAP (1u << 18)

__device__ __forceinline__ unsigned xb_ld(unsigned* p)              { return __hip_atomic_load(p, __ATOMIC_RELAXED, __HIP_MEMORY_SCOPE_AGENT); }
__device__ __forceinline__ unsigned xb_add(unsigned* p, unsigned v) { return __hip_atomic_fetch_add(p, v, __ATOMIC_RELAXED, __HIP_MEMORY_SCOPE_AGENT); }
__device__ __forceinline__ unsigned xb_xcc_id() { return (unsigned)__builtin_amdgcn_s_getreg((3 << 11) | 20) & 0xFu; }
#define XB_SPIN(cond, bar) do { unsigned _sp = 0; while (cond) { __builtin_amdgcn_s_sleep(1); \
    if ((++_sp & 255u) == 0u) { if (xb_ld(&(bar)[XB_TMO])) break; if (_sp > XB_SPIN_CAP) { atomicAdd(&(bar)[XB_TMO], 1u); break; } } } } while (0)

struct XcdBarrier {
    unsigned* bar; unsigned x;
    volatile LAS unsigned* st;
};

__device__ __forceinline__ XcdBarrier xcd_barrier_post(unsigned* bar, volatile LAS unsigned* st) {
    XcdBarrier b; b.bar = bar; b.x = xb_xcc_id(); b.st = st;
    if (otid() == 0) (void)xb_add(&bar[XB_XCNT(b.x)], 1u);
    return b;
}
__device__ __forceinline__ void xcd_barrier_complete(unsigned* bar, unsigned x, unsigned& nloc, unsigned& nx) {
    const unsigned G = (unsigned)ogrid();
    unsigned sum, cnt, mine, sp = 0u;
    for (;;) {
        sum = 0u; cnt = 0u; mine = 0u;
#pragma unroll
        for (unsigned j = 0; j < 16; ++j) { const unsigned c = xb_ld(&bar[XB_XCNT(j)]); sum += c; cnt += (c > 0u) ? 1u : 0u; mine = (j == x) ? c : mine; }
        if (sum == G) break;
        __builtin_amdgcn_s_sleep(1);
        if ((++sp & 255u) == 0u) { if (xb_ld(&bar[XB_TMO])) break; if (sp > XB_SPIN_CAP) { atomicAdd(&bar[XB_TMO], 1u); break; } }
    }
    nloc = mine > 0u ? mine : 1u; nx = cnt > 0u ? cnt : 1u;
}

__device__ __forceinline__ void xcd_barrier(const XcdBarrier& b) {
    asm volatile("s_waitcnt vmcnt(0)" ::: "memory");
    __syncthreads();
    if (otid() == 0) {
        unsigned* bar = b.bar;
        __builtin_amdgcn_s_waitcnt(0);
        unsigned nloc = b.st[0], nx = b.st[1];
        if (nloc == 0u) { xcd_barrier_complete(bar, b.x, nloc, nx); b.st[0] = nloc; b.st[1] = nx; }
        const unsigned old = xb_add(&bar[XB_XSUB(b.x)], 1u);
        const unsigned gen = old / nloc;
        if (old + 1u == (gen + 1u) * nloc) {
            __builtin_amdgcn_fence(__ATOMIC_RELEASE, "agent");
            asm volatile("s_waitcnt vmcnt(0)" ::: "memory");
            const unsigned og = xb_add(&bar[XB_TOP], 1u);
            const unsigned tg = og / nx;
            if (og + 1u == (tg + 1u) * nx) xb_add(&bar[XB_TOPGEN], 1u);
            else XB_SPIN(xb_ld(&bar[XB_TOPGEN]) == tg, bar);
            __builtin_amdgcn_fence(__ATOMIC_ACQUIRE, "agent");
            xb_add(&bar[XB_XGEN(b.x)], 1u);
            asm volatile("s_waitcnt vmcnt(0)" ::: "memory");
        } else {
            XB_SPIN(xb_ld(&bar[XB_XGEN(b.x)]) == gen, bar);
            __builtin_amdgcn_fence(__ATOMIC_ACQUIRE, "agent");
            asm volatile("s_waitcnt vmcnt(0)" ::: "memory");
        }
    }
    __syncthreads();
}

__device__ __forceinline__ void merge_rows8(const Args& a, int layer, int lane, int row0) {
    const bf16* qo = (const bf16*)(a.ws + WS_O); const bf16* so = (const bf16*)(a.ws + WS_SSMO); bf16* xn = (bf16*)(a.ws + WS_XN);
    const float* gn = a.in[20] + layer * 1024;
    v4u w[8][2];
#pragma unroll
    for (int r = 0; r < 8; ++r) { w[r][0] = *(const v4u*)(qo + (size_t)(row0 + r) * 512 + 8 * lane); w[r][1] = *(const v4u*)(so + (size_t)(row0 + r) * 512 + 8 * lane); }
    float g[2][8];
#pragma unroll
    for (int h = 0; h < 2; ++h)
#pragma unroll
        for (int k = 0; k < 8; ++k) g[h][k] = gn[h * 512 + 8 * lane + k];
#pragma unroll
    for (int r = 0; r < 8; ++r)
#pragma unroll
        for (int h = 0; h < 2; ++h) { const v4u ww = w[r][h];
            const float v[8] = {bflo(ww.x), bfhi(ww.x), bflo(ww.y), bfhi(ww.y), bflo(ww.z), bfhi(ww.z), bflo(ww.w), bfhi(ww.w)};
            float s = 0.f;
#pragma unroll
            for (int k = 0; k < 8; ++k) s += v[k] * v[k];
            const float rstd = __builtin_amdgcn_rsqf(wave_sum(s) * (1.f / 512.f) + 1e-6f);
            v4u o; o.x = pk2(v[0] * rstd * g[h][0], v[1] * rstd * g[h][1]); o.y = pk2(v[2] * rstd * g[h][2], v[3] * rstd * g[h][3]);
            o.z = pk2(v[4] * rstd * g[h][4], v[5] * rstd * g[h][5]); o.w = pk2(v[6] * rstd * g[h][6], v[7] * rstd * g[h][7]);
            *(v4u*)(xn + (size_t)(row0 + r) * 1024 + h * 512 + 8 * lane) = o; }
}
__device__ __forceinline__ void publish(unsigned* word) {
    asm volatile("s_waitcnt vmcnt(0)" ::: "memory"); __syncthreads();
    if (otid() == 0) { __builtin_amdgcn_fence(__ATOMIC_RELEASE, "agent"); asm volatile("s_waitcnt vmcnt(0)" ::: "memory"); __hip_atomic_fetch_add(word, 1u, __ATOMIC_RELAXED, __HIP_MEMORY_SCOPE_AGENT); }
}
__device__ __forceinline__ void publish_wt(unsigned* word) {
    asm volatile("s_waitcnt vmcnt(0)" ::: "memory"); __syncthreads();
    if (otid() == 0) __hip_atomic_fetch_add(word, 1u, __ATOMIC_RELAXED, __HIP_MEMORY_SCOPE_AGENT);
}
__device__ __forceinline__ void await(unsigned* word, unsigned target) {
    if (otid() == 0) { unsigned sp = 0; while (__hip_atomic_load(word, __ATOMIC_RELAXED, __HIP_MEMORY_SCOPE_AGENT) < target) { __builtin_amdgcn_s_sleep(80); if (++sp > (1u << 22)) break; }
        __builtin_amdgcn_fence(__ATOMIC_ACQUIRE, "agent"); asm volatile("s_waitcnt vmcnt(0)" ::: "memory"); }
    __syncthreads();
}
__device__ __forceinline__ void mix_phase(const Args& a, unsigned char* lds, int layer, bool ctx_out, int tid, int lane, int wave) {
    unsigned* ctr = (unsigned*)(a.ws + WS_CTL) + 8192 + (size_t)layer * 512;
    volatile LAS unsigned* qs = (volatile LAS unsigned*)((LAS unsigned char*)lds + QS_OFF);
    const int L3 = layer & 3, nmt = ctx_out ? 68 : 64; const int NCMB = L3 > 0 ? 64 : 0, NDN = L3 > 0 ? 528 : 0; const int NIN = 340;
    const int nattn = 640 + (ctx_out ? 32 : 0), i_glu = nattn, i_mrg = i_glu + 2 * nmt, nitems = i_mrg + 8 * nmt;
    const attn_body::bf16* qo = (const attn_body::bf16*)(a.ws + WS_QO); const attn_body::bf16* kall = (const attn_body::bf16*)(a.ws + WS_KALL); const attn_body::bf16* vall = (const attn_body::bf16*)(a.ws + WS_VALL);
    for (;;) {
        __syncthreads();
        if (otid() == 0) qs[0] = atomicAdd(ctr, 1u);
        __syncthreads();
        const int itq = __builtin_amdgcn_readfirstlane((int)qs[0]);
        if (itq >= NCMB + nitems + NIN + NDN) break;
        if (itq < NCMB) {
            const int t2 = otid(), w2 = __builtin_amdgcn_readfirstlane(t2 >> 6);
            for (int k = 0; k < 2; ++k) combine_row(a, L3, itq * 16 + w2 * 2 + k, t2 & 63);
            publish(ctr + 452); continue; }
        if (itq >= NCMB + nitems + NIN) {
            const int t2 = otid(), w2 = __builtin_amdgcn_readfirstlane(t2 >> 6), j = itq - (NCMB + nitems + NIN);
            transposes_range(a, (LAS unsigned char*)lds, L3, 1280 + j * 8, 1280 + j * 8 + 8, w2, 8, t2 & 63, w2); __syncthreads(); continue; }
        const int it0 = itq - NCMB;
        if (it0 < NIN) { const int b = it0 / 85, r = it0 % 85, t = r / 5, pn = r % 5, pm = t < 16 ? 16 * b + t : 64 + b;
            pg8::Gemm g{(const bf16*)(a.ws + WS_XN), (const bf16*)(a.ws + WS_WIN), NTOK, INC, 1024, 1024}; pg8::OneUnit S{pm, pn};
            pg8::EpiIn E{(bf16*)(a.ws + WS_QO), (bf16*)(a.ws + WS_KALL), (bf16*)(a.ws + WS_VALL), (bf16*)(a.ws + WS_PROJ), a.in[8] + L3 * 64, a.in[9] + L3 * 64, (const float*)(a.ws + WS_ROPE),
                          (const float*)(a.ws + WS_SSQ1), (const float*)(a.ws + WS_BIASIN) + (size_t)L3 * 5 * 1280};
            if (NCMB && t == 16) await(ctr + 452, 64u);
            pg8::gemm_phase<pg8::EpiIn, pg8::OneUnit, true, true>((LAS unsigned char*)lds, g, S, E); publish(ctr + 448 + b); continue; }
        const int it = it0 - NIN;
        if (it < 128) { await(ctr + 448 + (it >> 5), 85u); ssm_unit(a, (LAS unsigned char*)lds, L3, it >> 5, it & 31); publish(ctr + 64); }
        else if (it < 640) { const int r = it - 128, hq = r & 3, qb = (r >> 2) & 15, bk = r >> 6, b = bk >> 1, h = (bk & 1) * 4 + hq;
            await(ctr + 448 + b, 85u);
            attn_body::attn_unit<8>((long)b * 4096 + qb * 256, (long)b * 4352, h, 68, qo, kall, vall, (attn_body::bf16*)(a.ws + WS_O), (char*)lds); publish_wt(ctr + 128 + b * 16 + qb); }
        else if (it < nattn) { const int r = it - 640, b = r >> 3, h = r & 7;
            await(ctr + 448 + b, 85u);
            attn_body::attn_unit<8>((long)NLAT + b * 256, (long)b * 4352, h, 4, qo, kall, vall, (attn_body::bf16*)(a.ws + WS_O), (char*)lds); publish_wt(ctr + 128 + 64 + b); }
        else if (it < i_mrg) {
            const int r = it - i_glu; await(ctr + 64, 128u);
            pg8::Gemm g{(const bf16*)(a.ws + WS_Z), (const bf16*)(a.ws + WS_WGLU), NTOK, 512, 512, 512}; pg8::OneUnit S{r >> 1, r & 1};
            pg8::EpiGlu E{(const bf16*)(a.ws + WS_Z), (bf16*)(a.ws + WS_SSMO), a.in[19] + L3 * 512};
            pg8::gemm_phase<pg8::EpiGlu, pg8::OneUnit, true, true>((LAS unsigned char*)lds, g, S, E); publish(ctr + 128 + (r >> 1));
        }
        else {
            int r = it - i_mrg, pm0, npm;
            if (r < 32 * 8) { pm0 = 0; npm = 32; } else { r -= 32 * 8; pm0 = 32; npm = nmt - 32; }
            if (r < 4 * npm) { const int pm = pm0 + (r >> 2); await(ctr + 128 + pm, 10u);
                { const int t2 = otid(); merge_rows8(a, L3, t2 & 63, pm * 256 + (r & 3) * 64 + __builtin_amdgcn_readfirstlane(t2 >> 6) * 8); }
                publish(ctr + 256 + pm); }
            else { r -= 4 * npm; const int pm = pm0 + (r >> 2), pn = r & 3; await(ctr + 256 + pm, 4u);
                pg8::Gemm g{(const bf16*)(a.ws + WS_XN), (const bf16*)(a.ws + WS_WOUT), NTOK, 1024, 1024, 1024}; pg8::OneUnit S{pm, pn};
                pg8::EpiRes E{a.out, (float*)(a.ws + WS_XC), (const float*)(a.ws + WS_MOD) + (size_t)L3 * 5 * 6144 + 2048, (bf16*)(a.ws + WS_XT2), (const float*)(a.ws + WS_CS) + (size_t)(L3 * 2 + 1) * 5 * 1024, (float*)(a.ws + WS_SSQ2)};
                pg8::gemm_phase<pg8::EpiRes, pg8::OneUnit, true, true>((LAS unsigned char*)lds, g, S, E); }
        }
    }
}

typedef const __attribute__((address_space(4))) Args* KArgsP;
__device__ __forceinline__ KArgsP launder(KArgsP p) { asm volatile("" : "+s"(p)); return p; }
__global__ void __launch_bounds__(512, 2) mk_fwd(Args a_unused) {
    unsigned char* const lds = lds_dyn;
    const KArgsP ap0 = (KArgsP)__builtin_amdgcn_kernarg_segment_ptr();
    LAS unsigned char* L = (LAS unsigned char*)lds;
    const int ph_lo = launder(ap0)->ph_lo, ph_hi = launder(ap0)->ph_hi;
    { if ((threadIdx.x & 63) == 0) ((volatile LAS int*)((LAS unsigned char*)lds + WTAB_OFF))[hw_slot()] = (int)(threadIdx.x >> 6);
      __syncthreads(); }
    { volatile LAS unsigned* st = (volatile LAS unsigned*)((LAS unsigned char*)lds + QS_OFF + 64);
      if (otid() < 2) st[otid()] = 0u;
      __syncthreads();
      (void)xcd_barrier_post((unsigned*)(launder(ap0)->ws + WS_CTL) + 4096, st); }
#define XBAR() do { XcdBarrier xb_; xb_.bar = (unsigned*)(launder(ap0)->ws + WS_CTL) + 4096; xb_.x = xb_xcc_id(); xb_.st = (volatile LAS unsigned*)((LAS unsigned char*)lds + QS_OFF + 64); xcd_barrier(xb_); } while (0)
    if (ph_lo == 0) {
#if defined(__HIP_DEVICE_COMPILE__)
        const Args a = *launder(ap0);
#else
        const Args a = a_unused;
#endif
        if (PHON(13)) p0_phase(a, L, otid());
        if (ph_hi < 0) { __syncthreads(); cg::this_grid().sync(); }
        XBAR();
        if (PHON(13)) p1_phase(a, L, otid());
        { const int tid = otid(); prep_phase(a, L, 0, tid, tid & 63, __builtin_amdgcn_readfirstlane(tid >> 6)); }
        XBAR();
    }
    for (int ph = (ph_lo < 3 ? 3 : ph_lo); ph < ph_hi; ++ph) {
      const int nrep_ = 1;
      for (int rep = 0; rep < nrep_; ++rep) {
#if defined(__HIP_DEVICE_COMPILE__)
        const Args& a = *(const Args*)launder(ap0);
#else
        const Args& a = a_unused;
#endif
        const int G = ogrid(), c = obid();
        bf16* xn = (bf16*)(a.ws + WS_XN); float* xc = (float*)(a.ws + WS_XC);
        {
            const int l = (ph - 3) / NSTAGE, s = (ph - 3) % NSTAGE; const bool last = (l == DEPTH - 1); const int nrows = last ? NLAT : NTOK;
            const float* mod = (const float*)(a.ws + WS_MOD) + (size_t)l * 5 * 6144; const float* cs = (const float*)(a.ws + WS_CS);
            bf16* xt2 = (bf16*)(a.ws + WS_XT2); float* ssq1 = (float*)(a.ws + WS_SSQ1); float* ssq2 = (float*)(a.ws + WS_SSQ2);
            if (s == 0) { if (PHON(1)) { const int tid = otid(); mix_phase(a, lds, l + 4 * rep, !last, tid, tid & 63, __builtin_amdgcn_readfirstlane(tid >> 6)); } }
            else if (s == 1) { if (PHON(2)) { pg8::Gemm g{xt2, (const bf16*)(a.ws + WS_WUP), nrows, DFF2, 1024, 1024}; pg8::StaticOrder S; S.init(nrows, DFF2, G, c);
                pg8::EpiConv E{(bf16*)(a.ws + WS_HFFN), a.in[24] + (size_t)l * 3 * DFF2, a.in[25] + (size_t)l * DFF2, (float*)(a.ws + WS_SIDE), (LAS float*)(L + 131072),
                               ssq2, (const float*)(a.ws + WS_BIASUP) + (size_t)l * 5 * 5632};
                pg8::gemm_phase<pg8::EpiConv, pg8::StaticOrder, true, true>(L, g, S, E);
                if (!last) { const int t2 = otid(), w2 = __builtin_amdgcn_readfirstlane(t2 >> 6); transposes_range(a, L, l + 1, 0, 1280, c * 8 + w2, G * 8, t2 & 63, w2); } } }
            else if (PHON(3)) { pg8::Gemm g{(const bf16*)(a.ws + WS_HFFN), (const bf16*)(a.ws + WS_WDN), NLAT, 1024, DFF, DFF}; pg8::StaticOrder S; S.init(NLAT, 1024, G, c);
                if (G == 256) { pg8::Unit u0; if (S.next(0, u0)) fix_tile(a, l, u0.pm, otid()); } else { fix_phase(a, l, otid()); XBAR(); }
                pg8::EpiRes E{a.out, xc, mod + 5120, last ? (bf16*)nullptr : xn, cs + (size_t)((l + 1) * 2) * 5 * 1024, ssq1}; pg8::gemm_phase<pg8::EpiRes, pg8::StaticOrder, true, true>(L, g, S, E);
                if (!last) { pg8::Gemm g2{(const bf16*)(a.ws + WS_HFFN) + (size_t)NLAT * DFF, (const bf16*)(a.ws + WS_WDN), 1024, 1024, 256, DFF}; pg8::SliceOrder S2{G, c};
                    pg8::EpiPart E2{(float*)(a.ws + WS_PART)}; pg8::gemm_phase<pg8::EpiPart, pg8::SliceOrder, true, true>(L, g2, S2, E2); } }
        }
        if (ph + 1 < ph_hi || rep + 1 < nrep_) { XBAR(); for (int q_ = 0; q_ < REP_SYNC; ++q_) XBAR(); }
      }
    }
}

#ifndef MK_MULTI
#define MK_MULTI 0
#endif
extern "C" void kernel_launch(void* const* d_in, const int* in_sizes, int n_in, void* d_out, int out_size, void* d_ws, size_t ws_size, hipStream_t stream) {
    static int grid = 0;
    if (grid == 0) {
        if (n_in != 27 || ws_size < WS_END) { fprintf(stderr, "kernel_launch: bad shapes/workspace (n_in %d ws %zu need %zu)\n", n_in, ws_size, (size_t)WS_END); grid = -1; return; }
        int dev = 0, cus = 0, per_cu = 0;
        hipGetDevice(&dev); hipDeviceGetAttribute(&cus, hipDeviceAttributeMultiprocessorCount, dev);
        if (hipFuncSetAttribute((const void*)mk_fwd, hipFuncAttributeMaxDynamicSharedMemorySize, LDS_BYTES) != hipSuccess) { fprintf(stderr, "kernel_launch: hipFuncSetAttribute failed\n"); grid = -1; return; }
        if (hipOccupancyMaxActiveBlocksPerMultiprocessor(&per_cu, (const void*)mk_fwd, 512, LDS_BYTES) != hipSuccess || per_cu < 1) { fprintf(stderr, "kernel_launch: occupancy query says %d\n", per_cu); per_cu = 1; }
        (void)hipGetLastError();
        grid = cus * (per_cu > 1 ? 1 : per_cu);
        if (grid < 1) grid = 256;
    }
    if (grid < 0) return;
    (void)hipMemsetAsync((char*)d_ws + WS_CTL, 0, 65536, stream);
    Args a{};
    for (int i = 0; i < 27; ++i) a.in[i] = (const float*)d_in[i];
    a.out = (float*)d_out; a.ws = (unsigned char*)d_ws;
#if MK_MULTI
    for (int ph = 0; ph < NPHASE; ++ph) { a.ph_lo = ph; a.ph_hi = ph + 1; a.coop = 0; hipLaunchKernelGGL(mk_fwd, dim3(grid), dim3(512), LDS_BYTES, stream, a); }
#else
    a.ph_lo = 0; a.ph_hi = NPHASE; a.coop = 1;
    void* args[] = {&a};
    hipError_t e = hipLaunchCooperativeKernel((const void*)mk_fwd, dim3(grid), dim3(512), args, LDS_BYTES, stream);
    if (e != hipSuccess) fprintf(stderr, "cooperative launch failed: %s (grid %d)\n", hipGetErrorString(e), grid);
#endif
}
```

```cpp
#include <hip/hip_runtime.h>
#include <hip/hip_cooperative_groups.h>
#include <hip/hip_bf16.h>
#include <cstdio>
#include <cstdint>
#include <cmath>
namespace cg = cooperative_groups;
__device__ __forceinline__ int olane() { unsigned z = 0u; asm volatile("" : "+v"(z)); return (int)__builtin_amdgcn_mbcnt_hi(~0u, __builtin_amdgcn_mbcnt_lo(~0u, z)); }
extern __shared__ __attribute__((aligned(16))) unsigned char lds_dyn[];
constexpr int WTAB_OFF = 135168 + 256;
__device__ __forceinline__ int hw_slot() { return (int)__builtin_amdgcn_s_getreg((5 << 11) | (0 << 6) | 4); }
__device__ __forceinline__ int otid() {
    const int w = __builtin_amdgcn_readfirstlane(((volatile __attribute__((address_space(3))) int*)((__attribute__((address_space(3))) unsigned char*)lds_dyn + WTAB_OFF))[hw_slot()]);
    int t = w * 64 + olane(); asm volatile("" : "+v"(t)); return t;
}
template <int M> __device__ __forceinline__ float shx(float v) {
    if constexpr (M == 32) { auto rr = __builtin_amdgcn_permlane32_swap(__builtin_bit_cast(unsigned, v), __builtin_bit_cast(unsigned, v), false, false);
        const bool hi = (olane() & 32) != 0; return __builtin_bit_cast(float, hi ? rr[0] : rr[1]); }
    else return __builtin_bit_cast(float, __builtin_amdgcn_ds_swizzle(__builtin_bit_cast(int, v), (M << 10) | 0x1f));
}
__device__ __forceinline__ int obid() { int t = blockIdx.x; asm volatile("" : "+s"(t)); return t; }
__device__ __forceinline__ int ogrid() { int t = gridDim.x; asm volatile("" : "+s"(t)); return t; }
namespace pg8 {
#define PG8_LAS __attribute__((address_space(3)))
typedef unsigned short bf16_t;
typedef short bf16x8 __attribute__((ext_vector_type(8)));
typedef float f32x4 __attribute__((ext_vector_type(4)));
typedef unsigned u32x4 __attribute__((ext_vector_type(4)));
typedef unsigned u32x2 __attribute__((ext_vector_type(2)));
constexpr int BM = 256, BK = 64, HALF = 128, HTB = HALF * BK * 2  , STAGE_BYTES = 8 * HTB, NXCD = 8, WGM = 8;

__host__ __device__ __forceinline__ int lds_byte(int r, int c) { const int st = (r >> 4) * 2 + (c >> 5), rr = r & 15, cc = c & 31, ob = rr * 64 + cc * 2; return st * 1024 + (ob ^ (((ob >> 9) & 1) << 5)); }
__host__ __device__ __forceinline__ void stage_rc(int b, int& R, int& C) { const int st = b / 1024, sb = b % 1024, swz = sb ^ (((sb >> 9) & 1) << 5); R = (st >> 1) * 16 + swz / 64; C = (st & 1) * 32 + (swz % 64) / 2; }
__host__ __device__ __forceinline__ int perm32(int rho) { const int n = rho >> 4, i = rho & 15; return 8 * (i >> 2) + 4 * n + (i & 3); }

struct Unit { int pm, pn, kofs, ks; };
struct Gemm { const bf16_t* A; const bf16_t* Bt; int M, N, K, ld; };

struct StaticOrder {
    int nM, nN, nwg, G, c;
    __host__ __device__ void init(int M, int N, int G_, int c_) { nM = M / BM; nN = N / BM; nwg = nM * nN; G = G_; c = c_; }
    __host__ __device__ bool next(int i, Unit& u) const {
        const long L = (long)i * G + c; if (L >= nwg) return false;
        int wgid = (int)L; { const int q = nwg / NXCD, r = nwg % NXCD, xcd = wgid % NXCD, off = wgid / NXCD; wgid = (xcd < r ? xcd * (q + 1) : r * (q + 1) + (xcd - r) * q) + off; }
        const int nig = WGM * nN, gid = wgid / nig, fm = gid * WGM, gsz = (nM - fm) < WGM ? (nM - fm) : WGM;
        u.pm = fm + ((wgid % nig) % gsz); u.pn = (wgid % nig) / gsz; u.kofs = 0; u.ks = 0; return true;
    }
    __device__ __forceinline__ void a_ready(const Unit&) const {}
    __device__ __forceinline__ void done(const Unit&) const {}
};

__device__ __forceinline__ unsigned cvt_pk_bf16(float lo, float hi) { unsigned r; asm volatile("v_cvt_pk_bf16_f32 %0, %1, %2" : "=v"(r) : "v"(lo), "v"(hi)); return r; }
typedef float f32x2 __attribute__((ext_vector_type(2)));
struct EpiStore { static constexpr bool ROWPERM = false; static constexpr bool PREROWS = false;
    static constexpr bool PERM = true, AFTER_DRAIN = false;
    bf16_t* O; int ldc;
    __device__ __forceinline__ void operator()(const f32x4 (&acc)[2][2][4][2], const Unit& u, int wr, int wc, int fr, int fq) const {
        const int row0 = u.pm * BM + wr * 64 + fr; const int col0 = u.pn * BM + wc * 32 + 8 * fq;
#pragma unroll
        for (int ai = 0; ai < 2; ++ai)
#pragma unroll
            for (int m = 0; m < 4; ++m) { bf16_t* rowp = O + (size_t)(row0 + ai * HALF + m * 16) * ldc + col0;
#pragma unroll
                for (int bj = 0; bj < 2; ++bj) { const f32x4 v0 = acc[ai][bj][m][0], v1 = acc[ai][bj][m][1];
                    u32x4 w; w.x = cvt_pk_bf16(v0[0], v0[1]); w.y = cvt_pk_bf16(v0[2], v0[3]); w.z = cvt_pk_bf16(v1[0], v1[1]); w.w = cvt_pk_bf16(v1[2], v1[3]);
                    *(u32x4*)(rowp + bj * HALF) = w; } }
    }
};
__device__ __forceinline__ float bf_lo(unsigned w) { return __uint_as_float(w << 16); }
__device__ __forceinline__ float bf_hi(unsigned w) { return __uint_as_float(w & 0xffff0000u); }
__device__ __forceinline__ float sigm(float x) { return __builtin_amdgcn_rcpf(1.0f + __builtin_amdgcn_exp2f(-1.4426950408889634f * x)); }
struct EpiGlu { static constexpr bool ROWPERM = false; static constexpr bool PREROWS = false;
    static constexpr bool PERM = true, AFTER_DRAIN = false;
    const bf16_t* Z; bf16_t* O; const float* bias;
    __device__ __forceinline__ void operator()(const f32x4 (&acc)[2][2][4][2], const Unit& u, int wr, int wc, int fr, int fq) const {
        const int row0 = u.pm * BM + wr * 64 + fr; const int col0 = u.pn * BM + wc * 32 + 8 * fq;
        f32x4 bv[2][2];
#pragma unroll
        for (int bj = 0; bj < 2; ++bj)
#pragma unroll
            for (int n = 0; n < 2; ++n) bv[bj][n] = *(const f32x4*)(bias + col0 + bj * HALF + 4 * n);
#pragma unroll
        for (int ai = 0; ai < 2; ++ai) {
            u32x4 zv[4][2];
#pragma unroll
            for (int m = 0; m < 4; ++m)
#pragma unroll
                for (int bj = 0; bj < 2; ++bj) zv[m][bj] = *(const u32x4*)(Z + (size_t)(row0 + ai * HALF + m * 16) * 512 + col0 + bj * HALF);
            asm volatile("" ::: "memory");
#pragma unroll
            for (int m = 0; m < 4; ++m) { const size_t off = (size_t)(row0 + ai * HALF + m * 16) * 512 + col0;
#pragma unroll
                for (int bj = 0; bj < 2; ++bj) { const u32x4 zz = zv[m][bj];
                    const f32x4 v0 = acc[ai][bj][m][0] + bv[bj][0], v1 = acc[ai][bj][m][1] + bv[bj][1];
                    u32x4 w;
                    w.x = cvt_pk_bf16(bf_lo(zz.x) * sigm(v0[0]), bf_hi(zz.x) * sigm(v0[1])); w.y = cvt_pk_bf16(bf_lo(zz.y) * sigm(v0[2]), bf_hi(zz.y) * sigm(v0[3]));
                    w.z = cvt_pk_bf16(bf_lo(zz.z) * sigm(v1[0]), bf_hi(zz.z) * sigm(v1[1])); w.w = cvt_pk_bf16(bf_lo(zz.w) * sigm(v1[2]), bf_hi(zz.w) * sigm(v1[3]));
                    *(u32x4*)(O + off + bj * HALF) = w; } }
            asm volatile("" ::: "memory"); }
    }
};
struct EpiRes { static constexpr bool ROWPERM = false; static constexpr bool PREROWS = false;
    static constexpr bool PERM = true, AFTER_DRAIN = false;
    float* xlat; float* xctx; const float* gate; bf16_t* xt; const float* cscale; float* ssq;
    __device__ __forceinline__ void operator()(const f32x4 (&acc)[2][2][4][2], const Unit& u, int wr, int wc, int fr, int fq) const {
        const int rowt = u.pm * BM;
        float* xb = rowt < 16384 ? xlat + (size_t)rowt * 1024 : xctx + (size_t)(rowt - 16384) * 1024;
        const int v = rowt < 16384 ? (rowt >> 12) : 4;
        const int col0 = u.pn * BM + wc * 32 + 8 * fq;
        f32x4 gv[2][2], cv[2][2];
#pragma unroll
        for (int bj = 0; bj < 2; ++bj)
#pragma unroll
            for (int n = 0; n < 2; ++n) { gv[bj][n] = *(const f32x4*)(gate + v * 6144 + col0 + bj * HALF + n * 4); cv[bj][n] = xt ? *(const f32x4*)(cscale + v * 1024 + col0 + bj * HALF + n * 4) : (f32x4){0.f, 0.f, 0.f, 0.f}; }
#pragma unroll
        for (int hb = 0; hb < 4; ++hb) { const int ai = hb >> 1, m0 = (hb & 1) * 2;
            f32x4 xv[2][2][2];
#pragma unroll
            for (int mm = 0; mm < 2; ++mm)
#pragma unroll
                for (int bj = 0; bj < 2; ++bj)
#pragma unroll
                    for (int n = 0; n < 2; ++n) xv[mm][bj][n] = *(const f32x4*)(xb + (size_t)(ai * HALF + wr * 64 + (m0 + mm) * 16 + fr) * 1024 + col0 + bj * HALF + n * 4);
            asm volatile("" ::: "memory");
#pragma unroll
            for (int mm = 0; mm < 2; ++mm) { const int m = m0 + mm; const int rl = ai * HALF + wr * 64 + m * 16 + fr; float* rp = xb + (size_t)rl * 1024 + col0; float ss = 0.f;
#pragma unroll
                for (int bj = 0; bj < 2; ++bj)
#pragma unroll
                    for (int n = 0; n < 2; ++n) { f32x4 x = xv[mm][bj][n] + gv[bj][n] * acc[ai][bj][m][n]; *(f32x4*)(rp + bj * HALF + n * 4) = x;
                        if (xt) { ss += (x[0] * x[0] + x[1] * x[1]) + (x[2] * x[2] + x[3] * x[3]); const f32x4 y = x * cv[bj][n];
                            u32x2 w; w.x = cvt_pk_bf16(y[0], y[1]); w.y = cvt_pk_bf16(y[2], y[3]); *(u32x2*)(xt + (size_t)(rowt + rl) * 1024 + col0 + bj * HALF + n * 4) = w; } }
                if (xt) { ss += shx<16>(ss); ss += shx<32>(ss); if (fq == 0) ssq[(size_t)(rowt + rl) * 16 + u.pn * 4 + wc] = ss; } }
            asm volatile("" ::: "memory"); }
    }
};
__device__ __forceinline__ float row_rstd(const float* ssq, int row, int fq) {
    const f32x4 a = ((const f32x4*)(ssq + (size_t)row * 16))[fq];
    float s = (a[0] + a[1]) + (a[2] + a[3]); s += shx<16>(s); s += shx<32>(s);
    return __builtin_amdgcn_rsqf(s * (1.f / 1024.f) + 1e-6f);
}
__device__ __forceinline__ float dpp_shr1(float v) { return __builtin_bit_cast(float, __builtin_amdgcn_update_dpp(0, __builtin_bit_cast(int, v), 0x111, 0xf, 0xf, true)); }
__device__ __forceinline__ float dpp_shl1(float v) { return __builtin_bit_cast(float, __builtin_amdgcn_update_dpp(0, __builtin_bit_cast(int, v), 0x101, 0xf, 0xf, true)); }
__device__ __forceinline__ float silu_e(float x) { return x * __builtin_amdgcn_rcpf(1.0f + __builtin_amdgcn_exp2f(-1.4426950408889634f * x)); }
struct EpiConv { static constexpr bool ROWPERM = true; static constexpr bool PREROWS = true;
    static constexpr bool PERM = true, AFTER_DRAIN = false;
    bf16_t* H; const float* cw; const float* cb; float* side; PG8_LAS float* xl; const float* ssq; const float* bias; PG8_LAS float* rt;
    __device__ __forceinline__ void prerows(const Unit& u) const {
        const int t = otid();
        if (t < 256) { const f32x4* p = (const f32x4*)(ssq + (size_t)(u.pm * BM + t) * 16); const f32x4 a = p[0], b = p[1], c = p[2], d = p[3];
            const float sum = ((a[0] + a[1]) + (a[2] + a[3])) + ((b[0] + b[1]) + (b[2] + b[3])) + ((c[0] + c[1]) + (c[2] + c[3])) + ((d[0] + d[1]) + (d[2] + d[3]));
            rt[t] = __builtin_amdgcn_rsqf(sum * (1.f / 1024.f) + 1e-6f); }
    }
    __device__ __forceinline__ void operator()(f32x4 (&acc)[2][2][4][2], const Unit& u, int wr, int wc, int fr, int fq) const {
        { const int rowt = u.pm * BM; const int v = rowt < 16384 ? (rowt >> 12) : 4; const int cc = 128 * u.pn + 32 * wc + 8 * fq;
          f32x4 bv[2][2];
#pragma unroll
          for (int bj = 0; bj < 2; ++bj)
#pragma unroll
              for (int n = 0; n < 2; ++n) bv[bj][n] = *(const f32x4*)(bias + v * 5632 + bj * 2816 + cc + 4 * n);
#pragma unroll
          for (int ai = 0; ai < 2; ++ai)
#pragma unroll
              for (int m = 0; m < 4; ++m) { const float rs = rt[128 * wr + 8 * fr + 4 * ai + m];
#pragma unroll
                  for (int bj = 0; bj < 2; ++bj)
#pragma unroll
                      for (int n = 0; n < 2; ++n) acc[ai][bj][m][n] = acc[ai][bj][m][n] * rs + bv[bj][n]; } }
        const int xb = ((wr * 4 + wc) * 4 + fq) * 16;
        if (fr == 0) {
#pragma unroll
            for (int bj = 0; bj < 2; ++bj)
#pragma unroll
                for (int n = 0; n < 2; ++n) *(PG8_LAS f32x4*)(xl + xb + bj * 8 + n * 4) = acc[0][bj][0][n]; }
        if (fr == 15) {
#pragma unroll
            for (int bj = 0; bj < 2; ++bj)
#pragma unroll
                for (int n = 0; n < 2; ++n) *(PG8_LAS f32x4*)(xl + 512 + xb + bj * 8 + n * 4) = acc[1][bj][3][n]; }
        asm volatile("s_waitcnt lgkmcnt(0)" ::: "memory"); __builtin_amdgcn_s_barrier(); asm volatile("" ::: "memory");
        const int ch0 = 128 * u.pn + 32 * wc + 8 * fq;
        const size_t t0 = (size_t)u.pm * BM + 128 * wr + 8 * fr;
        const bool sfirst = (fr == 0 && wr == 0), slast = (fr == 15 && wr == 1);
        float* sd = side + (size_t)u.pm * 4 * 5632;
#pragma unroll
        for (int n = 0; n < 2; ++n) {
            f32x4 prv[2], nxt[2];
#pragma unroll
            for (int bj = 0; bj < 2; ++bj) {
#pragma unroll
                for (int j = 0; j < 4; ++j) { prv[bj][j] = dpp_shr1(acc[1][bj][3][n][j]); nxt[bj][j] = dpp_shl1(acc[0][bj][0][n][j]); }
                if (fr == 0 && wr == 1) prv[bj] = *(const PG8_LAS f32x4*)(xl + 512 + ((0 * 4 + wc) * 4 + fq) * 16 + bj * 8 + n * 4);
                if (fr == 15 && wr == 0) nxt[bj] = *(const PG8_LAS f32x4*)(xl + ((1 * 4 + wc) * 4 + fq) * 16 + bj * 8 + n * 4); }
            const int c = ch0 + 4 * n;
            const f32x4 w0a = *(const f32x4*)(cw + c), w1a = *(const f32x4*)(cw + 5632 + c), w2a = *(const f32x4*)(cw + 2 * 5632 + c), ba = *(const f32x4*)(cb + c);
            const f32x4 w0g = *(const f32x4*)(cw + 2816 + c), w1g = *(const f32x4*)(cw + 5632 + 2816 + c), w2g = *(const f32x4*)(cw + 2 * 5632 + 2816 + c), bg = *(const f32x4*)(cb + 2816 + c);
#pragma unroll
            for (int k = 0; k < 8; ++k) {
                const f32x4 ap = k == 0 ? prv[0] : acc[(k - 1) >> 2][0][(k - 1) & 3][n], ac = acc[k >> 2][0][k & 3][n], an = k == 7 ? nxt[0] : acc[(k + 1) >> 2][0][(k + 1) & 3][n];
                const f32x4 gp = k == 0 ? prv[1] : acc[(k - 1) >> 2][1][(k - 1) & 3][n], gc = acc[k >> 2][1][k & 3][n], gn = k == 7 ? nxt[1] : acc[(k + 1) >> 2][1][(k + 1) & 3][n];
                const f32x4 oa = w0a * ap + w1a * ac + w2a * an + ba, og = w0g * gp + w1g * gc + w2g * gn + bg;
                u32x2 w; w.x = cvt_pk_bf16(silu_e(og[0]) * oa[0], silu_e(og[1]) * oa[1]); w.y = cvt_pk_bf16(silu_e(og[2]) * oa[2], silu_e(og[3]) * oa[3]);
                *(u32x2*)(H + (t0 + k) * 2816 + c) = w;
                if (k == 0 && sfirst) { *(f32x4*)(sd + 0 * 5632 + c) = ac; *(f32x4*)(sd + 0 * 5632 + 2816 + c) = gc; *(f32x4*)(sd + 1 * 5632 + c) = oa; *(f32x4*)(sd + 1 * 5632 + 2816 + c) = og; }
                if (k == 7 && slast) { *(f32x4*)(sd + 2 * 5632 + c) = ac; *(f32x4*)(sd + 2 * 5632 + 2816 + c) = gc; *(f32x4*)(sd + 3 * 5632 + c) = oa; *(f32x4*)(sd + 3 * 5632 + 2816 + c) = og; }
            }
        }
    }
};
struct EpiIn { static constexpr bool ROWPERM = false; static constexpr bool PREROWS = false;
    static constexpr bool PERM = false, AFTER_DRAIN = false;
    bf16_t* QO; bf16_t* KA; bf16_t* VA; bf16_t* UB; const float* qg; const float* kg; const float* rt; const float* ssq; const float* bias;
    __device__ __forceinline__ void operator()(const f32x4 (&acc)[2][2][4][2], const Unit& u, int wr, int wc, int fr, int fq) const {
        const int rowt = u.pm * BM + wr * 64 + fr;
        const int vb = (u.pm * BM) < 16384 ? ((u.pm * BM) >> 12) : 4;
        const int sbase = u.pn >= 3 ? 768 + (u.pn - 3) * 256 + 32 * wc : (u.pn < 2 ? (4 * u.pn + wc) * 64 : (wc < 2 ? 512 + wc * 64 : 640 + (wc - 2) * 64));
        const int sbj = u.pn >= 3 ? 128 : 32;
        f32x4 bsv[2][2];
#pragma unroll
        for (int bj = 0; bj < 2; ++bj)
#pragma unroll
            for (int n = 0; n < 2; ++n) bsv[bj][n] = *(const f32x4*)(bias + vb * 1280 + sbase + sbj * bj + 16 * n + 4 * fq);
        float rsv[2][4];
#pragma unroll
        for (int ai = 0; ai < 2; ++ai)
#pragma unroll
            for (int m = 0; m < 4; ++m) rsv[ai][m] = row_rstd(ssq, rowt + ai * HALF + m * 16, fq);
        if (u.pn >= 3) {
#pragma unroll
            for (int ai = 0; ai < 2; ++ai)
#pragma unroll
                for (int m = 0; m < 4; ++m) { bf16_t* rp = UB + (size_t)(rowt + ai * HALF + m * 16) * 512 + (u.pn - 3) * 256 + wc * 32 + 4 * fq; const float rs = rsv[ai][m];
#pragma unroll
                    for (int bj = 0; bj < 2; ++bj)
#pragma unroll
                        for (int n = 0; n < 2; ++n) { const f32x4 v = acc[ai][bj][m][n] * rs + bsv[bj][n]; u32x2 w; w.x = cvt_pk_bf16(v[0], v[1]); w.y = cvt_pk_bf16(v[2], v[3]); *(u32x2*)(rp + bj * HALF + n * 16) = w; } }
            return;
        }
        const bool isv = (u.pn == 2 && wc >= 2), isq = u.pn < 2;
        const float* gsrc = isq ? qg : kg;
        f32x4 gn[2][2];
#pragma unroll
        for (int bj = 0; bj < 2; ++bj)
#pragma unroll
            for (int n = 0; n < 2; ++n) gn[bj][n] = *(const f32x4*)(gsrc + 32 * bj + 16 * n + 4 * fq);
        const float osc = isq ? 0.125f * 1.4426950408889634f : 1.0f;
#pragma unroll
        for (int ai = 0; ai < 2; ++ai)
#pragma unroll
            for (int m = 0; m < 4; ++m) {
                const int row = rowt + ai * HALF + m * 16; const bool lat = row < 16384; const int sidx = row & 4095;
                const size_t kvrow = lat ? (size_t)(row >> 12) * 4352 + 256 + sidx : (size_t)((row - 16384) >> 8) * 4352 + ((row - 16384) & 255);
                f32x4 y[2][2]; const float rs = rsv[ai][m];
#pragma unroll
                for (int bj = 0; bj < 2; ++bj)
#pragma unroll
                    for (int n = 0; n < 2; ++n) y[bj][n] = acc[ai][bj][m][n] * rs + bsv[bj][n];
                if (!isv) {
                    float ss = 0.f;
#pragma unroll
                    for (int bj = 0; bj < 2; ++bj)
#pragma unroll
                        for (int n = 0; n < 2; ++n) { const f32x4 v = y[bj][n]; ss += (v[0] * v[0] + v[1] * v[1]) + (v[2] * v[2] + v[3] * v[3]); }
                    ss += shx<16>(ss); ss += shx<32>(ss);
                    const float rstd = __builtin_amdgcn_rsqf(ss * (1.f / 64.f) + 1e-6f);
#pragma unroll
                    for (int bj = 0; bj < 2; ++bj) {
                        f32x4 t1 = y[bj][0] * rstd * gn[bj][0], t2 = y[bj][1] * rstd * gn[bj][1];
                        if (lat) { const int p = bj == 0 ? (sidx >> 6) : (sidx & 63);
                            const f32x4 cs = *(const f32x4*)(rt + p * 16 + 4 * fq), sn = *(const f32x4*)(rt + 1024 + p * 16 + 4 * fq);
                            const f32x4 o1 = t1 * cs - t2 * sn, o2 = t2 * cs + t1 * sn; t1 = o1; t2 = o2; }
                        y[bj][0] = t1 * osc; y[bj][1] = t2 * osc; }
                }
                bf16_t* dst = isq ? QO + (size_t)row * 512 + (4 * u.pn + wc) * 64 : (isv ? VA + kvrow * 128 + (wc - 2) * 64 : KA + kvrow * 128 + wc * 64);
#pragma unroll
                for (int bj = 0; bj < 2; ++bj)
#pragma unroll
                    for (int n = 0; n < 2; ++n) { const f32x4 v = y[bj][n]; u32x2 w; w.x = cvt_pk_bf16(v[0], v[1]); w.y = cvt_pk_bf16(v[2], v[3]); *(u32x2*)(dst + 32 * bj + 16 * n + 4 * fq) = w; }
            }
    }
};

struct SliceOrder {
    int G, c;
    __host__ __device__ bool next(int i, Unit& u) const { const int L = i * G + c; if (L >= 176) return false; u.ks = L >> 4; u.kofs = u.ks * 256; u.pm = (L >> 2) & 3; u.pn = L & 3; return true; }
    __device__ __forceinline__ void a_ready(const Unit&) const {}
    __device__ __forceinline__ void done(const Unit&) const {}
};
struct EpiPart { static constexpr bool ROWPERM = false; static constexpr bool PREROWS = false;
    static constexpr bool PERM = true, AFTER_DRAIN = false;
    float* P;
    __device__ __forceinline__ void operator()(const f32x4 (&acc)[2][2][4][2], const Unit& u, int wr, int wc, int fr, int fq) const {
        float* base = P + ((size_t)u.ks * 1024 + u.pm * BM + wr * 64 + fr) * 1024 + u.pn * BM + wc * 32 + 8 * fq;
#pragma unroll
        for (int ai = 0; ai < 2; ++ai)
#pragma unroll
            for (int m = 0; m < 4; ++m)
#pragma unroll
                for (int bj = 0; bj < 2; ++bj)
#pragma unroll
                    for (int n = 0; n < 2; ++n) *(f32x4*)(base + (size_t)(ai * HALF + m * 16) * 1024 + bj * HALF + n * 4) = acc[ai][bj][m][n];
    }
};

struct OneUnit { int pm, pn;
    __host__ __device__ bool next(int i, Unit& u) const { if (i > 0) return false; u.pm = pm; u.pn = pn; u.kofs = 0; u.ks = 0; return true; }
    __device__ __forceinline__ void a_ready(const Unit&) const {}
    __device__ __forceinline__ void done(const Unit&) const {}
};
template <class Epi, class Sched, bool ALIGN_EPI = false, bool SP2 = false>
__device__ __forceinline__ void gemm_phase(PG8_LAS unsigned char* lds, const Gemm g, const Sched& S, const Epi& E) {
    const int tid = otid(), wid = __builtin_amdgcn_readfirstlane(tid >> 6), lane = tid & 63, wr = wid >> 2, wc = wid & 3, fr = lane & 15, fq = lane >> 4;
    const int K = g.ld, nt = g.K / BK;
    unsigned voffA[2], voffB[2];
#pragma unroll
    for (int i = 0; i < 2; ++i) { int R, C; stage_rc(tid * 16 + i * 8192, R, C); const int Rb = Epi::PERM ? ((R & ~31) + perm32(R & 31)) : R;
        const int Ra = Epi::ROWPERM ? (128 * (R >> 6) + 8 * (R & 15) + ((R >> 4) & 3)) : R;
        voffA[i] = (unsigned)(Ra * K + C) * 2u; voffB[i] = (unsigned)(Rb * K + C) * 2u; }
    const size_t hstepA = Epi::ROWPERM ? (size_t)4 * K * 2 : (size_t)HALF * K * 2;
    const size_t kstep = (size_t)(BK * 2);
    const size_t hstep = (size_t)HALF * K * 2;
    const size_t tstep = 2 * hstep;
    const unsigned ldsw = (unsigned)wid * 1024u;
    const int aoff = lds_byte(wr * 64 + fr, fq * 8), boff = lds_byte(wc * 32 + fr, fq * 8);
#define PG8_SA(b, h) (((b) * 2 + (h)) * HTB)
#define PG8_SB(b, h) ((4 + (b) * 2 + (h)) * HTB)
#define PG8_STAGE(bufoff, gbase, voff) do { _Pragma("unroll") for (int _i = 0; _i < 2; ++_i) \
        __builtin_amdgcn_global_load_lds((const unsigned*)((const char*)(gbase) + (voff)[_i]), (PG8_LAS unsigned*)(lds + (bufoff) + ldsw + _i * 8192), 16, 0, 0); } while (0)
#define PG8_LDA(dst, b, h) do { _Pragma("unroll") for (int m = 0; m < 4; ++m) _Pragma("unroll") for (int k = 0; k < 2; ++k) dst[m][k] = *(const PG8_LAS bf16x8*)(lds + PG8_SA(b, h) + aoff + m * 2048 + k * 1024); } while (0)
#define PG8_LDB(dst, b, h) do { _Pragma("unroll") for (int n = 0; n < 2; ++n) _Pragma("unroll") for (int k = 0; k < 2; ++k) dst[n][k] = *(const PG8_LAS bf16x8*)(lds + PG8_SB(b, h) + boff + n * 2048 + k * 1024); } while (0)
#define PG8_MMA(ai, bj, At, Bt) do { __builtin_amdgcn_s_setprio(1); _Pragma("unroll") for (int m = 0; m < 4; ++m) _Pragma("unroll") for (int n = 0; n < 2; ++n) _Pragma("unroll") for (int k = 0; k < 2; ++k) \
        acc[ai][bj][m][n] = __builtin_amdgcn_mfma_f32_16x16x32_bf16(Bt[n][k], At[m][k], acc[ai][bj][m][n], 0, 0, 0); __builtin_amdgcn_s_setprio(0); } while (0)
#define PG8_WAIT_V(n) asm volatile("s_waitcnt vmcnt(" #n ")" ::: "memory")
#define PG8_WAIT_L(n) asm volatile("s_waitcnt lgkmcnt(" #n ")" ::: "memory")
#define PG8_BAR __builtin_amdgcn_s_barrier()
#define PG8_SCHED __builtin_amdgcn_sched_barrier(0)
    Unit cur, nxt; int ui = 0;
    if (!S.next(0, cur)) return;
    if constexpr (Epi::PREROWS) E.prerows(cur);
    f32x4 acc[2][2][4][2];
#pragma unroll
    for (int a = 0; a < 2; ++a)
#pragma unroll
        for (int b = 0; b < 2; ++b)
#pragma unroll
            for (int m = 0; m < 4; ++m)
#pragma unroll
                for (int n = 0; n < 2; ++n) acc[a][b][m][n] = (f32x4){0.f, 0.f, 0.f, 0.f};
    bf16x8 At[4][2], B0[2][2], B1[2][2];
    const char* cA = (const char*)g.A + (size_t)cur.pm * tstep + (size_t)cur.kofs * 2; const char* cB = (const char*)g.Bt + (size_t)cur.pn * tstep + (size_t)cur.kofs * 2;
    S.a_ready(cur);
    if constexpr (SP2) {
        PG8_STAGE(PG8_SB(0, 0), cB, voffB); PG8_STAGE(PG8_SB(0, 1), cB + hstep, voffB); PG8_STAGE(PG8_SA(0, 0), cA, voffA); PG8_STAGE(PG8_SA(0, 1), cA + hstepA, voffA);
        if (wr == 1) PG8_BAR;
        PG8_WAIT_V(2); PG8_BAR;
        PG8_STAGE(PG8_SB(1, 0), cB + kstep, voffB); PG8_STAGE(PG8_SA(1, 0), cA + kstep, voffA); PG8_STAGE(PG8_SB(1, 1), cB + hstep + kstep, voffB);
        PG8_WAIT_V(6); PG8_BAR;
    } else {
        PG8_STAGE(PG8_SB(0, 0), cB, voffB); PG8_STAGE(PG8_SA(0, 0), cA, voffA); PG8_STAGE(PG8_SB(0, 1), cB + hstep, voffB); PG8_STAGE(PG8_SA(0, 1), cA + hstepA, voffA);
        if (wr == 1) PG8_BAR;
        PG8_WAIT_V(4); PG8_BAR;
        PG8_STAGE(PG8_SB(1, 0), cB + kstep, voffB); PG8_STAGE(PG8_SA(1, 0), cA + kstep, voffA); PG8_STAGE(PG8_SB(1, 1), cB + hstep + kstep, voffB);
        PG8_WAIT_V(6); PG8_BAR;
    }
    for (;;) {
        const bool has_next = S.next(ui + 1, nxt);
        const char* nA = has_next ? (const char*)g.A + (size_t)nxt.pm * tstep + (size_t)nxt.kofs * 2 : cA; const char* nB = has_next ? (const char*)g.Bt + (size_t)nxt.pn * tstep + (size_t)nxt.kofs * 2 : cB;
        for (int t = 0; t < nt; t += 2) {
            const bool last = (t == nt - 2);
            const char* a1 = cA + (size_t)(t + 1) * kstep;
            const char* a2 = last ? nA : cA + (size_t)(t + 2) * kstep; const char* b2 = last ? nB : cB + (size_t)(t + 2) * kstep;
            const char* a3 = a2 + kstep; const char* b3 = b2 + kstep;
            if (last && has_next) S.a_ready(nxt);
            if constexpr (SP2) {
            PG8_LDB(B0, 0, 0); PG8_LDB(B1, 0, 1); PG8_SCHED; PG8_LDA(At, 0, 0); PG8_STAGE(PG8_SA(1, 1), a1 + hstepA, voffA);
            PG8_WAIT_V(8); PG8_WAIT_L(0); PG8_BAR; PG8_MMA(0, 0, At, B0); PG8_MMA(0, 1, At, B1); PG8_BAR; PG8_SCHED;
            PG8_LDA(At, 0, 1); PG8_STAGE(PG8_SB(0, 0), b2, voffB); PG8_STAGE(PG8_SB(0, 1), b2 + hstep, voffB); PG8_STAGE(PG8_SA(0, 0), a2, voffA);
            PG8_WAIT_V(8); PG8_WAIT_L(0); PG8_BAR; PG8_MMA(1, 0, At, B0); PG8_MMA(1, 1, At, B1); PG8_BAR; PG8_SCHED;
            PG8_LDB(B0, 1, 0); PG8_LDB(B1, 1, 1); PG8_SCHED; PG8_LDA(At, 1, 0); PG8_STAGE(PG8_SA(0, 1), a2 + hstepA, voffA);
            PG8_WAIT_V(8); PG8_WAIT_L(0); PG8_BAR; PG8_MMA(0, 0, At, B0); PG8_MMA(0, 1, At, B1); PG8_BAR; PG8_SCHED;
            PG8_LDA(At, 1, 1); PG8_STAGE(PG8_SB(1, 0), b3, voffB); PG8_STAGE(PG8_SB(1, 1), b3 + hstep, voffB); PG8_STAGE(PG8_SA(1, 0), a3, voffA);
            PG8_WAIT_V(8); PG8_WAIT_L(0); PG8_BAR; PG8_MMA(1, 0, At, B0); PG8_MMA(1, 1, At, B1); PG8_BAR; PG8_SCHED;
            } else {
            PG8_LDB(B0, 0, 0); PG8_SCHED; PG8_LDA(At, 0, 0); PG8_STAGE(PG8_SA(1, 1), a1 + hstepA, voffA);
            PG8_WAIT_L(8); PG8_BAR; PG8_WAIT_L(0); PG8_MMA(0, 0, At, B0); PG8_BAR; PG8_SCHED;
            PG8_LDB(B1, 0, 1); PG8_STAGE(PG8_SB(0, 0), b2, voffB);
            PG8_BAR; PG8_WAIT_L(0); PG8_MMA(0, 1, At, B1); PG8_BAR;
            PG8_LDA(At, 0, 1); PG8_STAGE(PG8_SA(0, 0), a2, voffA);
            PG8_BAR; PG8_WAIT_L(0); PG8_MMA(1, 0, At, B0); PG8_BAR; PG8_SCHED;
            PG8_STAGE(PG8_SB(0, 1), b2 + hstep, voffB);
            PG8_WAIT_V(6); PG8_BAR; PG8_MMA(1, 1, At, B1); PG8_BAR;
            PG8_LDB(B0, 1, 0); PG8_SCHED; PG8_LDA(At, 1, 0); PG8_STAGE(PG8_SA(0, 1), a2 + hstepA, voffA);
            PG8_WAIT_L(8); PG8_BAR; PG8_WAIT_L(0); PG8_MMA(0, 0, At, B0); PG8_BAR; PG8_SCHED;
            PG8_LDB(B1, 1, 1); PG8_STAGE(PG8_SB(1, 0), b3, voffB);
            PG8_BAR; PG8_WAIT_L(0); PG8_MMA(0, 1, At, B1); PG8_BAR;
            PG8_LDA(At, 1, 1); PG8_STAGE(PG8_SA(1, 0), a3, voffA);
            PG8_BAR; PG8_WAIT_L(0); PG8_MMA(1, 0, At, B0); PG8_BAR; PG8_SCHED;
            PG8_STAGE(PG8_SB(1, 1), b3 + hstep, voffB);
            PG8_WAIT_V(6); PG8_BAR; PG8_MMA(1, 1, At, B1); PG8_BAR;
            }
        }
        if constexpr (ALIGN_EPI) { if (wr == 0) PG8_BAR; }
        if constexpr (!Epi::AFTER_DRAIN) { int l2 = olane(); asm volatile("" : "+v"(l2)); const int fr2 = l2 & 15, fq2 = l2 >> 4; E(acc, cur, wr, wc, fr2, fq2); S.done(cur); }
        if (!has_next) break;
        if constexpr (Epi::PREROWS) E.prerows(nxt);
#pragma unroll
        for (int a = 0; a < 2; ++a)
#pragma unroll
            for (int b = 0; b < 2; ++b)
#pragma unroll
                for (int m = 0; m < 4; ++m)
#pragma unroll
                    for (int n = 0; n < 2; ++n) acc[a][b][m][n] = (f32x4){0.f, 0.f, 0.f, 0.f};
        cur = nxt; cA = nA; cB = nB; ++ui;
        if constexpr (ALIGN_EPI) { if (wr == 1) PG8_BAR; }
    }
    PG8_WAIT_V(0);
    if constexpr (!ALIGN_EPI) { if (wr == 0) PG8_BAR; }
    PG8_BAR;
    if constexpr (Epi::AFTER_DRAIN) { E.fused(acc, cur, wr, wc, fr, fq, lds, wid, lane); S.done(cur); }
#undef PG8_SA
#undef PG8_SB
#undef PG8_STAGE
#undef PG8_LDA
#undef PG8_LDB
#undef PG8_MMA
#undef PG8_WAIT_V
#undef PG8_WAIT_L
#undef PG8_BAR
#undef PG8_SCHED
}
}
#include <hip/hip_bf16.h>
namespace attn_body {
using bf16=__hip_bfloat16;
using bf16x8=__attribute__((ext_vector_type(8)))short;
using s16x4=__attribute__((ext_vector_type(4)))short;
using f32x16=__attribute__((ext_vector_type(16)))float;
using u32x4=__attribute__((ext_vector_type(4)))unsigned;
constexpr int D=64,QP=512,KP=128;
constexpr int NW=8,QBLK=32,QB=QBLK*NW,KVBLK=64;
__device__ __forceinline__ int crow(int r,int hi){return (r&3)+8*(r>>2)+4*hi;}
#define SBAR() __builtin_amdgcn_sched_barrier(0)
__device__ __forceinline__ void cmask(f32x16&p0,f32x16&p1,int jb,int qrel,int hi){
  const float NEG=-INFINITY; int kb=64*jb+4*hi;
  #pragma unroll
  for(int r=0;r<16;++r){int kv=kb+(r&3)+8*(r>>2); if(kv>qrel)p0[r]=NEG; if(kv+32>qrel)p1[r]=NEG;}
}

constexpr int NSLOT=3, SLOTB=8192;
constexpr int LDS_K=0, LDS_V=NSLOT*SLOTB, LDS_WS=2*NSLOT*SLOTB, LDS_OST=LDS_WS+NW*64*4, LDS_BYTES=LDS_OST+NW*4096;
constexpr float C2=0.125f*1.4426950408889634f;
__device__ __forceinline__ void glds16(const void*gsrc,unsigned lds_dst){unsigned keep;
  asm volatile("s_mov_b32 %0, m0\n\ts_mov_b32 m0, %2\n\ts_nop 0\n\tglobal_load_lds_dwordx4 %1, off\n\ts_mov_b32 m0, %0":"=&s"(keep):"v"(gsrc),"s"(lds_dst):"memory");}
__device__ __forceinline__ float max3f(float a,float b,float c){float r;asm("v_max3_f32 %0, %1, %2, %3":"=v"(r):"v"(a),"v"(b),"v"(c));return r;}
__device__ __forceinline__ float max2f(float a,float b){float r;asm("v_max_f32_e32 %0, %1, %2":"=v"(r):"v"(a),"v"(b));return r;}
__device__ __forceinline__ float fadd_s(float a,float b){float r;asm("v_add_f32_e32 %0, %1, %2":"=v"(r):"v"(a),"v"(b));return r;}
__device__ __forceinline__ float fsub_s(float a,float b){float r;asm("v_sub_f32_e32 %0, %1, %2":"=v"(r):"v"(a),"v"(b));return r;}
typedef float f32x2_t __attribute__((ext_vector_type(2))); typedef __bf16 bf16x2_t __attribute__((ext_vector_type(2)));
__device__ __forceinline__ unsigned cvtpk_s(float lo,float hi){f32x2_t v={lo,hi};bf16x2_t b=__builtin_convertvector(v,bf16x2_t);return __builtin_bit_cast(unsigned,b);}
#define WAIT_BAR(N) asm volatile("s_waitcnt vmcnt(" #N ") lgkmcnt(0)\n\ts_barrier":::"memory")

__device__ __forceinline__ void qkt(f32x16&p0,f32x16&p1,const char*Kslot,const bf16x8*qr,const f32x16&negm,int r32,int hi){
  const char*kb=Kslot+hi*1024+r32*16;
  #pragma unroll
  for(int d0=0;d0<4;++d0){
    const bf16x8 b0=*reinterpret_cast<const bf16x8*>(kb+d0*2048);
    const bf16x8 b1=*reinterpret_cast<const bf16x8*>(kb+d0*2048+512);
    if(d0==0){p0=__builtin_amdgcn_mfma_f32_32x32x16_bf16(b0,qr[0],negm,0,0,0);p1=__builtin_amdgcn_mfma_f32_32x32x16_bf16(b1,qr[0],negm,0,0,0);}
    else{p0=__builtin_amdgcn_mfma_f32_32x32x16_bf16(b0,qr[d0],p0,0,0,0);p1=__builtin_amdgcn_mfma_f32_32x32x16_bf16(b1,qr[d0],p1,0,0,0);}}
}
typedef __attribute__((address_space(3))) const char* lds_cptr;
typedef short v4i16_t __attribute__((ext_vector_type(4)));
__device__ __forceinline__ void kload8(bf16x8*kf,lds_cptr kp){
  kf[0]=*(const __attribute__((address_space(3))) bf16x8*)(kp);      kf[1]=*(const __attribute__((address_space(3))) bf16x8*)(kp+512);
  kf[2]=*(const __attribute__((address_space(3))) bf16x8*)(kp+2048); kf[3]=*(const __attribute__((address_space(3))) bf16x8*)(kp+2560);
  kf[4]=*(const __attribute__((address_space(3))) bf16x8*)(kp+4096); kf[5]=*(const __attribute__((address_space(3))) bf16x8*)(kp+4608);
  kf[6]=*(const __attribute__((address_space(3))) bf16x8*)(kp+6144); kf[7]=*(const __attribute__((address_space(3))) bf16x8*)(kp+6656);
}
__device__ __forceinline__ void kload2(bf16x8*kf,lds_cptr kp,int j){ kf[2*j]=*(const __attribute__((address_space(3))) bf16x8*)(kp+j*2048); kf[2*j+1]=*(const __attribute__((address_space(3))) bf16x8*)(kp+j*2048+512); }
__device__ __forceinline__ s16x4 vtr(lds_cptr p){ return __builtin_bit_cast(s16x4,__builtin_amdgcn_ds_read_tr16_b64_v4i16((__attribute__((address_space(3))) v4i16_t*)p)); }
__device__ __forceinline__ float rowmax(const f32x16&p0,const f32x16&p1){
  float a=max3f(p0[0],p0[1],p1[0]),b=max3f(p0[2],p0[3],p1[1]);a=max3f(a,p1[2],p1[3]);
  #pragma unroll
  for(int r=4;r<16;r+=4){a=max3f(a,p0[r],p0[r+1]);b=max3f(b,p0[r+2],p0[r+3]);a=max3f(a,p1[r],p1[r+1]);b=max3f(b,p1[r+2],p1[r+3]);}
  const float m=max2f(a,b);
  auto rr=__builtin_amdgcn_permlane32_swap(__float_as_uint(m),__float_as_uint(m),false,false);
  return max2f(__uint_as_float(rr[0]),__uint_as_float(rr[1]));
}
__device__ __forceinline__ void pv(f32x16*o,int vb,bf16x8 pa0,bf16x8 pa1,bf16x8 pa2,bf16x8 pa3){
  #pragma unroll
  for(int d0=0;d0<2;++d0){s16x4 lo[4],hi[4];
    #pragma unroll
    for(int ks=0;ks<4;++ks){
      asm volatile("ds_read_b64_tr_b16 %0,%1 offset:%c2":"=&v"(lo[ks]):"v"(vb),"i"(d0*4096+ks*1024):"memory");
      asm volatile("ds_read_b64_tr_b16 %0,%1 offset:%c2":"=&v"(hi[ks]):"v"(vb),"i"(d0*4096+ks*1024+512):"memory");}
    asm volatile("s_waitcnt lgkmcnt(0)":::"memory");SBAR();
    #define PK(k) (bf16x8){lo[k][0],lo[k][1],lo[k][2],lo[k][3],hi[k][0],hi[k][1],hi[k][2],hi[k][3]}
    o[d0]=__builtin_amdgcn_mfma_f32_32x32x16_bf16(pa0,PK(0),o[d0],0,0,0);
    o[d0]=__builtin_amdgcn_mfma_f32_32x32x16_bf16(pa1,PK(1),o[d0],0,0,0);
    o[d0]=__builtin_amdgcn_mfma_f32_32x32x16_bf16(pa2,PK(2),o[d0],0,0,0);
    o[d0]=__builtin_amdgcn_mfma_f32_32x32x16_bf16(pa3,PK(3),o[d0],0,0,0);
    #undef PK
  }
}

#ifndef ATTN_STORE16
#define ATTN_STORE16(p,v) do{ unsigned long long* p8_=(unsigned long long*)(p); const u32x4 v_=(v); __hip_atomic_store(p8_,(unsigned long long)v_.x|((unsigned long long)v_.y<<32),__ATOMIC_RELAXED,__HIP_MEMORY_SCOPE_AGENT); __hip_atomic_store(p8_+1,(unsigned long long)v_.z|((unsigned long long)v_.w<<32),__ATOMIC_RELAXED,__HIP_MEMORY_SCOPE_AGENT); }while(0)
#endif
template<int THRL> __device__ __forceinline__ void attn_unit(long qrow0,long kvrow0,int h,int NT,const bf16*Q,const bf16*__restrict__ K,const bf16*__restrict__ V,bf16*O,char*shm){
  const int tid=otid(),lane=tid&63,r32=lane&31,hi=lane>>5; const int wid=__builtin_amdgcn_readfirstlane(tid>>6);
  const bf16*Qw=Q+(qrow0+wid*QBLK)*QP+h*D;
  const bf16*Kh=K+kvrow0*KP+(h>>2)*D,*Vh=V+kvrow0*KP+(h>>2)*D;
  const unsigned lds0=(unsigned)(uintptr_t)shm;
  float*wsf=(float*)(shm+LDS_WS)+wid*64;
  const bf16*ksrc=Kh+(long)lane*KP+wid*8;
  const bf16*vsrc=Vh+(long)(16*(wid&3)+(lane>>2))*KP+(wid>>2)*32+(lane&3)*8;
  const unsigned kdst=lds0+LDS_K+wid*1024, vdst=lds0+LDS_V+wid*1024;
  #define DMA_K(t,slot) glds16(ksrc+(long)(t)*KVBLK*KP,(unsigned)__builtin_amdgcn_readfirstlane(kdst+(slot)))
  #define DMA_V(t,slot) glds16(vsrc+(long)(t)*KVBLK*KP,(unsigned)__builtin_amdgcn_readfirstlane(vdst+(slot)))
  const int vb0=(int)(lds0+LDS_V)+((lane>>4)&1)*32+(lane&3)*8+(4*hi+((lane&15)>>2))*64;
  const char*Kbase=shm+LDS_K; bf16x8 kf[8];
  const lds_cptr shm3=(lds_cptr)shm; const lds_cptr kp0=shm3+LDS_K+hi*1024+r32*16; const lds_cptr vp0=shm3+LDS_V+((lane>>4)&1)*32+(lane&3)*8+(4*hi+((lane&15)>>2))*64;
  DMA_K(0,0);DMA_V(0,0);DMA_K(1,SLOTB);
  bf16x8 qr[4];
  #pragma unroll
  for(int d0=0;d0<4;++d0)qr[d0]=*reinterpret_cast<const bf16x8*>(&Qw[(long)r32*QP+d0*16+hi*8]);
  float mhat=0.f,l_reg=0.f;f32x16 o[2];o[0]=f32x16{};o[1]=f32x16{};f32x16 negm=f32x16{};asm volatile("":"+v"(negm));
  #define CMASK(P0,P1,t) do{}while(0)
  bool resc=false;
  #define START(P0,P1) do{ const float rm=rowmax(P0,P1); resc=false; \
    { const float dl=rm; mhat=fadd_s(mhat,dl); \
      _Pragma("unroll") for(int r=0;r<16;++r){P0[r]=fsub_s(P0[r],dl);P1[r]=fsub_s(P1[r],dl);} \
      _Pragma("unroll") for(int r=0;r<16;++r)negm[r]=-mhat; asm volatile("":"+v"(negm)); } \
    _Pragma("unroll") for(int r=0;r<16;++r)P0[r]=__builtin_amdgcn_exp2f(P0[r]); }while(0)
  #define RESC() do{ if(resc){ asm volatile("s_waitcnt lgkmcnt(0)":::"memory"); \
      _Pragma("unroll") for(int d_=0;d_<2;++d_) _Pragma("unroll") for(int r=0;r<16;++r)o[d_][r]*=wsf[crow(r,hi)]; } }while(0)
  f32x16 pA0,pA1,pB0,pB1;
  int sl_prev=0,sl_cur=0,sl_next=SLOTB;
  #define ROT() do{sl_prev=sl_cur;sl_cur=sl_next;sl_next=(sl_next==(NSLOT-1)*SLOTB)?0:sl_next+SLOTB;}while(0)
  DMA_K(2,2*SLOTB);
  WAIT_BAR(3);
  qkt(pA0,pA1,Kbase,qr,negm,r32,hi);asm volatile("s_nop 15\n\ts_nop 7":"+v"(pA0),"+v"(pA1));CMASK(pA0,pA1,0);
  START(pA0,pA1);
  _Pragma("unroll") for(int r=0;r<16;++r)pA1[r]=__builtin_amdgcn_exp2f(pA1[r]);
  WAIT_BAR(0);
  DMA_K(3,0);DMA_V(1,SLOTB);
  ROT();
  kload8(kf,kp0+sl_cur);
  WAIT_BAR(2);
  s16x4 vlo[8],vhi[8]; u32x4 pw0,pw1,pw2,pw3;
  #define PKW(P,B) cvtpk_s(P[B],P[B+1])
  #define PAF(k) __builtin_bit_cast(bf16x8,pw##k)
  #define VFR(i) (bf16x8){vlo[i][0],vlo[i][1],vlo[i][2],vlo[i][3],vhi[i][0],vhi[i][1],vhi[i][2],vhi[i][3]}
  #define PIN(x) asm volatile("":"+v"(x))
  #define MX3(a,b,c) __builtin_fmaxf(__builtin_fmaxf((a),(b)),(c))
  #define GAPA(MF,A0,A1,A2,A3,W0,W1,PW) do{ MF; sacc+=A0; sacc+=A1; sacc+=A2; sacc+=A3; PIN(sacc); W0; W1; PIN(PW); SBAR(); }while(0)
  #define EX(v) __builtin_amdgcn_exp2f(v)
  #define GAPB(MF,X,B) do{ MF; X[B]=EX(X[B]); X[B+1]=EX(X[B+1]); X[B+2]=EX(X[B+2]); X[B+3]=EX(X[B+3]); PIN(X); SBAR(); }while(0)
  #define VRD(i) do{ vlo[i]=vtr(vp_+(((i)>>2)*4096+((i)&3)*1024)); vhi[i]=vtr(vp_+(((i)>>2)*4096+((i)&3)*1024+512)); }while(0)
  #define KRD(G,j) do{ if(G){ kload2(kf,kp0+sl_next,j); SBAR(); } }while(0)
  #define STEP(C0,C1,P0,P1,t,GK,GV,GL) do{ SBAR(); \
    const lds_cptr vp_=vp0+sl_prev; \
    VRD(0); SBAR(); float sacc=(P0[0]+P0[1]); \
    GAPA(C0=__builtin_amdgcn_mfma_f32_32x32x16_bf16(kf[0],qr[0],negm,0,0,0), P0[2],P0[3],P0[4],P0[5],     pw0[0]=PKW(P0,0), pw0[1]=PKW(P0,2), pw0); \
    VRD(4); SBAR(); GAPA(C1=__builtin_amdgcn_mfma_f32_32x32x16_bf16(kf[1],qr[0],negm,0,0,0), P0[6],P0[7],P0[8],P0[9],     pw0[2]=PKW(P0,4), pw0[3]=PKW(P0,6), pw0); \
    VRD(1); SBAR(); GAPA(C0=__builtin_amdgcn_mfma_f32_32x32x16_bf16(kf[2],qr[1],C0,0,0,0),   P0[10],P0[11],P0[12],P0[13], pw1[0]=PKW(P0,8), pw1[1]=PKW(P0,10), pw1); \
    VRD(5); SBAR(); GAPA(C1=__builtin_amdgcn_mfma_f32_32x32x16_bf16(kf[3],qr[1],C1,0,0,0),   P0[14],P0[15],P1[0],P1[1],   pw1[2]=PKW(P0,12),pw1[3]=PKW(P0,14), pw1); \
    VRD(2); SBAR(); GAPA(C0=__builtin_amdgcn_mfma_f32_32x32x16_bf16(kf[4],qr[2],C0,0,0,0),   P1[2],P1[3],P1[4],P1[5],     pw2[0]=PKW(P1,0), pw2[1]=PKW(P1,2), pw2); \
    VRD(6); SBAR(); GAPA(C1=__builtin_amdgcn_mfma_f32_32x32x16_bf16(kf[5],qr[2],C1,0,0,0),   P1[6],P1[7],P1[8],P1[9],     pw2[2]=PKW(P1,4), pw2[3]=PKW(P1,6), pw2); \
    VRD(3); SBAR(); GAPA(C0=__builtin_amdgcn_mfma_f32_32x32x16_bf16(kf[6],qr[3],C0,0,0,0),   P1[10],P1[11],P1[12],P1[13], pw3[0]=PKW(P1,8), pw3[1]=PKW(P1,10), pw3); \
    VRD(7); SBAR(); GAPA(C1=__builtin_amdgcn_mfma_f32_32x32x16_bf16(kf[7],qr[3],C1,0,0,0),   P1[14],P1[15],0.f,0.f,       pw3[2]=PKW(P1,12),pw3[3]=PKW(P1,14), pw3); \
    l_reg+=sacc; \
    if(GK){DMA_K((t)+3,sl_cur);} if(GV){DMA_V((t)+1,sl_next);} \
    CMASK(C0,C1,t); \
    { float a=MX3(C0[0],C0[1],C1[0]),b=MX3(C0[2],C0[3],C1[1]); a=MX3(a,C1[2],C1[3]); \
      _Pragma("unroll") for(int r=4;r<16;r+=4){a=MX3(a,C0[r],C0[r+1]);b=MX3(b,C0[r+2],C0[r+3]);a=MX3(a,C1[r],C1[r+1]);b=MX3(b,C1[r+2],C1[r+3]);} \
      float rm=__builtin_fmaxf(a,b); { auto rr=__builtin_amdgcn_permlane32_swap(__float_as_uint(rm),__float_as_uint(rm),false,false); rm=__builtin_fmaxf(__uint_as_float(rr[0]),__uint_as_float(rr[1])); } \
      resc=false; \
      if(__builtin_expect(__any(rm>(float)THRL),0)){ const float dl=__builtin_fmaxf(rm,0.f); mhat+=dl; \
        _Pragma("unroll") for(int r=0;r<16;++r){C0[r]-=dl;C1[r]-=dl;} \
        _Pragma("unroll") for(int r=0;r<16;++r)negm[r]=-mhat; asm volatile("":"+v"(negm)); \
        const float f=__builtin_amdgcn_exp2f(-dl); l_reg*=f; if(hi==0)wsf[r32]=f; resc=true; } } \
    SBAR(); \
    GAPB(o[0]=__builtin_amdgcn_mfma_f32_32x32x16_bf16(PAF(0),VFR(0),o[0],0,0,0), C0,0); \
    GAPB(o[1]=__builtin_amdgcn_mfma_f32_32x32x16_bf16(PAF(0),VFR(4),o[1],0,0,0), C0,4); \
    KRD(GL,0); GAPB(o[0]=__builtin_amdgcn_mfma_f32_32x32x16_bf16(PAF(1),VFR(1),o[0],0,0,0), C0,8); \
    KRD(GL,1); GAPB(o[1]=__builtin_amdgcn_mfma_f32_32x32x16_bf16(PAF(1),VFR(5),o[1],0,0,0), C0,12); \
    KRD(GL,2); GAPB(o[0]=__builtin_amdgcn_mfma_f32_32x32x16_bf16(PAF(2),VFR(2),o[0],0,0,0), C1,0); \
    KRD(GL,3); GAPB(o[1]=__builtin_amdgcn_mfma_f32_32x32x16_bf16(PAF(2),VFR(6),o[1],0,0,0), C1,4); \
    GAPB(o[0]=__builtin_amdgcn_mfma_f32_32x32x16_bf16(PAF(3),VFR(3),o[0],0,0,0), C1,8); \
    GAPB(o[1]=__builtin_amdgcn_mfma_f32_32x32x16_bf16(PAF(3),VFR(7),o[1],0,0,0), C1,12); \
    }while(0)
  int t=1;
  #undef CMASK
  #define CMASK(P0,P1,t) do{}while(0)
  for(;t+5<NT;t+=2){
    STEP(pB0,pB1,pA0,pA1,t,true,true,true);     WAIT_BAR(2); RESC(); ROT();
    STEP(pA0,pA1,pB0,pB1,t+1,true,true,true);   WAIT_BAR(2); RESC(); ROT();
  }
  #undef CMASK
  #define CMASK(P0,P1,t) do{}while(0)
  #define ENDW(tt) do{ if((tt)+3<NT){WAIT_BAR(2);} else if((tt)+2<NT){WAIT_BAR(1);} else {WAIT_BAR(0);} }while(0)
  for(;t+1<NT;t+=2){
    STEP(pB0,pB1,pA0,pA1,t,(t+3<NT),(t+1<NT),(t+1<NT));       ENDW(t);   RESC(); ROT();
    STEP(pA0,pA1,pB0,pB1,t+1,(t+4<NT),(t+2<NT),(t+2<NT));     ENDW(t+1); RESC(); ROT();
  }
  STEP(pB0,pB1,pA0,pA1,NT-1,false,false,false); RESC();
  { float sacc=pB0[0]+pB0[1]; _Pragma("unroll") for(int r=2;r<16;++r)sacc+=pB0[r]; _Pragma("unroll") for(int r=0;r<16;++r)sacc+=pB1[r]; l_reg+=sacc;
    pw0=(u32x4){PKW(pB0,0),PKW(pB0,2),PKW(pB0,4),PKW(pB0,6)};pw1=(u32x4){PKW(pB0,8),PKW(pB0,10),PKW(pB0,12),PKW(pB0,14)};pw2=(u32x4){PKW(pB1,0),PKW(pB1,2),PKW(pB1,4),PKW(pB1,6)};pw3=(u32x4){PKW(pB1,8),PKW(pB1,10),PKW(pB1,12),PKW(pB1,14)};
    SBAR(); pv(o,vb0+sl_cur,PAF(0),PAF(1),PAF(2),PAF(3)); }
  #undef PKW
  #undef PAF
  #undef VFR
  #undef PIN
  #undef MX3
  #undef GAPA
  #undef GAPB
  #undef EX
  #undef VRD
  #undef KRD
  #undef STEP
  #undef ENDW
  {auto rr=__builtin_amdgcn_permlane32_swap(__float_as_uint(l_reg),__float_as_uint(l_reg),false,false);l_reg=__uint_as_float(rr[0])+__uint_as_float(rr[1]);}
  if(hi==0)wsf[32+r32]=l_reg;asm volatile("s_waitcnt lgkmcnt(0)":::"memory");
  float rli[16];
  #pragma unroll
  for(int r=0;r<16;++r)rli[r]=__builtin_amdgcn_rcpf(wsf[32+crow(r,hi)]);
  bf16*Ow=O+(qrow0+wid*QBLK)*QP+h*D;
  { bf16*stg=(bf16*)(shm+LDS_OST)+wid*2048;
    #pragma unroll
    for(int r=0;r<16;++r){const int orow=crow(r,hi);
      #pragma unroll
      for(int d0=0;d0<2;++d0)stg[orow*64+d0*32+r32]=__float2bfloat16(o[d0][r]*rli[r]);}
    asm volatile("s_waitcnt lgkmcnt(0)":::"memory");
    #pragma unroll
    for(int i=0;i<4;++i){const int row=i*8+(lane>>3),ch=lane&7; const u32x4 v=*(const u32x4*)(stg+row*64+ch*8); ATTN_STORE16(Ow+(long)row*QP+ch*8,v);} }
  asm volatile("s_waitcnt lgkmcnt(0)\n\ts_barrier":::"memory");
  #undef DMA_K
  #undef DMA_V
  #undef CMASK
  #undef START
  #undef RESC
  #undef ROT
}
constexpr int ATTN_LDS_BYTES=LDS_BYTES;
#undef SBAR
#undef WAIT_BAR
}
#define GAS __attribute__((address_space(1)))
#define LAS __attribute__((address_space(3)))
typedef unsigned short bf16;
typedef unsigned v4u __attribute__((ext_vector_type(4)));
typedef unsigned v2u __attribute__((ext_vector_type(2)));
typedef float f32x4 __attribute__((ext_vector_type(4)));
typedef short bf16x8 __attribute__((ext_vector_type(8)));

constexpr int NTOK = 17408, NLAT = 16384, DMOD = 1024, INC = 1280, DFF = 2816, DFF2 = 5632, DEPTH = 4;
constexpr int NSTAGE = 3, NPHASE = 3 + DEPTH * NSTAGE;
constexpr size_t MiB = 1u << 20;
constexpr size_t WS_CTL = 0, WS_MOD = 1 * MiB, WS_XC = 2 * MiB, WS_ROPE = 6 * MiB, WS_A16 = 7 * MiB;
constexpr size_t WS_WIN = 8 * MiB, WS_WGLU = 11 * MiB, WS_WOUT = 12 * MiB, WS_WUP = 14 * MiB, WS_WDN = 25 * MiB;
constexpr size_t WS_PFPR = 31 * MiB, WS_MTOT = 47 * MiB, WS_XN = 79 * MiB, WS_R = 113 * MiB;
constexpr size_t WS_PROJ = WS_R, WS_QO = WS_R + 43 * MiB, WS_KALL = WS_R + 60 * MiB, WS_VALL = WS_R + 65 * MiB, WS_Z = WS_R + 70 * MiB,
                 WS_SSMO = WS_R + 87 * MiB, WS_SSCR = WS_R + 104 * MiB, WS_HIN = WS_R + 138 * MiB, WS_O = WS_R + 155 * MiB;
constexpr size_t WS_HFFN = WS_R, WS_SIDE = WS_R + 94 * MiB, WS_XT2 = WS_R + 172 * MiB, WS_SSQ1 = WS_R + 206 * MiB, WS_SSQ2 = WS_R + 208 * MiB, WS_END = WS_R + 210 * MiB, WS_PART = WS_R + 104 * MiB;
constexpr size_t WS_CS = 1 * MiB + 512 * 1024, WS_BIASIN = 7 * MiB + 256 * 1024, WS_BIASUP = 7 * MiB + 512 * 1024;
constexpr int LDS_BYTES = 147456, QS_OFF = 135168;
#ifndef PHM
#define PHM 0xffff
#endif
#define PHON(k) ((PHM >> (k)) & 1)
#ifndef REP_STAGE
#define REP_STAGE -1
#endif
#ifndef REP_SYNC
#define REP_SYNC 0
#endif
constexpr float C2Q = 0.125f * 1.4426950408889634f;

struct Args { const float* in[27]; float* out; unsigned char* ws; int ph_lo, ph_hi, coop, pad; };

__device__ __forceinline__ unsigned pk2(float lo, float hi) { return pg8::cvt_pk_bf16(lo, hi); }
__device__ __forceinline__ float bflo(unsigned w) { return __uint_as_float(w << 16); }
__device__ __forceinline__ float bfhi(unsigned w) { return __uint_as_float(w & 0xffff0000u); }
__device__ __forceinline__ float wave_sum(float v) {
    v += shx<1>(v); v += shx<2>(v); v += shx<4>(v); v += shx<8>(v); v += shx<16>(v); v += shx<32>(v);
    return v;
}
__device__ __forceinline__ float silu_f(float x) { return x * __builtin_amdgcn_rcpf(1.0f + __builtin_amdgcn_exp2f(-1.4426950408889634f * x)); }
__device__ __forceinline__ float gelu_tanh(float y) { const float u = 0.7978845608028654f * (y + 0.044715f * y * y * y); return y * __builtin_amdgcn_rcpf(1.0f + __builtin_amdgcn_exp2f(-2.8853900817779268f * u)); }

__device__ __forceinline__ void transpose_item(const float* W, int K, int N, bf16* WT, LAS float* scr, int item, int lane, int rmap = 0) {
    const int nblk = N / 32, kb = item / nblk, nb = item % nblk, k0 = 64 * kb, n0 = 32 * nb;
    const int r0 = rmap == 2 ? (n0 >= 768 ? n0 : ((n0 >> 6) < 8 ? ((n0 >> 6) >> 2) * 256 + ((n0 >> 6) & 3) * 32 : 512 + ((n0 >> 6) - 8) * 32) + 128 * ((n0 >> 5) & 1)) : rmap == 0 ? n0 : (n0 < 2816 ? (n0 >> 7) * 256 + (n0 & 127) : ((n0 - 2816) >> 7) * 256 + 128 + ((n0 - 2816) & 127));
#pragma unroll 8
    for (int i = 0; i < 32; ++i) { const int kk = 2 * i + (lane >> 5); scr[kk * 33 + (lane & 31)] = W[(size_t)(k0 + kk) * N + n0 + (lane & 31)]; }
    asm volatile("s_waitcnt lgkmcnt(0)" ::: "memory");
    const int c = lane & 7;
#pragma unroll
    for (int j = 0; j < 4; ++j) { const int n = (lane >> 3) + 8 * j; const LAS float* s = scr + (8 * c) * 33 + n;
        v4u o; o.x = pk2(s[0 * 33], s[1 * 33]); o.y = pk2(s[2 * 33], s[3 * 33]); o.z = pk2(s[4 * 33], s[5 * 33]); o.w = pk2(s[6 * 33], s[7 * 33]);
        *(v4u*)(WT + (size_t)(r0 + n) * K + k0 + 8 * c) = o; }
    asm volatile("s_waitcnt lgkmcnt(0)" ::: "memory");
}

__device__ __forceinline__ float* xrow(float* xlat, float* xctx, int row) { return row < NLAT ? xlat + (size_t)row * DMOD : xctx + (size_t)(row - NLAT) * DMOD; }
__device__ __forceinline__ int modv(int row) { return row < NLAT ? (row >> 12) : 4; }

__device__ __forceinline__ void norm_row(const float* src, float* dstcopy, bf16* xn, const float* g, const float* shift, const float* scale, int lane) {
    const f32x4* xr = (const f32x4*)src + lane;
    f32x4 v[4]; float s = 0.f;
#pragma unroll
    for (int j = 0; j < 4; ++j) { v[j] = xr[64 * j]; s += (v[j].x * v[j].x + v[j].y * v[j].y) + (v[j].z * v[j].z + v[j].w * v[j].w); }
    if (dstcopy) {
#pragma unroll
        for (int j = 0; j < 4; ++j) ((f32x4*)dstcopy + lane)[64 * j] = v[j];
    }
    const float rstd = __builtin_amdgcn_rsqf(wave_sum(s) * (1.f / DMOD) + 1e-6f);
    unsigned long long* o8 = (unsigned long long*)xn + lane;
#pragma unroll
    for (int j = 0; j < 4; ++j) {
        const f32x4 gg = ((const f32x4*)g + lane)[64 * j], sh = ((const f32x4*)shift + lane)[64 * j], sc = ((const f32x4*)scale + lane)[64 * j];
        const f32x4 y = (v[j] * rstd) * gg * (sc + 1.0f) + sh;
        o8[64 * j] = (unsigned long long)pk2(y.x, y.y) | ((unsigned long long)pk2(y.z, y.w) << 32);
    }
}
__device__ __forceinline__ void ssm_tables(const Args& a, LAS unsigned char* lds, int layer, int g, int tid) {
    LAS float* pw = (LAS float*)lds;
    LAS float* bbs = pw + 4352;
    LAS float* cs = bbs + 4096;
    LAS float* G = cs + 4096;
    if (tid < 128) {
        const int dir = tid >> 6, n = tid & 63; const int gi = (layer * 2 + dir) * 32 + g; const int idx = gi * 64 + n;
        const float lr = a.in[10][idx], li = a.in[11][idx], dt = expf(a.in[12][gi]);
        for (int e = 0; e <= 16; ++e) { const float mag = expf(lr * dt * (float)e), ang = li * dt * (float)e;
            pw[((dir * 17 + e) * 64 + n) * 2] = mag * cosf(ang); pw[((dir * 17 + e) * 64 + n) * 2 + 1] = mag * sinf(ang); }
        const float mag1 = expf(lr * dt); const float are = mag1 * cosf(li * dt), aim = mag1 * sinf(li * dt), den = lr * lr + li * li;
        const float fre = ((are - 1.f) * lr + aim * li) / den, fim = (aim * lr - (are - 1.f) * li) / den;
        for (int q = 0; q < 16; ++q) { const float br = a.in[13][(size_t)idx * 16 + q], bi = a.in[14][(size_t)idx * 16 + q];
            bbs[((dir * 64 + n) * 16 + q) * 2] = fre * br - fim * bi; bbs[((dir * 64 + n) * 16 + q) * 2 + 1] = fre * bi + fim * br; }
    }
    for (int i = tid; i < 2048; i += 512) { const int dir = i >> 10, p = (i >> 6) & 15, n = i & 63; const size_t src = ((size_t)((layer * 2 + dir) * 32 + g) * 16 + p) * 64 + n;
        cs[2 * i] = a.in[15][src]; cs[2 * i + 1] = a.in[16][src]; }
    __syncthreads();
    for (int i = tid; i < 8192; i += 512) { const int dir = i >> 12, l = (i >> 8) & 15, p = (i >> 4) & 15, q = i & 15; float sum = 0.f;
        for (int n = 0; n < 64; ++n) { const float cr = cs[((dir * 16 + p) * 64 + n) * 2], ci = cs[((dir * 16 + p) * 64 + n) * 2 + 1];
            const float ar = pw[((dir * 17 + l) * 64 + n) * 2], ai = pw[((dir * 17 + l) * 64 + n) * 2 + 1];
            const float br = bbs[((dir * 64 + n) * 16 + q) * 2], bi = bbs[((dir * 64 + n) * 16 + q) * 2 + 1];
            const float zr = cr * ar - ci * ai, zi = cr * ai + ci * ar; sum += zr * br - zi * bi; }
        G[i] = sum; }
    __syncthreads();
    bf16* Mt = (bf16*)(a.ws + WS_MTOT) + (size_t)(layer * 32 + g) * 256 * 512;
    for (int i = tid; i < 16384; i += 512) { const int row = i >> 6, k0 = (i & 63) * 8, t = row >> 4, p = row & 15; float v[8];
        if (k0 < 256) { const int sp = k0 >> 4, q0 = k0 & 15;
#pragma unroll
            for (int jj = 0; jj < 8; ++jj) { const int q = q0 + jj; float x = 0.f;
                if (sp <= t) x += G[((0 * 16 + (t - sp)) * 16 + p) * 16 + q];
                if (sp >= t) x += G[((1 * 16 + (sp - t)) * 16 + p) * 16 + q];
                if (sp == t && p == q) x += a.in[17][(layer * 32 + g) * 16 + p];
                v[jj] = x; }
        } else {
#pragma unroll
            for (int jj = 0; jj < 8; ++jj) { const int nn = k0 - 256 + jj, dir = nn >> 7, comp = (nn >> 6) & 1, n = nn & 63, e = dir == 0 ? t + 1 : 16 - t;
                const float cr = cs[((dir * 16 + p) * 64 + n) * 2], ci = cs[((dir * 16 + p) * 64 + n) * 2 + 1];
                const float ar = pw[((dir * 17 + e) * 64 + n) * 2], ai = pw[((dir * 17 + e) * 64 + n) * 2 + 1];
                v[jj] = comp == 0 ? (cr * ar - ci * ai) : -(cr * ai + ci * ar); }
        }
        v4u o; o.x = pk2(v[0], v[1]); o.y = pk2(v[2], v[3]); o.z = pk2(v[4], v[5]); o.w = pk2(v[6], v[7]);
        *(v4u*)(Mt + (size_t)row * 512 + k0) = o; }
    bf16* Pf = (bf16*)(a.ws + WS_PFPR) + (size_t)(layer * 32 + g) * 256 * 256;
    for (int i = tid; i < 8192; i += 512) { const int nn = i >> 5, k0 = (i & 31) * 8, sp = k0 >> 4, q0 = k0 & 15, dir = nn >> 7, comp = (nn >> 6) & 1, n = nn & 63, e = dir == 0 ? 15 - sp : sp;
        const float ar = pw[((dir * 17 + e) * 64 + n) * 2], ai = pw[((dir * 17 + e) * 64 + n) * 2 + 1]; float v[8];
#pragma unroll
        for (int jj = 0; jj < 8; ++jj) { const float br = bbs[((dir * 64 + n) * 16 + q0 + jj) * 2], bi = bbs[((dir * 64 + n) * 16 + q0 + jj) * 2 + 1];
            v[jj] = comp == 0 ? (ar * br - ai * bi) : (ar * bi + ai * br); }
        v4u o; o.x = pk2(v[0], v[1]); o.y = pk2(v[2], v[3]); o.z = pk2(v[4], v[5]); o.w = pk2(v[6], v[7]);
        *(v4u*)(Pf + (size_t)nn * 256 + k0) = o; }
    if (tid < 128) { const int dir = tid >> 6, n = tid & 63; float* A16 = (float*)(a.ws + WS_A16);
        A16[(((layer * 32 + g) * 2 + dir) * 64 + n) * 2] = pw[((dir * 17 + 16) * 64 + n) * 2]; A16[(((layer * 32 + g) * 2 + dir) * 64 + n) * 2 + 1] = pw[((dir * 17 + 16) * 64 + n) * 2 + 1]; }
    __syncthreads();
}

__device__ __forceinline__ void gemv_item(const float* W, int N, int n0, const LAS float* sv, LAS float* red, float* out, int ostride, const float* badd, int tid) {
    typedef float f32x2 __attribute__((ext_vector_type(2)));
    const int lane = tid & 63, wave = tid >> 6; const float* Wp = W + (size_t)(wave * 128) * N + n0 + 2 * lane;
    float acc[5][2];
#pragma unroll
    for (int v = 0; v < 5; ++v) { acc[v][0] = 0.f; acc[v][1] = 0.f; }
    for (int k0 = 0; k0 < 128; k0 += 16) {
        f32x2 w[16];
#pragma unroll
        for (int j = 0; j < 16; ++j) w[j] = *(const f32x2*)(Wp + (size_t)(k0 + j) * N);
#pragma unroll
        for (int j = 0; j < 16; ++j)
#pragma unroll
            for (int v = 0; v < 5; ++v) { const float sx = sv[v * 1024 + wave * 128 + k0 + j]; acc[v][0] += sx * w[j].x; acc[v][1] += sx * w[j].y; }
    }
#pragma unroll
    for (int v = 0; v < 5; ++v) { red[(wave * 5 + v) * 128 + 2 * lane] = acc[v][0]; red[(wave * 5 + v) * 128 + 2 * lane + 1] = acc[v][1]; }
    __syncthreads();
    for (int i = tid; i < 5 * 128; i += 512) { const int v = i >> 7, c = i & 127; float sum = badd ? badd[n0 + c] : 0.f;
#pragma unroll
        for (int w8 = 0; w8 < 8; ++w8) sum += red[(w8 * 5 + v) * 128 + c];
        out[(size_t)v * ostride + n0 + c] = sum; }
    __syncthreads();
}
__device__ __forceinline__ void p0_phase(const Args& a, LAS unsigned char* lds, int tid) {
    LAS float* sv = (LAS float*)lds;
    LAS float* red = sv + 5 * 1024;
    for (int i = tid; i < 5 * 1024; i += 512) { const int v = i >> 10, k = i & 1023; const float x = v < 4 ? a.in[1][v * 1024 + k] : a.in[3][k]; sv[i] = silu_f(x); }
    __syncthreads();
    float* mod = (float*)(a.ws + WS_MOD);
    const int G0 = ogrid(), half0 = G0 >= 256 ? 128 : 0;
    if (obid() < half0 || half0 == 0) { for (int it = obid(); it < DEPTH * 32; it += (half0 ? half0 : G0)) ssm_tables(a, lds + 49152, it >> 5, it & 31, tid); }
    for (int it = (half0 ? obid() - half0 : obid()); it >= 0 && it < DEPTH * 48; it += (half0 ? G0 - half0 : G0)) {
        const int l = it / 48, n0 = (it % 48) * 128;
        gemv_item(a.in[4] + (size_t)l * 1024 * 6144, 6144, n0, sv, red, mod + (size_t)l * 5 * 6144, 6144, a.in[5] + l * 6144, tid);
    }
    if (obid() == ogrid() - 1) {
        float* rt = (float*)(a.ws + WS_ROPE);
        for (int i = tid; i < 1024; i += 512) { const int p = i >> 4, f = i & 15; const float fr = powf(10000.0f, -(float)f / 16.0f); const float ang = (float)p * fr;
            rt[i] = cosf(ang); rt[1024 + i] = sinf(ang); }
    }
}

__device__ __forceinline__ void p1_phase(const Args& a, LAS unsigned char* lds, int tid) {
    LAS float* sv = (LAS float*)lds;
    LAS float* red = sv + 5 * 1024;
    const float* mod = (const float*)(a.ws + WS_MOD); float* cs = (float*)(a.ws + WS_CS);
    for (int i = obid() * 512 + tid; i < DEPTH * 2 * 5 * 1024; i += ogrid() * 512) { const int k = i & 1023, v = (i >> 10) % 5, which = (i / 5120) & 1, l = i / 10240;
        const float g = which == 0 ? a.in[6][l * 1024 + k] : a.in[22][l * 1024 + k]; cs[i] = g * (1.0f + mod[((size_t)l * 5 + v) * 6144 + (which == 0 ? 1024 : 4096) + k]); }
    for (int it = obid(); it < DEPTH * 54; it += ogrid()) {
        const int l = it / 54, r = it % 54; const bool up = r >= 10; const int n0 = (up ? r - 10 : r) * 128, N = up ? 5632 : 1280;
        for (int i = tid; i < 5 * 1024; i += 512) sv[i] = mod[((size_t)l * 5 + (i >> 10)) * 6144 + (up ? 3072 : 0) + (i & 1023)];
        __syncthreads();
        float* bo = up ? (float*)(a.ws + WS_BIASUP) + (size_t)l * 5 * 5632 : (float*)(a.ws + WS_BIASIN) + (size_t)l * 5 * 1280;
        gemv_item(up ? a.in[23] + (size_t)l * 1024 * 5632 : a.in[7] + (size_t)l * 1024 * 1280, N, n0, sv, red, bo, N, nullptr, tid);
    }
}

__device__ __forceinline__ void prep_row(const float* src, float* dstcopy, bf16* xt, const float* gnorm, const float* scl, float* ssq, int lane) {
    const f32x4* xr = (const f32x4*)src + lane; f32x4 v[4]; float s = 0.f;
#pragma unroll
    for (int j = 0; j < 4; ++j) { v[j] = xr[64 * j]; s += (v[j].x * v[j].x + v[j].y * v[j].y) + (v[j].z * v[j].z + v[j].w * v[j].w); }
#pragma unroll
    for (int j = 0; j < 4; ++j) ((f32x4*)dstcopy + lane)[64 * j] = v[j];
    s = wave_sum(s);
    if (lane < 16) ssq[lane] = lane == 0 ? s : 0.f;
    unsigned long long* o8 = (unsigned long long*)xt + lane;
#pragma unroll
    for (int j = 0; j < 4; ++j) { const f32x4 y = v[j] * (((const f32x4*)gnorm + lane)[64 * j] * (((const f32x4*)scl + lane)[64 * j] + 1.0f)); o8[64 * j] = (unsigned long long)pk2(y.x, y.y) | ((unsigned long long)pk2(y.z, y.w) << 32); }
}
__device__ __forceinline__ void transposes_range(const Args& a, LAS unsigned char* lds, int layer, int lo, int hi, int gw, int NGW, int lane, int wave) {
    LAS float* scr = (LAS float*)(lds + wave * 16384);
    constexpr int I_IN = 16 * 40, I_GLU = 8 * 16, I_OUT = 16 * 32, I_UP = 16 * 176;
    for (int it = lo + gw; it < hi; it += NGW) {
        int r = it;
        if (r < I_IN) { transpose_item(a.in[7] + (size_t)layer * 1024 * 1280, 1024, 1280, (bf16*)(a.ws + WS_WIN), scr, r, lane, 2); continue; } r -= I_IN;
        if (r < I_GLU) { transpose_item(a.in[18] + (size_t)layer * 512 * 512, 512, 512, (bf16*)(a.ws + WS_WGLU), scr, r, lane); continue; } r -= I_GLU;
        if (r < I_OUT) { transpose_item(a.in[21] + (size_t)layer * 1024 * 1024, 1024, 1024, (bf16*)(a.ws + WS_WOUT), scr, r, lane); continue; } r -= I_OUT;
        if (r < I_UP) { transpose_item(a.in[23] + (size_t)layer * 1024 * 5632, 1024, 5632, (bf16*)(a.ws + WS_WUP), scr, r, lane, 1); continue; } r -= I_UP;
        transpose_item(a.in[26] + (size_t)layer * 2816 * 1024, 2816, 1024, (bf16*)(a.ws + WS_WDN), scr, r, lane);
    }
}
__device__ __forceinline__ void combine_row(const Args& a, int layer, int r, int lane) {
    float* xc = (float*)(a.ws + WS_XC); bf16* xn = (bf16*)(a.ws + WS_XN) + (size_t)NLAT * DMOD; float* ssq = (float*)(a.ws + WS_SSQ1) + (size_t)NLAT * 16;
    const float* csv = (const float*)(a.ws + WS_CS) + ((size_t)(layer * 2) * 5 + 4) * 1024; const float* gate = (const float*)(a.ws + WS_MOD) + ((size_t)(layer - 1) * 5 + 4) * 6144 + 5120;
    const float* P = (const float*)(a.ws + WS_PART);
    float s = 0.f;
#pragma unroll
    for (int j = 0; j < 4; ++j) { const int col = 4 * lane + 256 * j; f32x4 p = *(const f32x4*)(P + (size_t)r * 1024 + col);
#pragma unroll
        for (int ks = 1; ks < 11; ++ks) p = p + *(const f32x4*)(P + ((size_t)ks * 1024 + r) * 1024 + col);
        f32x4 x = *(const f32x4*)(xc + (size_t)r * 1024 + col) + *(const f32x4*)(gate + col) * p; *(f32x4*)(xc + (size_t)r * 1024 + col) = x;
        s += (x.x * x.x + x.y * x.y) + (x.z * x.z + x.w * x.w); const f32x4 y = x * *(const f32x4*)(csv + col);
        *(unsigned long long*)(xn + (size_t)r * 1024 + col) = (unsigned long long)pk2(y.x, y.y) | ((unsigned long long)pk2(y.z, y.w) << 32); }
    s = wave_sum(s);
    if (lane < 16) ssq[(size_t)r * 16 + lane] = lane == 0 ? s : 0.f;
}
__device__ __forceinline__ void prep_phase(const Args& a, LAS unsigned char* lds, int layer, int tid, int lane, int wave) {
    const int gw = obid() * 8 + wave, NGW = ogrid() * 8;
    transposes_range(a, lds, layer, 0, 5504, gw, NGW, lane, wave);
    float* xc = (float*)(a.ws + WS_XC); bf16* xn = (bf16*)(a.ws + WS_XN); float* ssq = (float*)(a.ws + WS_SSQ1);
    for (int row = gw; row < NTOK; row += NGW) {
        const float* src = row < NLAT ? a.in[0] + (size_t)row * DMOD : a.in[2] + (size_t)(row - NLAT) * DMOD;
        prep_row(src, xrow(a.out, xc, row), xn + (size_t)row * DMOD, a.in[6], (const float*)(a.ws + WS_MOD) + (size_t)modv(row) * 6144 + 1024, ssq + (size_t)row * 16, lane);
    }
}

__device__ __forceinline__ int tokrow(int b, int c) { return c < 16 ? NLAT + b * 256 + 16 * c : b * 4096 + 16 * (c - 16); }
__device__ __forceinline__ void ssm_unit(const Args& a, LAS unsigned char* lds3, int layer, int b, int g) {
    const int tid = otid(), lane = tid & 63, wave = __builtin_amdgcn_readfirstlane(tid >> 6);
    const bf16* proj = (const bf16*)(a.ws + WS_PROJ) + 16 * g;
    const bf16* Pf = (const bf16*)(a.ws + WS_PFPR) + (size_t)(layer * 32 + g) * 256 * 256;
    const bf16* Mt = (const bf16*)(a.ws + WS_MTOT) + (size_t)(layer * 32 + g) * 256 * 512;
    const int unit = b * 32 + g;
    float* Sscr = (float*)(a.ws + WS_SSCR) + (size_t)unit * 272 * 256;
    bf16* Hin = (bf16*)(a.ws + WS_HIN) + (size_t)unit * 272 * 256;
    bf16* Z = (bf16*)(a.ws + WS_Z);
    const int i = lane & 15, kb = lane >> 4, sp_lo = kb >> 1, q0 = 8 * (kb & 1);
    const int lr = tid >> 5, lp = tid & 31;
    LAS unsigned char* ubuf = lds3;
    LAS unsigned char* hbuf = lds3 + 2 * 8448;
    {
        bf16x8 pf[2][8];
#pragma unroll
        for (int j = 0; j < 2; ++j)
#pragma unroll
            for (int ks = 0; ks < 8; ++ks) pf[j][ks] = *(const bf16x8*)(Pf + (size_t)(32 * wave + 16 * j + i) * 256 + 32 * ks + 8 * kb);
        v4u nx = *(const v4u*)(proj + ((size_t)tokrow(b, lr) + (lp >> 1)) * 512 + 8 * (lp & 1));
        for (int mt = 0; mt < 17; ++mt) {
            LAS unsigned char* ub = ubuf + (mt & 1) * 8448;
            *(LAS v4u*)(ub + lr * 528 + lp * 16) = nx;
            { const int mtn = mt < 16 ? mt + 1 : 16; nx = *(const v4u*)(proj + ((size_t)tokrow(b, 16 * mtn + lr) + (lp >> 1)) * 512 + 8 * (lp & 1)); }
            __syncthreads();
            pg8::f32x4 acc0 = {0.f, 0.f, 0.f, 0.f}, acc1 = {0.f, 0.f, 0.f, 0.f};
#pragma unroll
            for (int ks = 0; ks < 8; ++ks) { const bf16x8 af = *(const LAS bf16x8*)(ub + i * 528 + (32 * ks + 8 * kb) * 2);
                acc0 = __builtin_amdgcn_mfma_f32_16x16x32_bf16(af, pf[0][ks], acc0, 0, 0, 0); acc1 = __builtin_amdgcn_mfma_f32_16x16x32_bf16(af, pf[1][ks], acc1, 0, 0, 0); }
#pragma unroll
            for (int r = 0; r < 4; ++r) { float* sp = Sscr + (size_t)(16 * mt + 4 * kb + r) * 256 + 32 * wave + i; sp[0] = acc0[r]; sp[16] = acc1[r]; }
        }
    }
    __syncthreads();
    if (wave < 2) {
        const int dir = wave, n = lane; const float* A16 = (const float*)(a.ws + WS_A16) + (((layer * 32 + g) * 2 + dir) * 64 + n) * 2;
        const float ar = A16[0], ai = A16[1]; float hr = 0.f, hi = 0.f;
        const float* sb = Sscr + dir * 128 + n; bf16* hb = Hin + dir * 128 + n;
        float sr[16], si[16], tr[16], ti[16];
#pragma unroll
        for (int j = 0; j < 16; ++j) { const int c = dir == 0 ? j : 15 - j; sr[j] = sb[(size_t)c * 256]; si[j] = sb[(size_t)c * 256 + 64]; }
        for (int s0 = 0; s0 < 272; s0 += 16) {
            const int s1 = s0 + 16 < 272 ? s0 + 16 : s0;
#pragma unroll
            for (int j = 0; j < 16; ++j) { const int st = s1 + j; const int c = dir == 0 ? st : (st < 16 ? 15 - st : 287 - st); tr[j] = sb[(size_t)c * 256]; ti[j] = sb[(size_t)c * 256 + 64]; }
#pragma unroll
            for (int j = 0; j < 16; ++j) { const int st = s0 + j; const int c = dir == 0 ? st : (st < 16 ? 15 - st : 287 - st);
                hb[(size_t)c * 256] = (bf16)(pk2(hr, 0.f) & 0xffffu); hb[(size_t)c * 256 + 64] = (bf16)(pk2(hi, 0.f) & 0xffffu);
                const float nr = ar * hr - ai * hi + sr[j], ni = ar * hi + ai * hr + si[j]; hr = nr; hi = ni; }
#pragma unroll
            for (int j = 0; j < 16; ++j) { sr[j] = tr[j]; si[j] = ti[j]; }
        }
    }
    __syncthreads();
    {
        bf16x8 mf[2][16];
#pragma unroll
        for (int j = 0; j < 2; ++j)
#pragma unroll
            for (int ks = 0; ks < 16; ++ks) mf[j][ks] = *(const bf16x8*)(Mt + (size_t)(32 * wave + 16 * j + i) * 512 + 32 * ks + 8 * kb);
        v4u nx = *(const v4u*)(proj + ((size_t)tokrow(b, lr) + (lp >> 1)) * 512 + 8 * (lp & 1));
        v4u nh = *(const v4u*)(Hin + (size_t)lr * 256 + 8 * lp);
        for (int mt = 0; mt < 17; ++mt) {
            LAS unsigned char* ub = ubuf + (mt & 1) * 8448; LAS unsigned char* hb2 = hbuf + (mt & 1) * 8448;
            *(LAS v4u*)(ub + lr * 528 + lp * 16) = nx; *(LAS v4u*)(hb2 + lr * 528 + lp * 16) = nh;
            { const int mtn = mt < 16 ? mt + 1 : 16; nx = *(const v4u*)(proj + ((size_t)tokrow(b, 16 * mtn + lr) + (lp >> 1)) * 512 + 8 * (lp & 1));
              nh = *(const v4u*)(Hin + (size_t)(16 * mtn + lr) * 256 + 8 * lp); }
            __syncthreads();
            const size_t rb = (size_t)tokrow(b, 16 * mt + i);
            pg8::f32x4 acc0 = {0.f, 0.f, 0.f, 0.f}, acc1 = {0.f, 0.f, 0.f, 0.f};
#pragma unroll
            for (int ks = 0; ks < 16; ++ks) { const bf16x8 af = ks < 8 ? *(const LAS bf16x8*)(ub + i * 528 + (32 * ks + 8 * kb) * 2) : *(const LAS bf16x8*)(hb2 + i * 528 + (32 * (ks - 8) + 8 * kb) * 2);
                acc0 = __builtin_amdgcn_mfma_f32_16x16x32_bf16(mf[0][ks], af, acc0, 0, 0, 0); acc1 = __builtin_amdgcn_mfma_f32_16x16x32_bf16(mf[1][ks], af, acc1, 0, 0, 0); }
            bf16* zp = Z + (rb + 2 * wave) * 512 + 16 * g + 4 * kb;
            { v2u o; o.x = pk2(gelu_tanh(acc0[0]), gelu_tanh(acc0[1])); o.y = pk2(gelu_tanh(acc0[2]), gelu_tanh(acc0[3])); *(v2u*)zp = o; }
            { v2u o; o.x = pk2(gelu_tanh(acc1[0]), gelu_tanh(acc1[1])); o.y = pk2(gelu_tanh(acc1[2]), gelu_tanh(acc1[3])); *(v2u*)(zp + 512) = o; }
        }
    }
    __syncthreads();
}

__device__ __forceinline__ void merge_rows(const Args& a, int layer, int lane, int gw, int NGW, int row_lo, int nrows) {
    const bf16* qo = (const bf16*)(a.ws + WS_O); const bf16* so = (const bf16*)(a.ws + WS_SSMO); bf16* xn = (bf16*)(a.ws + WS_XN);
    const float* gn = a.in[20] + layer * 1024;
    for (int row = row_lo + gw; row < nrows; row += NGW) {
#pragma unroll
        for (int h = 0; h < 2; ++h) {
            const v4u w = *(const v4u*)((h == 0 ? qo : so) + (size_t)row * 512 + 8 * lane);
            float v[8] = {bflo(w.x), bfhi(w.x), bflo(w.y), bfhi(w.y), bflo(w.z), bfhi(w.z), bflo(w.w), bfhi(w.w)};
            float s = 0.f;
#pragma unroll
            for (int k = 0; k < 8; ++k) s += v[k] * v[k];
            const float rstd = __builtin_amdgcn_rsqf(wave_sum(s) * (1.f / 512.f) + 1e-6f);
            const float* gp = gn + h * 512 + 8 * lane;
            v4u o; o.x = pk2(v[0] * rstd * gp[0], v[1] * rstd * gp[1]); o.y = pk2(v[2] * rstd * gp[2], v[3] * rstd * gp[3]);
            o.z = pk2(v[4] * rstd * gp[4], v[5] * rstd * gp[5]); o.w = pk2(v[6] * rstd * gp[6], v[7] * rstd * gp[7]);
            *(v4u*)(xn + (size_t)row * 1024 + h * 512 + 8 * lane) = o;
        }
    }
}

__device__ __forceinline__ void fix_phase(const Args& a, int layer, int tid) {
    bf16* hf = (bf16*)(a.ws + WS_HFFN); const float* side = (const float*)(a.ws + WS_SIDE);
    const float* cw = a.in[24] + (size_t)layer * 3 * DFF2;
    for (int it = obid() * 512 + tid; it < 60 * 2 * 704; it += ogrid() * 512) {
        const int c = (it % 704) * 4, r = it / 704, kind = r & 1, bi = r >> 1, pm = (bi / 15) * 16 + (bi % 15) + 1;
        pg8::f32x4 oa, og; size_t row;
        if (kind == 0) { const float* pf = side + ((size_t)pm * 4 + 1) * 5632; const float* rl = side + ((size_t)(pm - 1) * 4 + 2) * 5632; row = (size_t)pm * 256;
            oa = *(const pg8::f32x4*)(pf + c) + *(const pg8::f32x4*)(cw + c) * *(const pg8::f32x4*)(rl + c);
            og = *(const pg8::f32x4*)(pf + 2816 + c) + *(const pg8::f32x4*)(cw + 2816 + c) * *(const pg8::f32x4*)(rl + 2816 + c); }
        else { const float* pl = side + ((size_t)(pm - 1) * 4 + 3) * 5632; const float* rf = side + ((size_t)pm * 4 + 0) * 5632; row = (size_t)pm * 256 - 1;
            oa = *(const pg8::f32x4*)(pl + c) + *(const pg8::f32x4*)(cw + 2 * 5632 + c) * *(const pg8::f32x4*)(rf + c);
            og = *(const pg8::f32x4*)(pl + 2816 + c) + *(const pg8::f32x4*)(cw + 2 * 5632 + 2816 + c) * *(const pg8::f32x4*)(rf + 2816 + c); }
        v2u o; o.x = pk2(silu_f(og[0]) * oa[0], silu_f(og[1]) * oa[1]); o.y = pk2(silu_f(og[2]) * oa[2], silu_f(og[3]) * oa[3]);
        *(v2u*)(hf + row * DFF + c) = o;
    }
}

__device__ __forceinline__ void fix_tile(const Args& a, int layer, int pm, int tid) {
    bf16* hf = (bf16*)(a.ws + WS_HFFN); const float* side = (const float*)(a.ws + WS_SIDE);
    const float* cw = a.in[24] + (size_t)layer * 3 * DFF2;
    for (int it = tid; it < 2 * 704; it += 512) {
        const int c = (it % 704) * 4, kind = it / 704;
        if (kind == 0 ? (pm & 15) == 0 : (pm & 15) == 15) continue;
        pg8::f32x4 oa, og; size_t row;
        if (kind == 0) { const float* pf = side + ((size_t)pm * 4 + 1) * 5632; const float* rl = side + ((size_t)(pm - 1) * 4 + 2) * 5632; row = (size_t)pm * 256;
            oa = *(const pg8::f32x4*)(pf + c) + *(const pg8::f32x4*)(cw + c) * *(const pg8::f32x4*)(rl + c);
            og = *(const pg8::f32x4*)(pf + 2816 + c) + *(const pg8::f32x4*)(cw + 2816 + c) * *(const pg8::f32x4*)(rl + 2816 + c); }
        else { const float* pl = side + ((size_t)pm * 4 + 3) * 5632; const float* rf = side + ((size_t)(pm + 1) * 4 + 0) * 5632; row = (size_t)pm * 256 + 255;
            oa = *(const pg8::f32x4*)(pl + c) + *(const pg8::f32x4*)(cw + 2 * 5632 + c) * *(const pg8::f32x4*)(rf + c);
            og = *(const pg8::f32x4*)(pl + 2816 + c) + *(const pg8::f32x4*)(cw + 2 * 5632 + 2816 + c) * *(const pg8::f32x4*)(rf + 2816 + c); }
        v2u o; o.x = pk2(silu_f(og[0]) * oa[0], silu_f(og[1]) * oa[1]); o.y = pk2(silu_f(og[2]) * oa[2], silu_f(og[3]) * oa[3]);
        *(v2u*)(hf + row * DFF + c) = o;
    }
    asm volatile("s_waitcnt vmcnt(0)" ::: "memory"); __syncthreads();
}

#define RLX_AGENT __ATOMIC_RELAXED, __HIP_MEMORY_SCOPE_AGENT
#define XB_TMO      128
#define XB_XCNT(j)  (256  + 64 * (j))
#define XB_XSUB(j)  (1280 + 64 * (j))
#define XB_XGEN(j)  (2304 + 64 * (j))
#define XB_TOP      3328
#define XB_TOPGEN   3392
#define XCD_BAR_WORDS 3456
#define XB_SPIN_CAP (1u << 18)

__device__ __forceinline__ unsigned xb_ld(unsigned* p)              { return __hip_atomic_load(p, __ATOMIC_RELAXED, __HIP_MEMORY_SCOPE_AGENT); }
__device__ __forceinline__ unsigned xb_add(unsigned* p, unsigned v) { return __hip_atomic_fetch_add(p, v, __ATOMIC_RELAXED, __HIP_MEMORY_SCOPE_AGENT); }
__device__ __forceinline__ unsigned xb_xcc_id() { return (unsigned)__builtin_amdgcn_s_getreg((3 << 11) | 20) & 0xFu; }
#define XB_SPIN(cond, bar) do { unsigned _sp = 0; while (cond) { __builtin_amdgcn_s_sleep(1); \
    if ((++_sp & 255u) == 0u) { if (xb_ld(&(bar)[XB_TMO])) break; if (_sp > XB_SPIN_CAP) { atomicAdd(&(bar)[XB_TMO], 1u); break; } } } } while (0)

struct XcdBarrier {
    unsigned* bar; unsigned x;
    volatile LAS unsigned* st;
};

__device__ __forceinline__ XcdBarrier xcd_barrier_post(unsigned* bar, volatile LAS unsigned* st) {
    XcdBarrier b; b.bar = bar; b.x = xb_xcc_id(); b.st = st;
    if (otid() == 0) (void)xb_add(&bar[XB_XCNT(b.x)], 1u);
    return b;
}
__device__ __forceinline__ void xcd_barrier_complete(unsigned* bar, unsigned x, unsigned& nloc, unsigned& nx) {
    const unsigned G = (unsigned)ogrid();
    unsigned sum, cnt, mine, sp = 0u;
    for (;;) {
        sum = 0u; cnt = 0u; mine = 0u;
#pragma unroll
        for (unsigned j = 0; j < 16; ++j) { const unsigned c = xb_ld(&bar[XB_XCNT(j)]); sum += c; cnt += (c > 0u) ? 1u : 0u; mine = (j == x) ? c : mine; }
        if (sum == G) break;
        __builtin_amdgcn_s_sleep(1);
        if ((++sp & 255u) == 0u) { if (xb_ld(&bar[XB_TMO])) break; if (sp > XB_SPIN_CAP) { atomicAdd(&bar[XB_TMO], 1u); break; } }
    }
    nloc = mine > 0u ? mine : 1u; nx = cnt > 0u ? cnt : 1u;
}

__device__ __forceinline__ void xcd_barrier(const XcdBarrier& b) {
    asm volatile("s_waitcnt vmcnt(0)" ::: "memory");
    __syncthreads();
    if (otid() == 0) {
        unsigned* bar = b.bar;
        __builtin_amdgcn_s_waitcnt(0);
        unsigned nloc = b.st[0], nx = b.st[1];
        if (nloc == 0u) { xcd_barrier_complete(bar, b.x, nloc, nx); b.st[0] = nloc; b.st[1] = nx; }
        const unsigned old = xb_add(&bar[XB_XSUB(b.x)], 1u);
        const unsigned gen = old / nloc;
        if (old + 1u == (gen + 1u) * nloc) {
            __builtin_amdgcn_fence(__ATOMIC_RELEASE, "agent");
            asm volatile("s_waitcnt vmcnt(0)" ::: "memory");
            const unsigned og = xb_add(&bar[XB_TOP], 1u);
            const unsigned tg = og / nx;
            if (og + 1u == (tg + 1u) * nx) xb_add(&bar[XB_TOPGEN], 1u);
            else XB_SPIN(xb_ld(&bar[XB_TOPGEN]) == tg, bar);
            __builtin_amdgcn_fence(__ATOMIC_ACQUIRE, "agent");
            xb_add(&bar[XB_XGEN(b.x)], 1u);
            asm volatile("s_waitcnt vmcnt(0)" ::: "memory");
        } else {
            XB_SPIN(xb_ld(&bar[XB_XGEN(b.x)]) == gen, bar);
            __builtin_amdgcn_fence(__ATOMIC_ACQUIRE, "agent");
            asm volatile("s_waitcnt vmcnt(0)" ::: "memory");
        }
    }
    __syncthreads();
}

__device__ __forceinline__ void merge_rows8(const Args& a, int layer, int lane, int row0) {
    const bf16* qo = (const bf16*)(a.ws + WS_O); const bf16* so = (const bf16*)(a.ws + WS_SSMO); bf16* xn = (bf16*)(a.ws + WS_XN);
    const float* gn = a.in[20] + layer * 1024;
    v4u w[8][2];
#pragma unroll
    for (int r = 0; r < 8; ++r) { w[r][0] = *(const v4u*)(qo + (size_t)(row0 + r) * 512 + 8 * lane); w[r][1] = *(const v4u*)(so + (size_t)(row0 + r) * 512 + 8 * lane); }
    float g[2][8];
#pragma unroll
    for (int h = 0; h < 2; ++h)
#pragma unroll
        for (int k = 0; k < 8; ++k) g[h][k] = gn[h * 512 + 8 * lane + k];
#pragma unroll
    for (int r = 0; r < 8; ++r)
#pragma unroll
        for (int h = 0; h < 2; ++h) { const v4u ww = w[r][h];
            const float v[8] = {bflo(ww.x), bfhi(ww.x), bflo(ww.y), bfhi(ww.y), bflo(ww.z), bfhi(ww.z), bflo(ww.w), bfhi(ww.w)};
            float s = 0.f;
#pragma unroll
            for (int k = 0; k < 8; ++k) s += v[k] * v[k];
            const float rstd = __builtin_amdgcn_rsqf(wave_sum(s) * (1.f / 512.f) + 1e-6f);
            v4u o; o.x = pk2(v[0] * rstd * g[h][0], v[1] * rstd * g[h][1]); o.y = pk2(v[2] * rstd * g[h][2], v[3] * rstd * g[h][3]);
            o.z = pk2(v[4] * rstd * g[h][4], v[5] * rstd * g[h][5]); o.w = pk2(v[6] * rstd * g[h][6], v[7] * rstd * g[h][7]);
            *(v4u*)(xn + (size_t)(row0 + r) * 1024 + h * 512 + 8 * lane) = o; }
}
__device__ __forceinline__ void publish(unsigned* word) {
    asm volatile("s_waitcnt vmcnt(0)" ::: "memory"); __syncthreads();
    if (otid() == 0) { __builtin_amdgcn_fence(__ATOMIC_RELEASE, "agent"); asm volatile("s_waitcnt vmcnt(0)" ::: "memory"); __hip_atomic_fetch_add(word, 1u, __ATOMIC_RELAXED, __HIP_MEMORY_SCOPE_AGENT); }
}
__device__ __forceinline__ void publish_wt(unsigned* word) {
    asm volatile("s_waitcnt vmcnt(0)" ::: "memory"); __syncthreads();
    if (otid() == 0) __hip_atomic_fetch_add(word, 1u, __ATOMIC_RELAXED, __HIP_MEMORY_SCOPE_AGENT);
}
__device__ __forceinline__ void await(unsigned* word, unsigned target) {
    if (otid() == 0) { unsigned sp = 0; while (__hip_atomic_load(word, __ATOMIC_RELAXED, __HIP_MEMORY_SCOPE_AGENT) < target) { __builtin_amdgcn_s_sleep(80); if (++sp > (1u << 22)) break; }
        __builtin_amdgcn_fence(__ATOMIC_ACQUIRE, "agent"); asm volatile("s_waitcnt vmcnt(0)" ::: "memory"); }
    __syncthreads();
}
__device__ __forceinline__ void mix_phase(const Args& a, unsigned char* lds, int layer, bool ctx_out, int tid, int lane, int wave) {
    unsigned* ctr = (unsigned*)(a.ws + WS_CTL) + 8192 + (size_t)layer * 512;
    volatile LAS unsigned* qs = (volatile LAS unsigned*)((LAS unsigned char*)lds + QS_OFF);
    const int L3 = layer & 3, nmt = ctx_out ? 68 : 64; const int NCMB = L3 > 0 ? 64 : 0, NDN = L3 > 0 ? 528 : 0; const int NIN = 340;
    const int nattn = 640 + (ctx_out ? 32 : 0), i_glu = nattn, i_mrg = i_glu + 2 * nmt, nitems = i_mrg + 8 * nmt;
    const attn_body::bf16* qo = (const attn_body::bf16*)(a.ws + WS_QO); const attn_body::bf16* kall = (const attn_body::bf16*)(a.ws + WS_KALL); const attn_body::bf16* vall = (const attn_body::bf16*)(a.ws + WS_VALL);
    for (;;) {
        __syncthreads();
        if (otid() == 0) qs[0] = atomicAdd(ctr, 1u);
        __syncthreads();
        const int itq = __builtin_amdgcn_readfirstlane((int)qs[0]);
        if (itq >= NCMB + nitems + NIN + NDN) break;
        if (itq < NCMB) {
            const int t2 = otid(), w2 = __builtin_amdgcn_readfirstlane(t2 >> 6);
            for (int k = 0; k < 2; ++k) combine_row(a, L3, itq * 16 + w2 * 2 + k, t2 & 63);
            publish(ctr + 452); continue; }
        if (itq >= NCMB + nitems + NIN) {
            const int t2 = otid(), w2 = __builtin_amdgcn_readfirstlane(t2 >> 6), j = itq - (NCMB + nitems + NIN);
            transposes_range(a, (LAS unsigned char*)lds, L3, 1280 + j * 8, 1280 + j * 8 + 8, w2, 8, t2 & 63, w2); __syncthreads(); continue; }
        const int it0 = itq - NCMB;
        if (it0 < NIN) { const int b = it0 / 85, r = it0 % 85, t = r / 5, pn = r % 5, pm = t < 16 ? 16 * b + t : 64 + b;
            pg8::Gemm g{(const bf16*)(a.ws + WS_XN), (const bf16*)(a.ws + WS_WIN), NTOK, INC, 1024, 1024}; pg8::OneUnit S{pm, pn};
            pg8::EpiIn E{(bf16*)(a.ws + WS_QO), (bf16*)(a.ws + WS_KALL), (bf16*)(a.ws + WS_VALL), (bf16*)(a.ws + WS_PROJ), a.in[8] + L3 * 64, a.in[9] + L3 * 64, (const float*)(a.ws + WS_ROPE),
                          (const float*)(a.ws + WS_SSQ1), (const float*)(a.ws + WS_BIASIN) + (size_t)L3 * 5 * 1280};
            if (NCMB && t == 16) await(ctr + 452, 64u);
            pg8::gemm_phase<pg8::EpiIn, pg8::OneUnit, true, true>((LAS unsigned char*)lds, g, S, E); publish(ctr + 448 + b); continue; }
        const int it = it0 - NIN;
        if (it < 128) { await(ctr + 448 + (it >> 5), 85u); ssm_unit(a, (LAS unsigned char*)lds, L3, it >> 5, it & 31); publish(ctr + 64); }
        else if (it < 640) { const int r = it - 128, hq = r & 3, qb = (r >> 2) & 15, bk = r >> 6, b = bk >> 1, h = (bk & 1) * 4 + hq;
            await(ctr + 448 + b, 85u);
            attn_body::attn_unit<8>((long)b * 4096 + qb * 256, (long)b * 4352, h, 68, qo, kall, vall, (attn_body::bf16*)(a.ws + WS_O), (char*)lds); publish_wt(ctr + 128 + b * 16 + qb); }
        else if (it < nattn) { const int r = it - 640, b = r >> 3, h = r & 7;
            await(ctr + 448 + b, 85u);
            attn_body::attn_unit<8>((long)NLAT + b * 256, (long)b * 4352, h, 4, qo, kall, vall, (attn_body::bf16*)(a.ws + WS_O), (char*)lds); publish_wt(ctr + 128 + 64 + b); }
        else if (it < i_mrg) {
            const int r = it - i_glu; await(ctr + 64, 128u);
            pg8::Gemm g{(const bf16*)(a.ws + WS_Z), (const bf16*)(a.ws + WS_WGLU), NTOK, 512, 512, 512}; pg8::OneUnit S{r >> 1, r & 1};
            pg8::EpiGlu E{(const bf16*)(a.ws + WS_Z), (bf16*)(a.ws + WS_SSMO), a.in[19] + L3 * 512};
            pg8::gemm_phase<pg8::EpiGlu, pg8::OneUnit, true, true>((LAS unsigned char*)lds, g, S, E); publish(ctr + 128 + (r >> 1));
        }
        else {
            int r = it - i_mrg, pm0, npm;
            if (r < 32 * 8) { pm0 = 0; npm = 32; } else { r -= 32 * 8; pm0 = 32; npm = nmt - 32; }
            if (r < 4 * npm) { const int pm = pm0 + (r >> 2); await(ctr + 128 + pm, 10u);
                { const int t2 = otid(); merge_rows8(a, L3, t2 & 63, pm * 256 + (r & 3) * 64 + __builtin_amdgcn_readfirstlane(t2 >> 6) * 8); }
                publish(ctr + 256 + pm); }
            else { r -= 4 * npm; const int pm = pm0 + (r >> 2), pn = r & 3; await(ctr + 256 + pm, 4u);
                pg8::Gemm g{(const bf16*)(a.ws + WS_XN), (const bf16*)(a.ws + WS_WOUT), NTOK, 1024, 1024, 1024}; pg8::OneUnit S{pm, pn};
                pg8::EpiRes E{a.out, (float*)(a.ws + WS_XC), (const float*)(a.ws + WS_MOD) + (size_t)L3 * 5 * 6144 + 2048, (bf16*)(a.ws + WS_XT2), (const float*)(a.ws + WS_CS) + (size_t)(L3 * 2 + 1) * 5 * 1024, (float*)(a.ws + WS_SSQ2)};
                pg8::gemm_phase<pg8::EpiRes, pg8::OneUnit, true, true>((LAS unsigned char*)lds, g, S, E); }
        }
    }
}

typedef const __attribute__((address_space(4))) Args* KArgsP;
__device__ __forceinline__ KArgsP launder(KArgsP p) { asm volatile("" : "+s"(p)); return p; }
__global__ void __launch_bounds__(512, 2) mk_fwd(Args a_unused) {
    unsigned char* const lds = lds_dyn;
    const KArgsP ap0 = (KArgsP)__builtin_amdgcn_kernarg_segment_ptr();
    LAS unsigned char* L = (LAS unsigned char*)lds;
    const int ph_lo = launder(ap0)->ph_lo, ph_hi = launder(ap0)->ph_hi;
    { if ((threadIdx.x & 63) == 0) ((volatile LAS int*)((LAS unsigned char*)lds + WTAB_OFF))[hw_slot()] = (int)(threadIdx.x >> 6);
      __syncthreads(); }
    { volatile LAS unsigned* st = (volatile LAS unsigned*)((LAS unsigned char*)lds + QS_OFF + 64);
      if (otid() < 2) st[otid()] = 0u;
      __syncthreads();
      (void)xcd_barrier_post((unsigned*)(launder(ap0)->ws + WS_CTL) + 4096, st); }
#define XBAR() do { XcdBarrier xb_; xb_.bar = (unsigned*)(launder(ap0)->ws + WS_CTL) + 4096; xb_.x = xb_xcc_id(); xb_.st = (volatile LAS unsigned*)((LAS unsigned char*)lds + QS_OFF + 64); xcd_barrier(xb_); } while (0)
    if (ph_lo == 0) {
#if defined(__HIP_DEVICE_COMPILE__)
        const Args a = *launder(ap0);
#else
        const Args a = a_unused;
#endif
        if (PHON(13)) p0_phase(a, L, otid());
        if (ph_hi < 0) { __syncthreads(); cg::this_grid().sync(); }
        XBAR();
        if (PHON(13)) p1_phase(a, L, otid());
        { const int tid = otid(); prep_phase(a, L, 0, tid, tid & 63, __builtin_amdgcn_readfirstlane(tid >> 6)); }
        XBAR();
    }
    for (int ph = (ph_lo < 3 ? 3 : ph_lo); ph < ph_hi; ++ph) {
      const int nrep_ = 1;
      for (int rep = 0; rep < nrep_; ++rep) {
#if defined(__HIP_DEVICE_COMPILE__)
        const Args& a = *(const Args*)launder(ap0);
#else
        const Args& a = a_unused;
#endif
        const int G = ogrid(), c = obid();
        bf16* xn = (bf16*)(a.ws + WS_XN); float* xc = (float*)(a.ws + WS_XC);
        {
            const int l = (ph - 3) / NSTAGE, s = (ph - 3) % NSTAGE; const bool last = (l == DEPTH - 1); const int nrows = last ? NLAT : NTOK;
            const float* mod = (const float*)(a.ws + WS_MOD) + (size_t)l * 5 * 6144; const float* cs = (const float*)(a.ws + WS_CS);
            bf16* xt2 = (bf16*)(a.ws + WS_XT2); float* ssq1 = (float*)(a.ws + WS_SSQ1); float* ssq2 = (float*)(a.ws + WS_SSQ2);
            if (s == 0) { if (PHON(1)) { const int tid = otid(); mix_phase(a, lds, l + 4 * rep, !last, tid, tid & 63, __builtin_amdgcn_readfirstlane(tid >> 6)); } }
            else if (s == 1) { if (PHON(2)) { pg8::Gemm g{xt2, (const bf16*)(a.ws + WS_WUP), nrows, DFF2, 1024, 1024}; pg8::StaticOrder S; S.init(nrows, DFF2, G, c);
                pg8::EpiConv E{(bf16*)(a.ws + WS_HFFN), a.in[24] + (size_t)l * 3 * DFF2, a.in[25] + (size_t)l * DFF2, (float*)(a.ws + WS_SIDE), (LAS float*)(L + 131072),
                               ssq2, (const float*)(a.ws + WS_BIASUP) + (size_t)l * 5 * 5632, (LAS float*)(L + 136192)};
                pg8::gemm_phase<pg8::EpiConv, pg8::StaticOrder, true, true>(L, g, S, E);
                if (!last) { const int t2 = otid(), w2 = __builtin_amdgcn_readfirstlane(t2 >> 6); transposes_range(a, L, l + 1, 0, 1280, c * 8 + w2, G * 8, t2 & 63, w2); } } }
            else if (PHON(3)) { pg8::Gemm g{(const bf16*)(a.ws + WS_HFFN), (const bf16*)(a.ws + WS_WDN), NLAT, 1024, DFF, DFF}; pg8::StaticOrder S; S.init(NLAT, 1024, G, c);
                if (G == 256) { pg8::Unit u0; if (S.next(0, u0)) fix_tile(a, l, u0.pm, otid()); } else { fix_phase(a, l, otid()); XBAR(); }
                pg8::EpiRes E{a.out, xc, mod + 5120, last ? (bf16*)nullptr : xn, cs + (size_t)((l + 1) * 2) * 5 * 1024, ssq1}; pg8::gemm_phase<pg8::EpiRes, pg8::StaticOrder, true, true>(L, g, S, E);
                if (!last) { pg8::Gemm g2{(const bf16*)(a.ws + WS_HFFN) + (size_t)NLAT * DFF, (const bf16*)(a.ws + WS_WDN), 1024, 1024, 256, DFF}; pg8::SliceOrder S2{G, c};
                    pg8::EpiPart E2{(float*)(a.ws + WS_PART)}; pg8::gemm_phase<pg8::EpiPart, pg8::SliceOrder, true, true>(L, g2, S2, E2); } }
        }
        if (ph + 1 < ph_hi || rep + 1 < nrep_) { XBAR(); for (int q_ = 0; q_ < REP_SYNC; ++q_) XBAR(); }
      }
    }
}

#ifndef MK_MULTI
#define MK_MULTI 0
#endif
extern "C" void kernel_launch(void* const* d_in, const int* in_sizes, int n_in, void* d_out, int out_size, void* d_ws, size_t ws_size, hipStream_t stream) {
    static int grid = 0;
    if (grid == 0) {
        if (n_in != 27 || ws_size < WS_END) { fprintf(stderr, "kernel_launch: bad shapes/workspace (n_in %d ws %zu need %zu)\n", n_in, ws_size, (size_t)WS_END); grid = -1; return; }
        int dev = 0, cus = 0, per_cu = 0;
        hipGetDevice(&dev); hipDeviceGetAttribute(&cus, hipDeviceAttributeMultiprocessorCount, dev);
        if (hipFuncSetAttribute((const void*)mk_fwd, hipFuncAttributeMaxDynamicSharedMemorySize, LDS_BYTES) != hipSuccess) { fprintf(stderr, "kernel_launch: hipFuncSetAttribute failed\n"); grid = -1; return; }
        if (hipOccupancyMaxActiveBlocksPerMultiprocessor(&per_cu, (const void*)mk_fwd, 512, LDS_BYTES) != hipSuccess || per_cu < 1) { fprintf(stderr, "kernel_launch: occupancy query says %d\n", per_cu); per_cu = 1; }
        (void)hipGetLastError();
        grid = cus * (per_cu > 1 ? 1 : per_cu);
        if (grid < 1) grid = 256;
    }
    if (grid < 0) return;
    (void)hipMemsetAsync((char*)d_ws + WS_CTL, 0, 65536, stream);
    Args a{};
    for (int i = 0; i < 27; ++i) a.in[i] = (const float*)d_in[i];
    a.out = (float*)d_out; a.ws = (unsigned char*)d_ws;
#if MK_MULTI
    for (int ph = 0; ph < NPHASE; ++ph) { a.ph_lo = ph; a.ph_hi = ph + 1; a.coop = 0; hipLaunchKernelGGL(mk_fwd, dim3(grid), dim3(512), LDS_BYTES, stream, a); }
#else
    a.ph_lo = 0; a.ph_hi = NPHASE; a.coop = 1;
    void* args[] = {&a};
    hipError_t e = hipLaunchCooperativeKernel((const void*)mk_fwd, dim3(grid), dim3(512), args, LDS_BYTES, stream);
    if (e != hipSuccess) fprintf(stderr, "cooperative launch failed: %s (grid %d)\n", hipGetErrorString(e), grid);
#endif
}
```

```cpp
#include <hip/hip_runtime.h>
#include <hip/hip_cooperative_groups.h>
#include <hip/hip_bf16.h>
#include <cstdio>
#include <cstdint>
#include <cmath>
namespace cg = cooperative_groups;
__device__ __forceinline__ int olane() { unsigned z = 0u; asm volatile("" : "+v"(z)); return (int)__builtin_amdgcn_mbcnt_hi(~0u, __builtin_amdgcn_mbcnt_lo(~0u, z)); }
extern __shared__ __attribute__((aligned(16))) unsigned char lds_dyn[];
constexpr int WTAB_OFF = 135168 + 256;
__device__ __forceinline__ int hw_slot() { return (int)__builtin_amdgcn_s_getreg((5 << 11) | (0 << 6) | 4); }
__device__ __forceinline__ int otid() {
    const int w = __builtin_amdgcn_readfirstlane(((volatile __attribute__((address_space(3))) int*)((__attribute__((address_space(3))) unsigned char*)lds_dyn + WTAB_OFF))[hw_slot()]);
    int t = w * 64 + olane(); asm volatile("" : "+v"(t)); return t;
}
template <int M> __device__ __forceinline__ float shx(float v) {
    if constexpr (M == 32) { auto rr = __builtin_amdgcn_permlane32_swap(__builtin_bit_cast(unsigned, v), __builtin_bit_cast(unsigned, v), false, false);
        const bool hi = (olane() & 32) != 0; return __builtin_bit_cast(float, hi ? rr[0] : rr[1]); }
    else return __builtin_bit_cast(float, __builtin_amdgcn_ds_swizzle(__builtin_bit_cast(int, v), (M << 10) | 0x1f));
}
__device__ __forceinline__ int obid() { int t = blockIdx.x; asm volatile("" : "+s"(t)); return t; }
__device__ __forceinline__ int ogrid() { int t = gridDim.x; asm volatile("" : "+s"(t)); return t; }
namespace pg8 {
#define PG8_LAS __attribute__((address_space(3)))
typedef unsigned short bf16_t;
typedef short bf16x8 __attribute__((ext_vector_type(8)));
typedef float f32x4 __attribute__((ext_vector_type(4)));
typedef unsigned u32x4 __attribute__((ext_vector_type(4)));
typedef unsigned u32x2 __attribute__((ext_vector_type(2)));
constexpr int BM = 256, BK = 64, HALF = 128, HTB = HALF * BK * 2  , STAGE_BYTES = 8 * HTB, NXCD = 8, WGM = 8;

__host__ __device__ __forceinline__ int lds_byte(int r, int c) { const int st = (r >> 4) * 2 + (c >> 5), rr = r & 15, cc = c & 31, ob = rr * 64 + cc * 2; return st * 1024 + (ob ^ (((ob >> 9) & 1) << 5)); }
__host__ __device__ __forceinline__ void stage_rc(int b, int& R, int& C) { const int st = b / 1024, sb = b % 1024, swz = sb ^ (((sb >> 9) & 1) << 5); R = (st >> 1) * 16 + swz / 64; C = (st & 1) * 32 + (swz % 64) / 2; }
__host__ __device__ __forceinline__ int perm32(int rho) { const int n = rho >> 4, i = rho & 15; return 8 * (i >> 2) + 4 * n + (i & 3); }

struct Unit { int pm, pn, kofs, ks; };
struct Gemm { const bf16_t* A; const bf16_t* Bt; int M, N, K, ld; };

struct StaticOrder {
    int nM, nN, nwg, G, c;
    __host__ __device__ void init(int M, int N, int G_, int c_) { nM = M / BM; nN = N / BM; nwg = nM * nN; G = G_; c = c_; }
    __host__ __device__ bool next(int i, Unit& u) const {
        const long L = (long)i * G + c; if (L >= nwg) return false;
        int wgid = (int)L; { const int q = nwg / NXCD, r = nwg % NXCD, xcd = wgid % NXCD, off = wgid / NXCD; wgid = (xcd < r ? xcd * (q + 1) : r * (q + 1) + (xcd - r) * q) + off; }
        const int nig = WGM * nN, gid = wgid / nig, fm = gid * WGM, gsz = (nM - fm) < WGM ? (nM - fm) : WGM;
        u.pm = fm + ((wgid % nig) % gsz); u.pn = (wgid % nig) / gsz; u.kofs = 0; u.ks = i & 1; return true;
    }
    __device__ __forceinline__ void a_ready(const Unit&) const {}
    __device__ __forceinline__ void done(const Unit&) const {}
};

__device__ __forceinline__ unsigned cvt_pk_bf16(float lo, float hi) { unsigned r; asm volatile("v_cvt_pk_bf16_f32 %0, %1, %2" : "=v"(r) : "v"(lo), "v"(hi)); return r; }
typedef float f32x2 __attribute__((ext_vector_type(2)));
struct EpiStore { static constexpr bool ROWPERM = false; static constexpr bool PREROWS = false;
    static constexpr bool PERM = true, AFTER_DRAIN = false;
    bf16_t* O; int ldc;
    __device__ __forceinline__ void operator()(const f32x4 (&acc)[2][2][4][2], const Unit& u, int wr, int wc, int fr, int fq) const {
        const int row0 = u.pm * BM + wr * 64 + fr; const int col0 = u.pn * BM + wc * 32 + 8 * fq;
#pragma unroll
        for (int ai = 0; ai < 2; ++ai)
#pragma unroll
            for (int m = 0; m < 4; ++m) { bf16_t* rowp = O + (size_t)(row0 + ai * HALF + m * 16) * ldc + col0;
#pragma unroll
                for (int bj = 0; bj < 2; ++bj) { const f32x4 v0 = acc[ai][bj][m][0], v1 = acc[ai][bj][m][1];
                    u32x4 w; w.x = cvt_pk_bf16(v0[0], v0[1]); w.y = cvt_pk_bf16(v0[2], v0[3]); w.z = cvt_pk_bf16(v1[0], v1[1]); w.w = cvt_pk_bf16(v1[2], v1[3]);
                    *(u32x4*)(rowp + bj * HALF) = w; } }
    }
};
__device__ __forceinline__ float bf_lo(unsigned w) { return __uint_as_float(w << 16); }
__device__ __forceinline__ float bf_hi(unsigned w) { return __uint_as_float(w & 0xffff0000u); }
__device__ __forceinline__ float sigm(float x) { return __builtin_amdgcn_rcpf(1.0f + __builtin_amdgcn_exp2f(-1.4426950408889634f * x)); }
struct EpiGlu { static constexpr bool ROWPERM = false; static constexpr bool PREROWS = false;
    static constexpr bool PERM = true, AFTER_DRAIN = false;
    const bf16_t* Z; bf16_t* O; const float* bias;
    __device__ __forceinline__ void operator()(const f32x4 (&acc)[2][2][4][2], const Unit& u, int wr, int wc, int fr, int fq) const {
        const int row0 = u.pm * BM + wr * 64 + fr; const int col0 = u.pn * BM + wc * 32 + 8 * fq;
        f32x4 bv[2][2];
#pragma unroll
        for (int bj = 0; bj < 2; ++bj)
#pragma unroll
            for (int n = 0; n < 2; ++n) bv[bj][n] = *(const f32x4*)(bias + col0 + bj * HALF + 4 * n);
#pragma unroll
        for (int ai = 0; ai < 2; ++ai) {
            u32x4 zv[4][2];
#pragma unroll
            for (int m = 0; m < 4; ++m)
#pragma unroll
                for (int bj = 0; bj < 2; ++bj) zv[m][bj] = *(const u32x4*)(Z + (size_t)(row0 + ai * HALF + m * 16) * 512 + col0 + bj * HALF);
            asm volatile("" ::: "memory");
#pragma unroll
            for (int m = 0; m < 4; ++m) { const size_t off = (size_t)(row0 + ai * HALF + m * 16) * 512 + col0;
#pragma unroll
                for (int bj = 0; bj < 2; ++bj) { const u32x4 zz = zv[m][bj];
                    const f32x4 v0 = acc[ai][bj][m][0] + bv[bj][0], v1 = acc[ai][bj][m][1] + bv[bj][1];
                    u32x4 w;
                    w.x = cvt_pk_bf16(bf_lo(zz.x) * sigm(v0[0]), bf_hi(zz.x) * sigm(v0[1])); w.y = cvt_pk_bf16(bf_lo(zz.y) * sigm(v0[2]), bf_hi(zz.y) * sigm(v0[3]));
                    w.z = cvt_pk_bf16(bf_lo(zz.z) * sigm(v1[0]), bf_hi(zz.z) * sigm(v1[1])); w.w = cvt_pk_bf16(bf_lo(zz.w) * sigm(v1[2]), bf_hi(zz.w) * sigm(v1[3]));
                    *(u32x4*)(O + off + bj * HALF) = w; } }
            asm volatile("" ::: "memory"); }
    }
};
struct EpiRes { static constexpr bool ROWPERM = false; static constexpr bool PREROWS = false;
    static constexpr bool PERM = true, AFTER_DRAIN = false;
    float* xlat; float* xctx; const float* gate; bf16_t* xt; const float* cscale; float* ssq;
    __device__ __forceinline__ void operator()(const f32x4 (&acc)[2][2][4][2], const Unit& u, int wr, int wc, int fr, int fq) const {
        const int rowt = u.pm * BM;
        float* xb = rowt < 16384 ? xlat + (size_t)rowt * 1024 : xctx + (size_t)(rowt - 16384) * 1024;
        const int v = rowt < 16384 ? (rowt >> 12) : 4;
        const int col0 = u.pn * BM + wc * 32 + 8 * fq;
        f32x4 gv[2][2], cv[2][2];
#pragma unroll
        for (int bj = 0; bj < 2; ++bj)
#pragma unroll
            for (int n = 0; n < 2; ++n) { gv[bj][n] = *(const f32x4*)(gate + v * 6144 + col0 + bj * HALF + n * 4); cv[bj][n] = xt ? *(const f32x4*)(cscale + v * 1024 + col0 + bj * HALF + n * 4) : (f32x4){0.f, 0.f, 0.f, 0.f}; }
#pragma unroll
        for (int hb = 0; hb < 4; ++hb) { const int ai = hb >> 1, m0 = (hb & 1) * 2;
            f32x4 xv[2][2][2];
#pragma unroll
            for (int mm = 0; mm < 2; ++mm)
#pragma unroll
                for (int bj = 0; bj < 2; ++bj)
#pragma unroll
                    for (int n = 0; n < 2; ++n) xv[mm][bj][n] = *(const f32x4*)(xb + (size_t)(ai * HALF + wr * 64 + (m0 + mm) * 16 + fr) * 1024 + col0 + bj * HALF + n * 4);
            asm volatile("" ::: "memory");
#pragma unroll
            for (int mm = 0; mm < 2; ++mm) { const int m = m0 + mm; const int rl = ai * HALF + wr * 64 + m * 16 + fr; float* rp = xb + (size_t)rl * 1024 + col0; float ss = 0.f;
#pragma unroll
                for (int bj = 0; bj < 2; ++bj)
#pragma unroll
                    for (int n = 0; n < 2; ++n) { f32x4 x = xv[mm][bj][n] + gv[bj][n] * acc[ai][bj][m][n]; *(f32x4*)(rp + bj * HALF + n * 4) = x;
                        if (xt) { ss += (x[0] * x[0] + x[1] * x[1]) + (x[2] * x[2] + x[3] * x[3]); const f32x4 y = x * cv[bj][n];
                            u32x2 w; w.x = cvt_pk_bf16(y[0], y[1]); w.y = cvt_pk_bf16(y[2], y[3]); *(u32x2*)(xt + (size_t)(rowt + rl) * 1024 + col0 + bj * HALF + n * 4) = w; } }
                if (xt) { ss += shx<16>(ss); ss += shx<32>(ss); if (fq == 0) ssq[(size_t)(rowt + rl) * 16 + u.pn * 4 + wc] = ss; } }
            asm volatile("" ::: "memory"); }
    }
};
__device__ __forceinline__ float row_rstd(const float* ssq, int row, int fq) {
    const f32x4 a = ((const f32x4*)(ssq + (size_t)row * 16))[fq];
    float s = (a[0] + a[1]) + (a[2] + a[3]); s += shx<16>(s); s += shx<32>(s);
    return __builtin_amdgcn_rsqf(s * (1.f / 1024.f) + 1e-6f);
}
__device__ __forceinline__ float dpp_shr1(float v) { return __builtin_bit_cast(float, __builtin_amdgcn_update_dpp(0, __builtin_bit_cast(int, v), 0x111, 0xf, 0xf, true)); }
__device__ __forceinline__ float dpp_shl1(float v) { return __builtin_bit_cast(float, __builtin_amdgcn_update_dpp(0, __builtin_bit_cast(int, v), 0x101, 0xf, 0xf, true)); }
__device__ __forceinline__ float silu_e(float x) { return x * __builtin_amdgcn_rcpf(1.0f + __builtin_amdgcn_exp2f(-1.4426950408889634f * x)); }
struct EpiConv { static constexpr bool ROWPERM = true; static constexpr bool PREROWS = true;
    static constexpr bool PERM = true, AFTER_DRAIN = false;
    bf16_t* H; const float* cw; const float* cb; float* side; PG8_LAS float* xl; const float* ssq; const float* bias; PG8_LAS float* rt;
    __device__ __forceinline__ void prerows(const Unit& u) const {
        const int t = otid();
        if (t < 256) { const f32x4* p = (const f32x4*)(ssq + (size_t)(u.pm * BM + t) * 16); const f32x4 a = p[0], b = p[1], c = p[2], d = p[3];
            const float sum = ((a[0] + a[1]) + (a[2] + a[3])) + ((b[0] + b[1]) + (b[2] + b[3])) + ((c[0] + c[1]) + (c[2] + c[3])) + ((d[0] + d[1]) + (d[2] + d[3]));
            rt[t] = __builtin_amdgcn_rsqf(sum * (1.f / 1024.f) + 1e-6f);
            const int v = (u.pm * BM) < 16384 ? ((u.pm * BM) >> 12) : 4;
            rt[256 + t] = bias[v * 5632 + (t >> 7) * 2816 + 128 * u.pn + (t & 127)]; }
        PG8_LAS float* wt = rt + 512 + (u.ks & 1) * 1024;
        for (int idx = t; idx < 1024; idx += 512) { const int k = idx >> 7, c = 128 * u.pn + (idx & 127);
            wt[idx] = k < 3 ? cw[k * 5632 + c] : (k == 3 ? cb[c] : (k < 7 ? cw[(k - 4) * 5632 + 2816 + c] : cb[2816 + c])); }
    }
    __device__ __forceinline__ void operator()(f32x4 (&acc)[2][2][4][2], const Unit& u, int wr, int wc, int fr, int fq) const {
        { const int rowt = u.pm * BM; const int v = rowt < 16384 ? (rowt >> 12) : 4; const int cc = 128 * u.pn + 32 * wc + 8 * fq;
          f32x4 bv[2][2];
#pragma unroll
          for (int bj = 0; bj < 2; ++bj)
#pragma unroll
              for (int n = 0; n < 2; ++n) bv[bj][n] = *(const PG8_LAS f32x4*)(rt + 256 + bj * 128 + 32 * wc + 8 * fq + 4 * n);
#pragma unroll
          for (int ai = 0; ai < 2; ++ai)
#pragma unroll
              for (int m = 0; m < 4; ++m) { const float rs = rt[128 * wr + 8 * fr + 4 * ai + m];
#pragma unroll
                  for (int bj = 0; bj < 2; ++bj)
#pragma unroll
                      for (int n = 0; n < 2; ++n) acc[ai][bj][m][n] = acc[ai][bj][m][n] * rs + bv[bj][n]; } }
        const int xb = ((wr * 4 + wc) * 4 + fq) * 16;
        if (fr == 0) {
#pragma unroll
            for (int bj = 0; bj < 2; ++bj)
#pragma unroll
                for (int n = 0; n < 2; ++n) *(PG8_LAS f32x4*)(xl + xb + bj * 8 + n * 4) = acc[0][bj][0][n]; }
        if (fr == 15) {
#pragma unroll
            for (int bj = 0; bj < 2; ++bj)
#pragma unroll
                for (int n = 0; n < 2; ++n) *(PG8_LAS f32x4*)(xl + 512 + xb + bj * 8 + n * 4) = acc[1][bj][3][n]; }
        asm volatile("s_waitcnt lgkmcnt(0)" ::: "memory"); __builtin_amdgcn_s_barrier(); asm volatile("" ::: "memory");
        const int ch0 = 128 * u.pn + 32 * wc + 8 * fq;
        const size_t t0 = (size_t)u.pm * BM + 128 * wr + 8 * fr;
        const bool sfirst = (fr == 0 && wr == 0), slast = (fr == 15 && wr == 1);
        float* sd = side + (size_t)u.pm * 4 * 5632;
#pragma unroll
        for (int n = 0; n < 2; ++n) {
            f32x4 prv[2], nxt[2];
#pragma unroll
            for (int bj = 0; bj < 2; ++bj) {
#pragma unroll
                for (int j = 0; j < 4; ++j) { prv[bj][j] = dpp_shr1(acc[1][bj][3][n][j]); nxt[bj][j] = dpp_shl1(acc[0][bj][0][n][j]); }
                if (fr == 0 && wr == 1) prv[bj] = *(const PG8_LAS f32x4*)(xl + 512 + ((0 * 4 + wc) * 4 + fq) * 16 + bj * 8 + n * 4);
                if (fr == 15 && wr == 0) nxt[bj] = *(const PG8_LAS f32x4*)(xl + ((1 * 4 + wc) * 4 + fq) * 16 + bj * 8 + n * 4); }
            const int c = ch0 + 4 * n;
            const PG8_LAS float* wt = rt + 512 + (u.ks & 1) * 1024 + 32 * wc + 8 * fq + 4 * n;
            const f32x4 w0a = *(const PG8_LAS f32x4*)(wt), w1a = *(const PG8_LAS f32x4*)(wt + 128), w2a = *(const PG8_LAS f32x4*)(wt + 256), ba = *(const PG8_LAS f32x4*)(wt + 384);
            const f32x4 w0g = *(const PG8_LAS f32x4*)(wt + 512), w1g = *(const PG8_LAS f32x4*)(wt + 640), w2g = *(const PG8_LAS f32x4*)(wt + 768), bg = *(const PG8_LAS f32x4*)(wt + 896);
#pragma unroll
            for (int k = 0; k < 8; ++k) {
                const f32x4 ap = k == 0 ? prv[0] : acc[(k - 1) >> 2][0][(k - 1) & 3][n], ac = acc[k >> 2][0][k & 3][n], an = k == 7 ? nxt[0] : acc[(k + 1) >> 2][0][(k + 1) & 3][n];
                const f32x4 gp = k == 0 ? prv[1] : acc[(k - 1) >> 2][1][(k - 1) & 3][n], gc = acc[k >> 2][1][k & 3][n], gn = k == 7 ? nxt[1] : acc[(k + 1) >> 2][1][(k + 1) & 3][n];
                const f32x4 oa = w0a * ap + w1a * ac + w2a * an + ba, og = w0g * gp + w1g * gc + w2g * gn + bg;
                u32x2 w; w.x = cvt_pk_bf16(silu_e(og[0]) * oa[0], silu_e(og[1]) * oa[1]); w.y = cvt_pk_bf16(silu_e(og[2]) * oa[2], silu_e(og[3]) * oa[3]);
                *(u32x2*)(H + (t0 + k) * 2816 + c) = w;
                if (k == 0 && sfirst) { *(f32x4*)(sd + 0 * 5632 + c) = ac; *(f32x4*)(sd + 0 * 5632 + 2816 + c) = gc; *(f32x4*)(sd + 1 * 5632 + c) = oa; *(f32x4*)(sd + 1 * 5632 + 2816 + c) = og; }
                if (k == 7 && slast) { *(f32x4*)(sd + 2 * 5632 + c) = ac; *(f32x4*)(sd + 2 * 5632 + 2816 + c) = gc; *(f32x4*)(sd + 3 * 5632 + c) = oa; *(f32x4*)(sd + 3 * 5632 + 2816 + c) = og; }
            }
        }
    }
};
struct EpiIn { static constexpr bool ROWPERM = false; static constexpr bool PREROWS = false;
    static constexpr bool PERM = false, AFTER_DRAIN = false;
    bf16_t* QO; bf16_t* KA; bf16_t* VA; bf16_t* UB; const float* qg; const float* kg; const float* rt; const float* ssq; const float* bias;
    __device__ __forceinline__ void operator()(const f32x4 (&acc)[2][2][4][2], const Unit& u, int wr, int wc, int fr, int fq) const {
        const int rowt = u.pm * BM + wr * 64 + fr;
        const int vb = (u.pm * BM) < 16384 ? ((u.pm * BM) >> 12) : 4;
        const int sbase = u.pn >= 3 ? 768 + (u.pn - 3) * 256 + 32 * wc : (u.pn < 2 ? (4 * u.pn + wc) * 64 : (wc < 2 ? 512 + wc * 64 : 640 + (wc - 2) * 64));
        const int sbj = u.pn >= 3 ? 128 : 32;
        f32x4 bsv[2][2];
#pragma unroll
        for (int bj = 0; bj < 2; ++bj)
#pragma unroll
            for (int n = 0; n < 2; ++n) bsv[bj][n] = *(const f32x4*)(bias + vb * 1280 + sbase + sbj * bj + 16 * n + 4 * fq);
        float rsv[2][4];
#pragma unroll
        for (int ai = 0; ai < 2; ++ai)
#pragma unroll
            for (int m = 0; m < 4; ++m) rsv[ai][m] = row_rstd(ssq, rowt + ai * HALF + m * 16, fq);
        if (u.pn >= 3) {
#pragma unroll
            for (int ai = 0; ai < 2; ++ai)
#pragma unroll
                for (int m = 0; m < 4; ++m) { bf16_t* rp = UB + (size_t)(rowt + ai * HALF + m * 16) * 512 + (u.pn - 3) * 256 + wc * 32 + 4 * fq; const float rs = rsv[ai][m];
#pragma unroll
                    for (int bj = 0; bj < 2; ++bj)
#pragma unroll
                        for (int n = 0; n < 2; ++n) { const f32x4 v = acc[ai][bj][m][n] * rs + bsv[bj][n]; u32x2 w; w.x = cvt_pk_bf16(v[0], v[1]); w.y = cvt_pk_bf16(v[2], v[3]); *(u32x2*)(rp + bj * HALF + n * 16) = w; } }
            return;
        }
        const bool isv = (u.pn == 2 && wc >= 2), isq = u.pn < 2;
        const float* gsrc = isq ? qg : kg;
        f32x4 gn[2][2];
#pragma unroll
        for (int bj = 0; bj < 2; ++bj)
#pragma unroll
            for (int n = 0; n < 2; ++n) gn[bj][n] = *(const f32x4*)(gsrc + 32 * bj + 16 * n + 4 * fq);
        const float osc = isq ? 0.125f * 1.4426950408889634f : 1.0f;
#pragma unroll
        for (int ai = 0; ai < 2; ++ai)
#pragma unroll
            for (int m = 0; m < 4; ++m) {
                const int row = rowt + ai * HALF + m * 16; const bool lat = row < 16384; const int sidx = row & 4095;
                const size_t kvrow = lat ? (size_t)(row >> 12) * 4352 + 256 + sidx : (size_t)((row - 16384) >> 8) * 4352 + ((row - 16384) & 255);
                f32x4 y[2][2]; const float rs = rsv[ai][m];
#pragma unroll
                for (int bj = 0; bj < 2; ++bj)
#pragma unroll
                    for (int n = 0; n < 2; ++n) y[bj][n] = acc[ai][bj][m][n] * rs + bsv[bj][n];
                if (!isv) {
                    float ss = 0.f;
#pragma unroll
                    for (int bj = 0; bj < 2; ++bj)
#pragma unroll
                        for (int n = 0; n < 2; ++n) { const f32x4 v = y[bj][n]; ss += (v[0] * v[0] + v[1] * v[1]) + (v[2] * v[2] + v[3] * v[3]); }
                    ss += shx<16>(ss); ss += shx<32>(ss);
                    const float rstd = __builtin_amdgcn_rsqf(ss * (1.f / 64.f) + 1e-6f);
#pragma unroll
                    for (int bj = 0; bj < 2; ++bj) {
                        f32x4 t1 = y[bj][0] * rstd * gn[bj][0], t2 = y[bj][1] * rstd * gn[bj][1];
                        if (lat) { const int p = bj == 0 ? (sidx >> 6) : (sidx & 63);
                            const f32x4 cs = *(const f32x4*)(rt + p * 16 + 4 * fq), sn = *(const f32x4*)(rt + 1024 + p * 16 + 4 * fq);
                            const f32x4 o1 = t1 * cs - t2 * sn, o2 = t2 * cs + t1 * sn; t1 = o1; t2 = o2; }
                        y[bj][0] = t1 * osc; y[bj][1] = t2 * osc; }
                }
                bf16_t* dst = isq ? QO + (size_t)row * 512 + (4 * u.pn + wc) * 64 : (isv ? VA + kvrow * 128 + (wc - 2) * 64 : KA + kvrow * 128 + wc * 64);
#pragma unroll
                for (int bj = 0; bj < 2; ++bj)
#pragma unroll
                    for (int n = 0; n < 2; ++n) { const f32x4 v = y[bj][n]; u32x2 w; w.x = cvt_pk_bf16(v[0], v[1]); w.y = cvt_pk_bf16(v[2], v[3]); *(u32x2*)(dst + 32 * bj + 16 * n + 4 * fq) = w; }
            }
    }
};

struct SliceOrder {
    int G, c;
    __host__ __device__ bool next(int i, Unit& u) const { const int L = i * G + c; if (L >= 176) return false; u.ks = L >> 4; u.kofs = u.ks * 256; u.pm = (L >> 2) & 3; u.pn = L & 3; return true; }
    __device__ __forceinline__ void a_ready(const Unit&) const {}
    __device__ __forceinline__ void done(const Unit&) const {}
};
struct EpiPart { static constexpr bool ROWPERM = false; static constexpr bool PREROWS = false;
    static constexpr bool PERM = true, AFTER_DRAIN = false;
    float* P;
    __device__ __forceinline__ void operator()(const f32x4 (&acc)[2][2][4][2], const Unit& u, int wr, int wc, int fr, int fq) const {
        float* base = P + ((size_t)u.ks * 1024 + u.pm * BM + wr * 64 + fr) * 1024 + u.pn * BM + wc * 32 + 8 * fq;
#pragma unroll
        for (int ai = 0; ai < 2; ++ai)
#pragma unroll
            for (int m = 0; m < 4; ++m)
#pragma unroll
                for (int bj = 0; bj < 2; ++bj)
#pragma unroll
                    for (int n = 0; n < 2; ++n) *(f32x4*)(base + (size_t)(ai * HALF + m * 16) * 1024 + bj * HALF + n * 4) = acc[ai][bj][m][n];
    }
};

struct OneUnit { int pm, pn;
    __host__ __device__ bool next(int i, Unit& u) const { if (i > 0) return false; u.pm = pm; u.pn = pn; u.kofs = 0; u.ks = 0; return true; }
    __device__ __forceinline__ void a_ready(const Unit&) const {}
    __device__ __forceinline__ void done(const Unit&) const {}
};
template <class Epi, class Sched, bool ALIGN_EPI = false, bool SP2 = false>
__device__ __forceinline__ void gemm_phase(PG8_LAS unsigned char* lds, const Gemm g, const Sched& S, const Epi& E) {
    const int tid = otid(), wid = __builtin_amdgcn_readfirstlane(tid >> 6), lane = tid & 63, wr = wid >> 2, wc = wid & 3, fr = lane & 15, fq = lane >> 4;
    const int K = g.ld, nt = g.K / BK;
    unsigned voffA[2], voffB[2];
#pragma unroll
    for (int i = 0; i < 2; ++i) { int R, C; stage_rc(tid * 16 + i * 8192, R, C); const int Rb = Epi::PERM ? ((R & ~31) + perm32(R & 31)) : R;
        const int Ra = Epi::ROWPERM ? (128 * (R >> 6) + 8 * (R & 15) + ((R >> 4) & 3)) : R;
        voffA[i] = (unsigned)(Ra * K + C) * 2u; voffB[i] = (unsigned)(Rb * K + C) * 2u; }
    const size_t hstepA = Epi::ROWPERM ? (size_t)4 * K * 2 : (size_t)HALF * K * 2;
    const size_t kstep = (size_t)(BK * 2);
    const size_t hstep = (size_t)HALF * K * 2;
    const size_t tstep = 2 * hstep;
    const unsigned ldsw = (unsigned)wid * 1024u;
    const int aoff = lds_byte(wr * 64 + fr, fq * 8), boff = lds_byte(wc * 32 + fr, fq * 8);
#define PG8_SA(b, h) (((b) * 2 + (h)) * HTB)
#define PG8_SB(b, h) ((4 + (b) * 2 + (h)) * HTB)
#define PG8_STAGE(bufoff, gbase, voff) do { _Pragma("unroll") for (int _i = 0; _i < 2; ++_i) \
        __builtin_amdgcn_global_load_lds((const unsigned*)((const char*)(gbase) + (voff)[_i]), (PG8_LAS unsigned*)(lds + (bufoff) + ldsw + _i * 8192), 16, 0, 0); } while (0)
#define PG8_LDA(dst, b, h) do { _Pragma("unroll") for (int m = 0; m < 4; ++m) _Pragma("unroll") for (int k = 0; k < 2; ++k) dst[m][k] = *(const PG8_LAS bf16x8*)(lds + PG8_SA(b, h) + aoff + m * 2048 + k * 1024); } while (0)
#define PG8_LDB(dst, b, h) do { _Pragma("unroll") for (int n = 0; n < 2; ++n) _Pragma("unroll") for (int k = 0; k < 2; ++k) dst[n][k] = *(const PG8_LAS bf16x8*)(lds + PG8_SB(b, h) + boff + n * 2048 + k * 1024); } while (0)
#define PG8_MMA(ai, bj, At, Bt) do { __builtin_amdgcn_s_setprio(1); _Pragma("unroll") for (int m = 0; m < 4; ++m) _Pragma("unroll") for (int n = 0; n < 2; ++n) _Pragma("unroll") for (int k = 0; k < 2; ++k) \
        acc[ai][bj][m][n] = __builtin_amdgcn_mfma_f32_16x16x32_bf16(Bt[n][k], At[m][k], acc[ai][bj][m][n], 0, 0, 0); __builtin_amdgcn_s_setprio(0); } while (0)
#define PG8_WAIT_V(n) asm volatile("s_waitcnt vmcnt(" #n ")" ::: "memory")
#define PG8_WAIT_L(n) asm volatile("s_waitcnt lgkmcnt(" #n ")" ::: "memory")
#define PG8_BAR __builtin_amdgcn_s_barrier()
#define PG8_SCHED __builtin_amdgcn_sched_barrier(0)
    Unit cur, nxt; int ui = 0;
    if (!S.next(0, cur)) return;
    if constexpr (Epi::PREROWS) E.prerows(cur);
    f32x4 acc[2][2][4][2];
#pragma unroll
    for (int a = 0; a < 2; ++a)
#pragma unroll
        for (int b = 0; b < 2; ++b)
#pragma unroll
            for (int m = 0; m < 4; ++m)
#pragma unroll
                for (int n = 0; n < 2; ++n) acc[a][b][m][n] = (f32x4){0.f, 0.f, 0.f, 0.f};
    bf16x8 At[4][2], B0[2][2], B1[2][2];
    const char* cA = (const char*)g.A + (size_t)cur.pm * tstep + (size_t)cur.kofs * 2; const char* cB = (const char*)g.Bt + (size_t)cur.pn * tstep + (size_t)cur.kofs * 2;
    S.a_ready(cur);
    if constexpr (SP2) {
        PG8_STAGE(PG8_SB(0, 0), cB, voffB); PG8_STAGE(PG8_SB(0, 1), cB + hstep, voffB); PG8_STAGE(PG8_SA(0, 0), cA, voffA); PG8_STAGE(PG8_SA(0, 1), cA + hstepA, voffA);
        if (wr == 1) PG8_BAR;
        PG8_WAIT_V(2); PG8_BAR;
        PG8_STAGE(PG8_SB(1, 0), cB + kstep, voffB); PG8_STAGE(PG8_SA(1, 0), cA + kstep, voffA); PG8_STAGE(PG8_SB(1, 1), cB + hstep + kstep, voffB);
        PG8_WAIT_V(6); PG8_BAR;
    } else {
        PG8_STAGE(PG8_SB(0, 0), cB, voffB); PG8_STAGE(PG8_SA(0, 0), cA, voffA); PG8_STAGE(PG8_SB(0, 1), cB + hstep, voffB); PG8_STAGE(PG8_SA(0, 1), cA + hstepA, voffA);
        if (wr == 1) PG8_BAR;
        PG8_WAIT_V(4); PG8_BAR;
        PG8_STAGE(PG8_SB(1, 0), cB + kstep, voffB); PG8_STAGE(PG8_SA(1, 0), cA + kstep, voffA); PG8_STAGE(PG8_SB(1, 1), cB + hstep + kstep, voffB);
        PG8_WAIT_V(6); PG8_BAR;
    }
    for (;;) {
        const bool has_next = S.next(ui + 1, nxt);
        const char* nA = has_next ? (const char*)g.A + (size_t)nxt.pm * tstep + (size_t)nxt.kofs * 2 : cA; const char* nB = has_next ? (const char*)g.Bt + (size_t)nxt.pn * tstep + (size_t)nxt.kofs * 2 : cB;
        for (int t = 0; t < nt; t += 2) {
            const bool last = (t == nt - 2);
            const char* a1 = cA + (size_t)(t + 1) * kstep;
            const char* a2 = last ? nA : cA + (size_t)(t + 2) * kstep; const char* b2 = last ? nB : cB + (size_t)(t + 2) * kstep;
            const char* a3 = a2 + kstep; const char* b3 = b2 + kstep;
            if (last && has_next) S.a_ready(nxt);
            if constexpr (SP2) {
            PG8_LDB(B0, 0, 0); PG8_LDB(B1, 0, 1); PG8_SCHED; PG8_LDA(At, 0, 0); PG8_STAGE(PG8_SA(1, 1), a1 + hstepA, voffA);
            PG8_WAIT_V(8); PG8_WAIT_L(0); PG8_BAR; PG8_MMA(0, 0, At, B0); PG8_MMA(0, 1, At, B1); PG8_BAR; PG8_SCHED;
            PG8_LDA(At, 0, 1); PG8_STAGE(PG8_SB(0, 0), b2, voffB); PG8_STAGE(PG8_SB(0, 1), b2 + hstep, voffB); PG8_STAGE(PG8_SA(0, 0), a2, voffA);
            PG8_WAIT_V(8); PG8_WAIT_L(0); PG8_BAR; PG8_MMA(1, 0, At, B0); PG8_MMA(1, 1, At, B1); PG8_BAR; PG8_SCHED;
            PG8_LDB(B0, 1, 0); PG8_LDB(B1, 1, 1); PG8_SCHED; PG8_LDA(At, 1, 0); PG8_STAGE(PG8_SA(0, 1), a2 + hstepA, voffA);
            PG8_WAIT_V(8); PG8_WAIT_L(0); PG8_BAR; PG8_MMA(0, 0, At, B0); PG8_MMA(0, 1, At, B1); PG8_BAR; PG8_SCHED;
            PG8_LDA(At, 1, 1); PG8_STAGE(PG8_SB(1, 0), b3, voffB); PG8_STAGE(PG8_SB(1, 1), b3 + hstep, voffB); PG8_STAGE(PG8_SA(1, 0), a3, voffA);
            PG8_WAIT_V(8); PG8_WAIT_L(0); PG8_BAR; PG8_MMA(1, 0, At, B0); PG8_MMA(1, 1, At, B1); PG8_BAR; PG8_SCHED;
            } else {
            PG8_LDB(B0, 0, 0); PG8_SCHED; PG8_LDA(At, 0, 0); PG8_STAGE(PG8_SA(1, 1), a1 + hstepA, voffA);
            PG8_WAIT_L(8); PG8_BAR; PG8_WAIT_L(0); PG8_MMA(0, 0, At, B0); PG8_BAR; PG8_SCHED;
            PG8_LDB(B1, 0, 1); PG8_STAGE(PG8_SB(0, 0), b2, voffB);
            PG8_BAR; PG8_WAIT_L(0); PG8_MMA(0, 1, At, B1); PG8_BAR;
            PG8_LDA(At, 0, 1); PG8_STAGE(PG8_SA(0, 0), a2, voffA);
            PG8_BAR; PG8_WAIT_L(0); PG8_MMA(1, 0, At, B0); PG8_BAR; PG8_SCHED;
            PG8_STAGE(PG8_SB(0, 1), b2 + hstep, voffB);
            PG8_WAIT_V(6); PG8_BAR; PG8_MMA(1, 1, At, B1); PG8_BAR;
            PG8_LDB(B0, 1, 0); PG8_SCHED; PG8_LDA(At, 1, 0); PG8_STAGE(PG8_SA(0, 1), a2 + hstepA, voffA);
            PG8_WAIT_L(8); PG8_BAR; PG8_WAIT_L(0); PG8_MMA(0, 0, At, B0); PG8_BAR; PG8_SCHED;
            PG8_LDB(B1, 1, 1); PG8_STAGE(PG8_SB(1, 0), b3, voffB);
            PG8_BAR; PG8_WAIT_L(0); PG8_MMA(0, 1, At, B1); PG8_BAR;
            PG8_LDA(At, 1, 1); PG8_STAGE(PG8_SA(1, 0), a3, voffA);
            PG8_BAR; PG8_WAIT_L(0); PG8_MMA(1, 0, At, B0); PG8_BAR; PG8_SCHED;
            PG8_STAGE(PG8_SB(1, 1), b3 + hstep, voffB);
            PG8_WAIT_V(6); PG8_BAR; PG8_MMA(1, 1, At, B1); PG8_BAR;
            }
        }
        if constexpr (ALIGN_EPI) { if (wr == 0) PG8_BAR; }
        if constexpr (!Epi::AFTER_DRAIN) { int l2 = olane(); asm volatile("" : "+v"(l2)); const int fr2 = l2 & 15, fq2 = l2 >> 4; E(acc, cur, wr, wc, fr2, fq2); S.done(cur); }
        if (!has_next) break;
        if constexpr (Epi::PREROWS) E.prerows(nxt);
#pragma unroll
        for (int a = 0; a < 2; ++a)
#pragma unroll
            for (int b = 0; b < 2; ++b)
#pragma unroll
                for (int m = 0; m < 4; ++m)
#pragma unroll
                    for (int n = 0; n < 2; ++n) acc[a][b][m][n] = (f32x4){0.f, 0.f, 0.f, 0.f};
        cur = nxt; cA = nA; cB = nB; ++ui;
        if constexpr (ALIGN_EPI) { if (wr == 1) PG8_BAR; }
    }
    PG8_WAIT_V(0);
    if constexpr (!ALIGN_EPI) { if (wr == 0) PG8_BAR; }
    PG8_BAR;
    if constexpr (Epi::AFTER_DRAIN) { E.fused(acc, cur, wr, wc, fr, fq, lds, wid, lane); S.done(cur); }
#undef PG8_SA
#undef PG8_SB
#undef PG8_STAGE
#undef PG8_LDA
#undef PG8_LDB
#undef PG8_MMA
#undef PG8_WAIT_V
#undef PG8_WAIT_L
#undef PG8_BAR
#undef PG8_SCHED
}
}
#include <hip/hip_bf16.h>
namespace attn_body {
using bf16=__hip_bfloat16;
using bf16x8=__attribute__((ext_vector_type(8)))short;
using s16x4=__attribute__((ext_vector_type(4)))short;
using f32x16=__attribute__((ext_vector_type(16)))float;
using u32x4=__attribute__((ext_vector_type(4)))unsigned;
constexpr int D=64,QP=512,KP=128;
constexpr int NW=8,QBLK=32,QB=QBLK*NW,KVBLK=64;
__device__ __forceinline__ int crow(int r,int hi){return (r&3)+8*(r>>2)+4*hi;}
#define SBAR() __builtin_amdgcn_sched_barrier(0)
__device__ __forceinline__ void cmask(f32x16&p0,f32x16&p1,int jb,int qrel,int hi){
  const float NEG=-INFINITY; int kb=64*jb+4*hi;
  #pragma unroll
  for(int r=0;r<16;++r){int kv=kb+(r&3)+8*(r>>2); if(kv>qrel)p0[r]=NEG; if(kv+32>qrel)p1[r]=NEG;}
}

constexpr int NSLOT=3, SLOTB=8192;
constexpr int LDS_K=0, LDS_V=NSLOT*SLOTB, LDS_WS=2*NSLOT*SLOTB, LDS_OST=LDS_WS+NW*64*4, LDS_BYTES=LDS_OST+NW*4096;
constexpr float C2=0.125f*1.4426950408889634f;
__device__ __forceinline__ void glds16(const void*gsrc,unsigned lds_dst){unsigned keep;
  asm volatile("s_mov_b32 %0, m0\n\ts_mov_b32 m0, %2\n\ts_nop 0\n\tglobal_load_lds_dwordx4 %1, off\n\ts_mov_b32 m0, %0":"=&s"(keep):"v"(gsrc),"s"(lds_dst):"memory");}
__device__ __forceinline__ float max3f(float a,float b,float c){float r;asm("v_max3_f32 %0, %1, %2, %3":"=v"(r):"v"(a),"v"(b),"v"(c));return r;}
__device__ __forceinline__ float max2f(float a,float b){float r;asm("v_max_f32_e32 %0, %1, %2":"=v"(r):"v"(a),"v"(b));return r;}
__device__ __forceinline__ float fadd_s(float a,float b){float r;asm("v_add_f32_e32 %0, %1, %2":"=v"(r):"v"(a),"v"(b));return r;}
__device__ __forceinline__ float fsub_s(float a,float b){float r;asm("v_sub_f32_e32 %0, %1, %2":"=v"(r):"v"(a),"v"(b));return r;}
typedef float f32x2_t __attribute__((ext_vector_type(2))); typedef __bf16 bf16x2_t __attribute__((ext_vector_type(2)));
__device__ __forceinline__ unsigned cvtpk_s(float lo,float hi){f32x2_t v={lo,hi};bf16x2_t b=__builtin_convertvector(v,bf16x2_t);return __builtin_bit_cast(unsigned,b);}
#define WAIT_BAR(N) asm volatile("s_waitcnt vmcnt(" #N ") lgkmcnt(0)\n\ts_barrier":::"memory")

__device__ __forceinline__ void qkt(f32x16&p0,f32x16&p1,const char*Kslot,const bf16x8*qr,const f32x16&negm,int r32,int hi){
  const char*kb=Kslot+hi*1024+r32*16;
  #pragma unroll
  for(int d0=0;d0<4;++d0){
    const bf16x8 b0=*reinterpret_cast<const bf16x8*>(kb+d0*2048);
    const bf16x8 b1=*reinterpret_cast<const bf16x8*>(kb+d0*2048+512);
    if(d0==0){p0=__builtin_amdgcn_mfma_f32_32x32x16_bf16(b0,qr[0],negm,0,0,0);p1=__builtin_amdgcn_mfma_f32_32x32x16_bf16(b1,qr[0],negm,0,0,0);}
    else{p0=__builtin_amdgcn_mfma_f32_32x32x16_bf16(b0,qr[d0],p0,0,0,0);p1=__builtin_amdgcn_mfma_f32_32x32x16_bf16(b1,qr[d0],p1,0,0,0);}}
}
typedef __attribute__((address_space(3))) const char* lds_cptr;
typedef short v4i16_t __attribute__((ext_vector_type(4)));
__device__ __forceinline__ void kload8(bf16x8*kf,lds_cptr kp){
  kf[0]=*(const __attribute__((address_space(3))) bf16x8*)(kp);      kf[1]=*(const __attribute__((address_space(3))) bf16x8*)(kp+512);
  kf[2]=*(const __attribute__((address_space(3))) bf16x8*)(kp+2048); kf[3]=*(const __attribute__((address_space(3))) bf16x8*)(kp+2560);
  kf[4]=*(const __attribute__((address_space(3))) bf16x8*)(kp+4096); kf[5]=*(const __attribute__((address_space(3))) bf16x8*)(kp+4608);
  kf[6]=*(const __attribute__((address_space(3))) bf16x8*)(kp+6144); kf[7]=*(const __attribute__((address_space(3))) bf16x8*)(kp+6656);
}
__device__ __forceinline__ void kload2(bf16x8*kf,lds_cptr kp,int j){ kf[2*j]=*(const __attribute__((address_space(3))) bf16x8*)(kp+j*2048); kf[2*j+1]=*(const __attribute__((address_space(3))) bf16x8*)(kp+j*2048+512); }
__device__ __forceinline__ s16x4 vtr(lds_cptr p){ return __builtin_bit_cast(s16x4,__builtin_amdgcn_ds_read_tr16_b64_v4i16((__attribute__((address_space(3))) v4i16_t*)p)); }
__device__ __forceinline__ float rowmax(const f32x16&p0,const f32x16&p1){
  float a=max3f(p0[0],p0[1],p1[0]),b=max3f(p0[2],p0[3],p1[1]);a=max3f(a,p1[2],p1[3]);
  #pragma unroll
  for(int r=4;r<16;r+=4){a=max3f(a,p0[r],p0[r+1]);b=max3f(b,p0[r+2],p0[r+3]);a=max3f(a,p1[r],p1[r+1]);b=max3f(b,p1[r+2],p1[r+3]);}
  const float m=max2f(a,b);
  auto rr=__builtin_amdgcn_permlane32_swap(__float_as_uint(m),__float_as_uint(m),false,false);
  return max2f(__uint_as_float(rr[0]),__uint_as_float(rr[1]));
}
__device__ __forceinline__ void pv(f32x16*o,int vb,bf16x8 pa0,bf16x8 pa1,bf16x8 pa2,bf16x8 pa3){
  #pragma unroll
  for(int d0=0;d0<2;++d0){s16x4 lo[4],hi[4];
    #pragma unroll
    for(int ks=0;ks<4;++ks){
      asm volatile("ds_read_b64_tr_b16 %0,%1 offset:%c2":"=&v"(lo[ks]):"v"(vb),"i"(d0*4096+ks*1024):"memory");
      asm volatile("ds_read_b64_tr_b16 %0,%1 offset:%c2":"=&v"(hi[ks]):"v"(vb),"i"(d0*4096+ks*1024+512):"memory");}
    asm volatile("s_waitcnt lgkmcnt(0)":::"memory");SBAR();
    #define PK(k) (bf16x8){lo[k][0],lo[k][1],lo[k][2],lo[k][3],hi[k][0],hi[k][1],hi[k][2],hi[k][3]}
    o[d0]=__builtin_amdgcn_mfma_f32_32x32x16_bf16(pa0,PK(0),o[d0],0,0,0);
    o[d0]=__builtin_amdgcn_mfma_f32_32x32x16_bf16(pa1,PK(1),o[d0],0,0,0);
    o[d0]=__builtin_amdgcn_mfma_f32_32x32x16_bf16(pa2,PK(2),o[d0],0,0,0);
    o[d0]=__builtin_amdgcn_mfma_f32_32x32x16_bf16(pa3,PK(3),o[d0],0,0,0);
    #undef PK
  }
}

#ifndef ATTN_STORE16
#define ATTN_STORE16(p,v) do{ unsigned long long* p8_=(unsigned long long*)(p); const u32x4 v_=(v); __hip_atomic_store(p8_,(unsigned long long)v_.x|((unsigned long long)v_.y<<32),__ATOMIC_RELAXED,__HIP_MEMORY_SCOPE_AGENT); __hip_atomic_store(p8_+1,(unsigned long long)v_.z|((unsigned long long)v_.w<<32),__ATOMIC_RELAXED,__HIP_MEMORY_SCOPE_AGENT); }while(0)
#endif
template<int THRL> __device__ __forceinline__ void attn_unit(long qrow0,long kvrow0,int h,int NT,const bf16*Q,const bf16*__restrict__ K,const bf16*__restrict__ V,bf16*O,char*shm){
  const int tid=otid(),lane=tid&63,r32=lane&31,hi=lane>>5; const int wid=__builtin_amdgcn_readfirstlane(tid>>6);
  const bf16*Qw=Q+(qrow0+wid*QBLK)*QP+h*D;
  const bf16*Kh=K+kvrow0*KP+(h>>2)*D,*Vh=V+kvrow0*KP+(h>>2)*D;
  const unsigned lds0=(unsigned)(uintptr_t)shm;
  float*wsf=(float*)(shm+LDS_WS)+wid*64;
  const bf16*ksrc=Kh+(long)lane*KP+wid*8;
  const bf16*vsrc=Vh+(long)(16*(wid&3)+(lane>>2))*KP+(wid>>2)*32+(lane&3)*8;
  const unsigned kdst=lds0+LDS_K+wid*1024, vdst=lds0+LDS_V+wid*1024;
  #define DMA_K(t,slot) glds16(ksrc+(long)(t)*KVBLK*KP,(unsigned)__builtin_amdgcn_readfirstlane(kdst+(slot)))
  #define DMA_V(t,slot) glds16(vsrc+(long)(t)*KVBLK*KP,(unsigned)__builtin_amdgcn_readfirstlane(vdst+(slot)))
  const int vb0=(int)(lds0+LDS_V)+((lane>>4)&1)*32+(lane&3)*8+(4*hi+((lane&15)>>2))*64;
  const char*Kbase=shm+LDS_K; bf16x8 kf[8];
  const lds_cptr shm3=(lds_cptr)shm; const lds_cptr kp0=shm3+LDS_K+hi*1024+r32*16; const lds_cptr vp0=shm3+LDS_V+((lane>>4)&1)*32+(lane&3)*8+(4*hi+((lane&15)>>2))*64;
  DMA_K(0,0);DMA_V(0,0);DMA_K(1,SLOTB);
  bf16x8 qr[4];
  #pragma unroll
  for(int d0=0;d0<4;++d0)qr[d0]=*reinterpret_cast<const bf16x8*>(&Qw[(long)r32*QP+d0*16+hi*8]);
  float mhat=0.f,l_reg=0.f;f32x16 o[2];o[0]=f32x16{};o[1]=f32x16{};f32x16 negm=f32x16{};asm volatile("":"+v"(negm));
  #define CMASK(P0,P1,t) do{}while(0)
  bool resc=false;
  #define START(P0,P1) do{ const float rm=rowmax(P0,P1); resc=false; \
    { const float dl=rm; mhat=fadd_s(mhat,dl); \
      _Pragma("unroll") for(int r=0;r<16;++r){P0[r]=fsub_s(P0[r],dl);P1[r]=fsub_s(P1[r],dl);} \
      _Pragma("unroll") for(int r=0;r<16;++r)negm[r]=-mhat; asm volatile("":"+v"(negm)); } \
    _Pragma("unroll") for(int r=0;r<16;++r)P0[r]=__builtin_amdgcn_exp2f(P0[r]); }while(0)
  #define RESC() do{ if(resc){ asm volatile("s_waitcnt lgkmcnt(0)":::"memory"); \
      _Pragma("unroll") for(int d_=0;d_<2;++d_) _Pragma("unroll") for(int r=0;r<16;++r)o[d_][r]*=wsf[crow(r,hi)]; } }while(0)
  f32x16 pA0,pA1,pB0,pB1;
  int sl_prev=0,sl_cur=0,sl_next=SLOTB;
  #define ROT() do{sl_prev=sl_cur;sl_cur=sl_next;sl_next=(sl_next==(NSLOT-1)*SLOTB)?0:sl_next+SLOTB;}while(0)
  DMA_K(2,2*SLOTB);
  WAIT_BAR(3);
  qkt(pA0,pA1,Kbase,qr,negm,r32,hi);asm volatile("s_nop 15\n\ts_nop 7":"+v"(pA0),"+v"(pA1));CMASK(pA0,pA1,0);
  START(pA0,pA1);
  _Pragma("unroll") for(int r=0;r<16;++r)pA1[r]=__builtin_amdgcn_exp2f(pA1[r]);
  WAIT_BAR(0);
  DMA_K(3,0);DMA_V(1,SLOTB);
  ROT();
  kload8(kf,kp0+sl_cur);
  WAIT_BAR(2);
  s16x4 vlo[8],vhi[8]; u32x4 pw0,pw1,pw2,pw3;
  #define PKW(P,B) cvtpk_s(P[B],P[B+1])
  #define PAF(k) __builtin_bit_cast(bf16x8,pw##k)
  #define VFR(i) (bf16x8){vlo[i][0],vlo[i][1],vlo[i][2],vlo[i][3],vhi[i][0],vhi[i][1],vhi[i][2],vhi[i][3]}
  #define PIN(x) asm volatile("":"+v"(x))
  #define MX3(a,b,c) __builtin_fmaxf(__builtin_fmaxf((a),(b)),(c))
  #define GAPA(MF,A0,A1,A2,A3,W0,W1,PW) do{ MF; sacc+=A0; sacc+=A1; sacc+=A2; sacc+=A3; PIN(sacc); W0; W1; PIN(PW); SBAR(); }while(0)
  #define EX(v) __builtin_amdgcn_exp2f(v)
  #define GAPB(MF,X,B) do{ MF; X[B]=EX(X[B]); X[B+1]=EX(X[B+1]); X[B+2]=EX(X[B+2]); X[B+3]=EX(X[B+3]); PIN(X); SBAR(); }while(0)
  #define VRD(i) do{ vlo[i]=vtr(vp_+(((i)>>2)*4096+((i)&3)*1024)); vhi[i]=vtr(vp_+(((i)>>2)*4096+((i)&3)*1024+512)); }while(0)
  #define KRD(G,j) do{ if(G){ kload2(kf,kp0+sl_next,j); SBAR(); } }while(0)
  #define STEP(C0,C1,P0,P1,t,GK,GV,GL) do{ SBAR(); \
    const lds_cptr vp_=vp0+sl_prev; \
    VRD(0); SBAR(); float sacc=(P0[0]+P0[1]); \
    GAPA(C0=__builtin_amdgcn_mfma_f32_32x32x16_bf16(kf[0],qr[0],negm,0,0,0), P0[2],P0[3],P0[4],P0[5],     pw0[0]=PKW(P0,0), pw0[1]=PKW(P0,2), pw0); \
    VRD(4); SBAR(); GAPA(C1=__builtin_amdgcn_mfma_f32_32x32x16_bf16(kf[1],qr[0],negm,0,0,0), P0[6],P0[7],P0[8],P0[9],     pw0[2]=PKW(P0,4), pw0[3]=PKW(P0,6), pw0); \
    VRD(1); SBAR(); GAPA(C0=__builtin_amdgcn_mfma_f32_32x32x16_bf16(kf[2],qr[1],C0,0,0,0),   P0[10],P0[11],P0[12],P0[13], pw1[0]=PKW(P0,8), pw1[1]=PKW(P0,10), pw1); \
    VRD(5); SBAR(); GAPA(C1=__builtin_amdgcn_mfma_f32_32x32x16_bf16(kf[3],qr[1],C1,0,0,0),   P0[14],P0[15],P1[0],P1[1],   pw1[2]=PKW(P0,12),pw1[3]=PKW(P0,14), pw1); \
    VRD(2); SBAR(); GAPA(C0=__builtin_amdgcn_mfma_f32_32x32x16_bf16(kf[4],qr[2],C0,0,0,0),   P1[2],P1[3],P1[4],P1[5],     pw2[0]=PKW(P1,0), pw2[1]=PKW(P1,2), pw2); \
    VRD(6); SBAR(); GAPA(C1=__builtin_amdgcn_mfma_f32_32x32x16_bf16(kf[5],qr[2],C1,0,0,0),   P1[6],P1[7],P1[8],P1[9],     pw2[2]=PKW(P1,4), pw2[3]=PKW(P1,6), pw2); \
    VRD(3); SBAR(); GAPA(C0=__builtin_amdgcn_mfma_f32_32x32x16_bf16(kf[6],qr[3],C0,0,0,0),   P1[10],P1[11],P1[12],P1[13], pw3[0]=PKW(P1,8), pw3[1]=PKW(P1,10), pw3); \
    VRD(7); SBAR(); GAPA(C1=__builtin_amdgcn_mfma_f32_32x32x16_bf16(kf[7],qr[3],C1,0,0,0),   P1[14],P1[15],0.f,0.f,       pw3[2]=PKW(P1,12),pw3[3]=PKW(P1,14), pw3); \
    l_reg+=sacc; \
    if(GK){DMA_K((t)+3,sl_cur);} if(GV){DMA_V((t)+1,sl_next);} \
    CMASK(C0,C1,t); \
    { float a=MX3(C0[0],C0[1],C1[0]),b=MX3(C0[2],C0[3],C1[1]); a=MX3(a,C1[2],C1[3]); \
      _Pragma("unroll") for(int r=4;r<16;r+=4){a=MX3(a,C0[r],C0[r+1]);b=MX3(b,C0[r+2],C0[r+3]);a=MX3(a,C1[r],C1[r+1]);b=MX3(b,C1[r+2],C1[r+3]);} \
      float rm=__builtin_fmaxf(a,b); { auto rr=__builtin_amdgcn_permlane32_swap(__float_as_uint(rm),__float_as_uint(rm),false,false); rm=__builtin_fmaxf(__uint_as_float(rr[0]),__uint_as_float(rr[1])); } \
      resc=false; \
      if(__builtin_expect(__any(rm>(float)THRL),0)){ const float dl=__builtin_fmaxf(rm,0.f); mhat+=dl; \
        _Pragma("unroll") for(int r=0;r<16;++r){C0[r]-=dl;C1[r]-=dl;} \
        _Pragma("unroll") for(int r=0;r<16;++r)negm[r]=-mhat; asm volatile("":"+v"(negm)); \
        const float f=__builtin_amdgcn_exp2f(-dl); l_reg*=f; if(hi==0)wsf[r32]=f; resc=true; } } \
    SBAR(); \
    GAPB(o[0]=__builtin_amdgcn_mfma_f32_32x32x16_bf16(PAF(0),VFR(0),o[0],0,0,0), C0,0); \
    GAPB(o[1]=__builtin_amdgcn_mfma_f32_32x32x16_bf16(PAF(0),VFR(4),o[1],0,0,0), C0,4); \
    KRD(GL,0); GAPB(o[0]=__builtin_amdgcn_mfma_f32_32x32x16_bf16(PAF(1),VFR(1),o[0],0,0,0), C0,8); \
    KRD(GL,1); GAPB(o[1]=__builtin_amdgcn_mfma_f32_32x32x16_bf16(PAF(1),VFR(5),o[1],0,0,0), C0,12); \
    KRD(GL,2); GAPB(o[0]=__builtin_amdgcn_mfma_f32_32x32x16_bf16(PAF(2),VFR(2),o[0],0,0,0), C1,0); \
    KRD(GL,3); GAPB(o[1]=__builtin_amdgcn_mfma_f32_32x32x16_bf16(PAF(2),VFR(6),o[1],0,0,0), C1,4); \
    GAPB(o[0]=__builtin_amdgcn_mfma_f32_32x32x16_bf16(PAF(3),VFR(3),o[0],0,0,0), C1,8); \
    GAPB(o[1]=__builtin_amdgcn_mfma_f32_32x32x16_bf16(PAF(3),VFR(7),o[1],0,0,0), C1,12); \
    }while(0)
  int t=1;
  #undef CMASK
  #define CMASK(P0,P1,t) do{}while(0)
  for(;t+5<NT;t+=2){
    STEP(pB0,pB1,pA0,pA1,t,true,true,true);     WAIT_BAR(2); RESC(); ROT();
    STEP(pA0,pA1,pB0,pB1,t+1,true,true,true);   WAIT_BAR(2); RESC(); ROT();
  }
  #undef CMASK
  #define CMASK(P0,P1,t) do{}while(0)
  #define ENDW(tt) do{ if((tt)+3<NT){WAIT_BAR(2);} else if((tt)+2<NT){WAIT_BAR(1);} else {WAIT_BAR(0);} }while(0)
  for(;t+1<NT;t+=2){
    STEP(pB0,pB1,pA0,pA1,t,(t+3<NT),(t+1<NT),(t+1<NT));       ENDW(t);   RESC(); ROT();
    STEP(pA0,pA1,pB0,pB1,t+1,(t+4<NT),(t+2<NT),(t+2<NT));     ENDW(t+1); RESC(); ROT();
  }
  STEP(pB0,pB1,pA0,pA1,NT-1,false,false,false); RESC();
  { float sacc=pB0[0]+pB0[1]; _Pragma("unroll") for(int r=2;r<16;++r)sacc+=pB0[r]; _Pragma("unroll") for(int r=0;r<16;++r)sacc+=pB1[r]; l_reg+=sacc;
    pw0=(u32x4){PKW(pB0,0),PKW(pB0,2),PKW(pB0,4),PKW(pB0,6)};pw1=(u32x4){PKW(pB0,8),PKW(pB0,10),PKW(pB0,12),PKW(pB0,14)};pw2=(u32x4){PKW(pB1,0),PKW(pB1,2),PKW(pB1,4),PKW(pB1,6)};pw3=(u32x4){PKW(pB1,8),PKW(pB1,10),PKW(pB1,12),PKW(pB1,14)};
    SBAR(); pv(o,vb0+sl_cur,PAF(0),PAF(1),PAF(2),PAF(3)); }
  #undef PKW
  #undef PAF
  #undef VFR
  #undef PIN
  #undef MX3
  #undef GAPA
  #undef GAPB
  #undef EX
  #undef VRD
  #undef KRD
  #undef STEP
  #undef ENDW
  {auto rr=__builtin_amdgcn_permlane32_swap(__float_as_uint(l_reg),__float_as_uint(l_reg),false,false);l_reg=__uint_as_float(rr[0])+__uint_as_float(rr[1]);}
  if(hi==0)wsf[32+r32]=l_reg;asm volatile("s_waitcnt lgkmcnt(0)":::"memory");
  float rli[16];
  #pragma unroll
  for(int r=0;r<16;++r)rli[r]=__builtin_amdgcn_rcpf(wsf[32+crow(r,hi)]);
  bf16*Ow=O+(qrow0+wid*QBLK)*QP+h*D;
  { bf16*stg=(bf16*)(shm+LDS_OST)+wid*2048;
    #pragma unroll
    for(int r=0;r<16;++r){const int orow=crow(r,hi);
      #pragma unroll
      for(int d0=0;d0<2;++d0)stg[orow*64+d0*32+r32]=__float2bfloat16(o[d0][r]*rli[r]);}
    asm volatile("s_waitcnt lgkmcnt(0)":::"memory");
    #pragma unroll
    for(int i=0;i<4;++i){const int row=i*8+(lane>>3),ch=lane&7; const u32x4 v=*(const u32x4*)(stg+row*64+ch*8); ATTN_STORE16(Ow+(long)row*QP+ch*8,v);} }
  asm volatile("s_waitcnt lgkmcnt(0)\n\ts_barrier":::"memory");
  #undef DMA_K
  #undef DMA_V
  #undef CMASK
  #undef START
  #undef RESC
  #undef ROT
}
constexpr int ATTN_LDS_BYTES=LDS_BYTES;
#undef SBAR
#undef WAIT_BAR
}
#define GAS __attribute__((address_space(1)))
#define LAS __attribute__((address_space(3)))
typedef unsigned short bf16;
typedef unsigned v4u __attribute__((ext_vector_type(4)));
typedef unsigned v2u __attribute__((ext_vector_type(2)));
typedef float f32x4 __attribute__((ext_vector_type(4)));
typedef short bf16x8 __attribute__((ext_vector_type(8)));

constexpr int NTOK = 17408, NLAT = 16384, DMOD = 1024, INC = 1280, DFF = 2816, DFF2 = 5632, DEPTH = 4;
constexpr int NSTAGE = 3, NPHASE = 3 + DEPTH * NSTAGE;
constexpr size_t MiB = 1u << 20;
constexpr size_t WS_CTL = 0, WS_MOD = 1 * MiB, WS_XC = 2 * MiB, WS_ROPE = 6 * MiB, WS_A16 = 7 * MiB;
constexpr size_t WS_WIN = 8 * MiB, WS_WGLU = 11 * MiB, WS_WOUT = 12 * MiB, WS_WUP = 14 * MiB, WS_WDN = 25 * MiB;
constexpr size_t WS_PFPR = 31 * MiB, WS_MTOT = 47 * MiB, WS_XN = 79 * MiB, WS_R = 113 * MiB;
constexpr size_t WS_PROJ = WS_R, WS_QO = WS_R + 43 * MiB, WS_KALL = WS_R + 60 * MiB, WS_VALL = WS_R + 65 * MiB, WS_Z = WS_R + 70 * MiB,
                 WS_SSMO = WS_R + 87 * MiB, WS_SSCR = WS_R + 104 * MiB, WS_HIN = WS_R + 138 * MiB, WS_O = WS_R + 155 * MiB;
constexpr size_t WS_HFFN = WS_R, WS_SIDE = WS_R + 94 * MiB, WS_XT2 = WS_R + 172 * MiB, WS_SSQ1 = WS_R + 206 * MiB, WS_SSQ2 = WS_R + 208 * MiB, WS_END = WS_R + 210 * MiB, WS_PART = WS_R + 104 * MiB;
constexpr size_t WS_CS = 1 * MiB + 512 * 1024, WS_BIASIN = 7 * MiB + 256 * 1024, WS_BIASUP = 7 * MiB + 512 * 1024;
constexpr int LDS_BYTES = 147456, QS_OFF = 135168;
#ifndef PHM
#define PHM 0xffff
#endif
#define PHON(k) ((PHM >> (k)) & 1)
#ifndef REP_STAGE
#define REP_STAGE -1
#endif
#ifndef REP_SYNC
#define REP_SYNC 0
#endif
constexpr float C2Q = 0.125f * 1.4426950408889634f;

struct Args { const float* in[27]; float* out; unsigned char* ws; int ph_lo, ph_hi, coop, pad; };

__device__ __forceinline__ unsigned pk2(float lo, float hi) { return pg8::cvt_pk_bf16(lo, hi); }
__device__ __forceinline__ float bflo(unsigned w) { return __uint_as_float(w << 16); }
__device__ __forceinline__ float bfhi(unsigned w) { return __uint_as_float(w & 0xffff0000u); }
__device__ __forceinline__ float wave_sum(float v) {
    v += shx<1>(v); v += shx<2>(v); v += shx<4>(v); v += shx<8>(v); v += shx<16>(v); v += shx<32>(v);
    return v;
}
__device__ __forceinline__ float silu_f(float x) { return x * __builtin_amdgcn_rcpf(1.0f + __builtin_amdgcn_exp2f(-1.4426950408889634f * x)); }
__device__ __forceinline__ float gelu_tanh(float y) { const float u = 0.7978845608028654f * (y + 0.044715f * y * y * y); return y * __builtin_amdgcn_rcpf(1.0f + __builtin_amdgcn_exp2f(-2.8853900817779268f * u)); }

__device__ __forceinline__ void transpose_item(const float* W, int K, int N, bf16* WT, LAS float* scr, int item, int lane, int rmap = 0) {
    const int nblk = N / 32, kb = item / nblk, nb = item % nblk, k0 = 64 * kb, n0 = 32 * nb;
    const int r0 = rmap == 2 ? (n0 >= 768 ? n0 : ((n0 >> 6) < 8 ? ((n0 >> 6) >> 2) * 256 + ((n0 >> 6) & 3) * 32 : 512 + ((n0 >> 6) - 8) * 32) + 128 * ((n0 >> 5) & 1)) : rmap == 0 ? n0 : (n0 < 2816 ? (n0 >> 7) * 256 + (n0 & 127) : ((n0 - 2816) >> 7) * 256 + 128 + ((n0 - 2816) & 127));
#pragma unroll 8
    for (int i = 0; i < 32; ++i) { const int kk = 2 * i + (lane >> 5); scr[kk * 33 + (lane & 31)] = W[(size_t)(k0 + kk) * N + n0 + (lane & 31)]; }
    asm volatile("s_waitcnt lgkmcnt(0)" ::: "memory");
    const int c = lane & 7;
#pragma unroll
    for (int j = 0; j < 4; ++j) { const int n = (lane >> 3) + 8 * j; const LAS float* s = scr + (8 * c) * 33 + n;
        v4u o; o.x = pk2(s[0 * 33], s[1 * 33]); o.y = pk2(s[2 * 33], s[3 * 33]); o.z = pk2(s[4 * 33], s[5 * 33]); o.w = pk2(s[6 * 33], s[7 * 33]);
        *(v4u*)(WT + (size_t)(r0 + n) * K + k0 + 8 * c) = o; }
    asm volatile("s_waitcnt lgkmcnt(0)" ::: "memory");
}

__device__ __forceinline__ float* xrow(float* xlat, float* xctx, int row) { return row < NLAT ? xlat + (size_t)row * DMOD : xctx + (size_t)(row - NLAT) * DMOD; }
__device__ __forceinline__ int modv(int row) { return row < NLAT ? (row >> 12) : 4; }

__device__ __forceinline__ void norm_row(const float* src, float* dstcopy, bf16* xn, const float* g, const float* shift, const float* scale, int lane) {
    const f32x4* xr = (const f32x4*)src + lane;
    f32x4 v[4]; float s = 0.f;
#pragma unroll
    for (int j = 0; j < 4; ++j) { v[j] = xr[64 * j]; s += (v[j].x * v[j].x + v[j].y * v[j].y) + (v[j].z * v[j].z + v[j].w * v[j].w); }
    if (dstcopy) {
#pragma unroll
        for (int j = 0; j < 4; ++j) ((f32x4*)dstcopy + lane)[64 * j] = v[j];
    }
    const float rstd = __builtin_amdgcn_rsqf(wave_sum(s) * (1.f / DMOD) + 1e-6f);
    unsigned long long* o8 = (unsigned long long*)xn + lane;
#pragma unroll
    for (int j = 0; j < 4; ++j) {
        const f32x4 gg = ((const f32x4*)g + lane)[64 * j], sh = ((const f32x4*)shift + lane)[64 * j], sc = ((const f32x4*)scale + lane)[64 * j];
        const f32x4 y = (v[j] * rstd) * gg * (sc + 1.0f) + sh;
        o8[64 * j] = (unsigned long long)pk2(y.x, y.y) | ((unsigned long long)pk2(y.z, y.w) << 32);
    }
}
__device__ __forceinline__ void ssm_tables(const Args& a, LAS unsigned char* lds, int layer, int g, int tid) {
    LAS float* pw = (LAS float*)lds;
    LAS float* bbs = pw + 4352;
    LAS float* cs = bbs + 4096;
    LAS float* G = cs + 4096;
    if (tid < 128) {
        const int dir = tid >> 6, n = tid & 63; const int gi = (layer * 2 + dir) * 32 + g; const int idx = gi * 64 + n;
        const float lr = a.in[10][idx], li = a.in[11][idx], dt = expf(a.in[12][gi]);
        for (int e = 0; e <= 16; ++e) { const float mag = expf(lr * dt * (float)e), ang = li * dt * (float)e;
            pw[((dir * 17 + e) * 64 + n) * 2] = mag * cosf(ang); pw[((dir * 17 + e) * 64 + n) * 2 + 1] = mag * sinf(ang); }
        const float mag1 = expf(lr * dt); const float are = mag1 * cosf(li * dt), aim = mag1 * sinf(li * dt), den = lr * lr + li * li;
        const float fre = ((are - 1.f) * lr + aim * li) / den, fim = (aim * lr - (are - 1.f) * li) / den;
        for (int q = 0; q < 16; ++q) { const float br = a.in[13][(size_t)idx * 16 + q], bi = a.in[14][(size_t)idx * 16 + q];
            bbs[((dir * 64 + n) * 16 + q) * 2] = fre * br - fim * bi; bbs[((dir * 64 + n) * 16 + q) * 2 + 1] = fre * bi + fim * br; }
    }
    for (int i = tid; i < 2048; i += 512) { const int dir = i >> 10, p = (i >> 6) & 15, n = i & 63; const size_t src = ((size_t)((layer * 2 + dir) * 32 + g) * 16 + p) * 64 + n;
        cs[2 * i] = a.in[15][src]; cs[2 * i + 1] = a.in[16][src]; }
    __syncthreads();
    for (int i = tid; i < 8192; i += 512) { const int dir = i >> 12, l = (i >> 8) & 15, p = (i >> 4) & 15, q = i & 15; float sum = 0.f;
        for (int n = 0; n < 64; ++n) { const float cr = cs[((dir * 16 + p) * 64 + n) * 2], ci = cs[((dir * 16 + p) * 64 + n) * 2 + 1];
            const float ar = pw[((dir * 17 + l) * 64 + n) * 2], ai = pw[((dir * 17 + l) * 64 + n) * 2 + 1];
            const float br = bbs[((dir * 64 + n) * 16 + q) * 2], bi = bbs[((dir * 64 + n) * 16 + q) * 2 + 1];
            const float zr = cr * ar - ci * ai, zi = cr * ai + ci * ar; sum += zr * br - zi * bi; }
        G[i] = sum; }
    __syncthreads();
    bf16* Mt = (bf16*)(a.ws + WS_MTOT) + (size_t)(layer * 32 + g) * 256 * 512;
    for (int i = tid; i < 16384; i += 512) { const int row = i >> 6, k0 = (i & 63) * 8, t = row >> 4, p = row & 15; float v[8];
        if (k0 < 256) { const int sp = k0 >> 4, q0 = k0 & 15;
#pragma unroll
            for (int jj = 0; jj < 8; ++jj) { const int q = q0 + jj; float x = 0.f;
                if (sp <= t) x += G[((0 * 16 + (t - sp)) * 16 + p) * 16 + q];
                if (sp >= t) x += G[((1 * 16 + (sp - t)) * 16 + p) * 16 + q];
                if (sp == t && p == q) x += a.in[17][(layer * 32 + g) * 16 + p];
                v[jj] = x; }
        } else {
#pragma unroll
            for (int jj = 0; jj < 8; ++jj) { const int nn = k0 - 256 + jj, dir = nn >> 7, comp = (nn >> 6) & 1, n = nn & 63, e = dir == 0 ? t + 1 : 16 - t;
                const float cr = cs[((dir * 16 + p) * 64 + n) * 2], ci = cs[((dir * 16 + p) * 64 + n) * 2 + 1];
                const float ar = pw[((dir * 17 + e) * 64 + n) * 2], ai = pw[((dir * 17 + e) * 64 + n) * 2 + 1];
                v[jj] = comp == 0 ? (cr * ar - ci * ai) : -(cr * ai + ci * ar); }
        }
        v4u o; o.x = pk2(v[0], v[1]); o.y = pk2(v[2], v[3]); o.z = pk2(v[4], v[5]); o.w = pk2(v[6], v[7]);
        *(v4u*)(Mt + (size_t)row * 512 + k0) = o; }
    bf16* Pf = (bf16*)(a.ws + WS_PFPR) + (size_t)(layer * 32 + g) * 256 * 256;
    for (int i = tid; i < 8192; i += 512) { const int nn = i >> 5, k0 = (i & 31) * 8, sp = k0 >> 4, q0 = k0 & 15, dir = nn >> 7, comp = (nn >> 6) & 1, n = nn & 63, e = dir == 0 ? 15 - sp : sp;
        const float ar = pw[((dir * 17 + e) * 64 + n) * 2], ai = pw[((dir * 17 + e) * 64 + n) * 2 + 1]; float v[8];
#pragma unroll
        for (int jj = 0; jj < 8; ++jj) { const float br = bbs[((dir * 64 + n) * 16 + q0 + jj) * 2], bi = bbs[((dir * 64 + n) * 16 + q0 + jj) * 2 + 1];
            v[jj] = comp == 0 ? (ar * br - ai * bi) : (ar * bi + ai * br); }
        v4u o; o.x = pk2(v[0], v[1]); o.y = pk2(v[2], v[3]); o.z = pk2(v[4], v[5]); o.w = pk2(v[6], v[7]);
        *(v4u*)(Pf + (size_t)nn * 256 + k0) = o; }
    if (tid < 128) { const int dir = tid >> 6, n = tid & 63; float* A16 = (float*)(a.ws + WS_A16);
        A16[(((layer * 32 + g) * 2 + dir) * 64 + n) * 2] = pw[((dir * 17 + 16) * 64 + n) * 2]; A16[(((layer * 32 + g) * 2 + dir) * 64 + n) * 2 + 1] = pw[((dir * 17 + 16) * 64 + n) * 2 + 1]; }
    __syncthreads();
}

__device__ __forceinline__ void gemv_item(const float* W, int N, int n0, const LAS float* sv, LAS float* red, float* out, int ostride, const float* badd, int tid) {
    typedef float f32x2 __attribute__((ext_vector_type(2)));
    const int lane = tid & 63, wave = tid >> 6; const float* Wp = W + (size_t)(wave * 128) * N + n0 + 2 * lane;
    float acc[5][2];
#pragma unroll
    for (int v = 0; v < 5; ++v) { acc[v][0] = 0.f; acc[v][1] = 0.f; }
    for (int k0 = 0; k0 < 128; k0 += 16) {
        f32x2 w[16];
#pragma unroll
        for (int j = 0; j < 16; ++j) w[j] = *(const f32x2*)(Wp + (size_t)(k0 + j) * N);
#pragma unroll
        for (int j = 0; j < 16; ++j)
#pragma unroll
            for (int v = 0; v < 5; ++v) { const float sx = sv[v * 1024 + wave * 128 + k0 + j]; acc[v][0] += sx * w[j].x; acc[v][1] += sx * w[j].y; }
    }
#pragma unroll
    for (int v = 0; v < 5; ++v) { red[(wave * 5 + v) * 128 + 2 * lane] = acc[v][0]; red[(wave * 5 + v) * 128 + 2 * lane + 1] = acc[v][1]; }
    __syncthreads();
    for (int i = tid; i < 5 * 128; i += 512) { const int v = i >> 7, c = i & 127; float sum = badd ? badd[n0 + c] : 0.f;
#pragma unroll
        for (int w8 = 0; w8 < 8; ++w8) sum += red[(w8 * 5 + v) * 128 + c];
        out[(size_t)v * ostride + n0 + c] = sum; }
    __syncthreads();
}
__device__ __forceinline__ void p0_phase(const Args& a, LAS unsigned char* lds, int tid) {
    LAS float* sv = (LAS float*)lds;
    LAS float* red = sv + 5 * 1024;
    for (int i = tid; i < 5 * 1024; i += 512) { const int v = i >> 10, k = i & 1023; const float x = v < 4 ? a.in[1][v * 1024 + k] : a.in[3][k]; sv[i] = silu_f(x); }
    __syncthreads();
    float* mod = (float*)(a.ws + WS_MOD);
    const int G0 = ogrid(), half0 = G0 >= 256 ? 128 : 0;
    if (obid() < half0 || half0 == 0) { for (int it = obid(); it < DEPTH * 32; it += (half0 ? half0 : G0)) ssm_tables(a, lds + 49152, it >> 5, it & 31, tid); }
    for (int it = (half0 ? obid() - half0 : obid()); it >= 0 && it < DEPTH * 48; it += (half0 ? G0 - half0 : G0)) {
        const int l = it / 48, n0 = (it % 48) * 128;
        gemv_item(a.in[4] + (size_t)l * 1024 * 6144, 6144, n0, sv, red, mod + (size_t)l * 5 * 6144, 6144, a.in[5] + l * 6144, tid);
    }
    if (obid() == ogrid() - 1) {
        float* rt = (float*)(a.ws + WS_ROPE);
        for (int i = tid; i < 1024; i += 512) { const int p = i >> 4, f = i & 15; const float fr = powf(10000.0f, -(float)f / 16.0f); const float ang = (float)p * fr;
            rt[i] = cosf(ang); rt[1024 + i] = sinf(ang); }
    }
}

__device__ __forceinline__ void p1_phase(const Args& a, LAS unsigned char* lds, int tid) {
    LAS float* sv = (LAS float*)lds;
    LAS float* red = sv + 5 * 1024;
    const float* mod = (const float*)(a.ws + WS_MOD); float* cs = (float*)(a.ws + WS_CS);
    for (int i = obid() * 512 + tid; i < DEPTH * 2 * 5 * 1024; i += ogrid() * 512) { const int k = i & 1023, v = (i >> 10) % 5, which = (i / 5120) & 1, l = i / 10240;
        const float g = which == 0 ? a.in[6][l * 1024 + k] : a.in[22][l * 1024 + k]; cs[i] = g * (1.0f + mod[((size_t)l * 5 + v) * 6144 + (which == 0 ? 1024 : 4096) + k]); }
    for (int it = obid(); it < DEPTH * 54; it += ogrid()) {
        const int l = it / 54, r = it % 54; const bool up = r >= 10; const int n0 = (up ? r - 10 : r) * 128, N = up ? 5632 : 1280;
        for (int i = tid; i < 5 * 1024; i += 512) sv[i] = mod[((size_t)l * 5 + (i >> 10)) * 6144 + (up ? 3072 : 0) + (i & 1023)];
        __syncthreads();
        float* bo = up ? (float*)(a.ws + WS_BIASUP) + (size_t)l * 5 * 5632 : (float*)(a.ws + WS_BIASIN) + (size_t)l * 5 * 1280;
        gemv_item(up ? a.in[23] + (size_t)l * 1024 * 5632 : a.in[7] + (size_t)l * 1024 * 1280, N, n0, sv, red, bo, N, nullptr, tid);
    }
}

__device__ __forceinline__ void prep_row(const float* src, float* dstcopy, bf16* xt, const float* gnorm, const float* scl, float* ssq, int lane) {
    const f32x4* xr = (const f32x4*)src + lane; f32x4 v[4]; float s = 0.f;
#pragma unroll
    for (int j = 0; j < 4; ++j) { v[j] = xr[64 * j]; s += (v[j].x * v[j].x + v[j].y * v[j].y) + (v[j].z * v[j].z + v[j].w * v[j].w); }
#pragma unroll
    for (int j = 0; j < 4; ++j) ((f32x4*)dstcopy + lane)[64 * j] = v[j];
    s = wave_sum(s);
    if (lane < 16) ssq[lane] = lane == 0 ? s : 0.f;
    unsigned long long* o8 = (unsigned long long*)xt + lane;
#pragma unroll
    for (int j = 0; j < 4; ++j) { const f32x4 y = v[j] * (((const f32x4*)gnorm + lane)[64 * j] * (((const f32x4*)scl + lane)[64 * j] + 1.0f)); o8[64 * j] = (unsigned long long)pk2(y.x, y.y) | ((unsigned long long)pk2(y.z, y.w) << 32); }
}
__device__ __forceinline__ void transposes_range(const Args& a, LAS unsigned char* lds, int layer, int lo, int hi, int gw, int NGW, int lane, int wave) {
    LAS float* scr = (LAS float*)(lds + wave * 16384);
    constexpr int I_IN = 16 * 40, I_GLU = 8 * 16, I_OUT = 16 * 32, I_UP = 16 * 176;
    for (int it = lo + gw; it < hi; it += NGW) {
        int r = it;
        if (r < I_IN) { transpose_item(a.in[7] + (size_t)layer * 1024 * 1280, 1024, 1280, (bf16*)(a.ws + WS_WIN), scr, r, lane, 2); continue; } r -= I_IN;
        if (r < I_GLU) { transpose_item(a.in[18] + (size_t)layer * 512 * 512, 512, 512, (bf16*)(a.ws + WS_WGLU), scr, r, lane); continue; } r -= I_GLU;
        if (r < I_OUT) { transpose_item(a.in[21] + (size_t)layer * 1024 * 1024, 1024, 1024, (bf16*)(a.ws + WS_WOUT), scr, r, lane); continue; } r -= I_OUT;
        if (r < I_UP) { transpose_item(a.in[23] + (size_t)layer * 1024 * 5632, 1024, 5632, (bf16*)(a.ws + WS_WUP), scr, r, lane, 1); continue; } r -= I_UP;
        transpose_item(a.in[26] + (size_t)layer * 2816 * 1024, 2816, 1024, (bf16*)(a.ws + WS_WDN), scr, r, lane);
    }
}
__device__ __forceinline__ void combine_row(const Args& a, int layer, int r, int lane) {
    float* xc = (float*)(a.ws + WS_XC); bf16* xn = (bf16*)(a.ws + WS_XN) + (size_t)NLAT * DMOD; float* ssq = (float*)(a.ws + WS_SSQ1) + (size_t)NLAT * 16;
    const float* csv = (const float*)(a.ws + WS_CS) + ((size_t)(layer * 2) * 5 + 4) * 1024; const float* gate = (const float*)(a.ws + WS_MOD) + ((size_t)(layer - 1) * 5 + 4) * 6144 + 5120;
    const float* P = (const float*)(a.ws + WS_PART);
    float s = 0.f;
#pragma unroll
    for (int j = 0; j < 4; ++j) { const int col = 4 * lane + 256 * j; f32x4 p = *(const f32x4*)(P + (size_t)r * 1024 + col);
#pragma unroll
        for (int ks = 1; ks < 11; ++ks) p = p + *(const f32x4*)(P + ((size_t)ks * 1024 + r) * 1024 + col);
        f32x4 x = *(const f32x4*)(xc + (size_t)r * 1024 + col) + *(const f32x4*)(gate + col) * p; *(f32x4*)(xc + (size_t)r * 1024 + col) = x;
        s += (x.x * x.x + x.y * x.y) + (x.z * x.z + x.w * x.w); const f32x4 y = x * *(const f32x4*)(csv + col);
        *(unsigned long long*)(xn + (size_t)r * 1024 + col) = (unsigned long long)pk2(y.x, y.y) | ((unsigned long long)pk2(y.z, y.w) << 32); }
    s = wave_sum(s);
    if (lane < 16) ssq[(size_t)r * 16 + lane] = lane == 0 ? s : 0.f;
}
__device__ __forceinline__ void prep_phase(const Args& a, LAS unsigned char* lds, int layer, int tid, int lane, int wave) {
    const int gw = obid() * 8 + wave, NGW = ogrid() * 8;
    transposes_range(a, lds, layer, 0, 5504, gw, NGW, lane, wave);
    float* xc = (float*)(a.ws + WS_XC); bf16* xn = (bf16*)(a.ws + WS_XN); float* ssq = (float*)(a.ws + WS_SSQ1);
    for (int row = gw; row < NTOK; row += NGW) {
        const float* src = row < NLAT ? a.in[0] + (size_t)row * DMOD : a.in[2] + (size_t)(row - NLAT) * DMOD;
        prep_row(src, xrow(a.out, xc, row), xn + (size_t)row * DMOD, a.in[6], (const float*)(a.ws + WS_MOD) + (size_t)modv(row) * 6144 + 1024, ssq + (size_t)row * 16, lane);
    }
}

__device__ __forceinline__ int tokrow(int b, int c) { return c < 16 ? NLAT + b * 256 + 16 * c : b * 4096 + 16 * (c - 16); }
__device__ __forceinline__ void ssm_unit(const Args& a, LAS unsigned char* lds3, int layer, int b, int g) {
    const int tid = otid(), lane = tid & 63, wave = __builtin_amdgcn_readfirstlane(tid >> 6);
    const bf16* proj = (const bf16*)(a.ws + WS_PROJ) + 16 * g;
    const bf16* Pf = (const bf16*)(a.ws + WS_PFPR) + (size_t)(layer * 32 + g) * 256 * 256;
    const bf16* Mt = (const bf16*)(a.ws + WS_MTOT) + (size_t)(layer * 32 + g) * 256 * 512;
    const int unit = b * 32 + g;
    float* Sscr = (float*)(a.ws + WS_SSCR) + (size_t)unit * 272 * 256;
    bf16* Hin = (bf16*)(a.ws + WS_HIN) + (size_t)unit * 272 * 256;
    bf16* Z = (bf16*)(a.ws + WS_Z);
    const int i = lane & 15, kb = lane >> 4, sp_lo = kb >> 1, q0 = 8 * (kb & 1);
    const int lr = tid >> 5, lp = tid & 31;
    LAS unsigned char* ubuf = lds3;
    LAS unsigned char* hbuf = lds3 + 2 * 8448;
    {
        bf16x8 pf[2][8];
#pragma unroll
        for (int j = 0; j < 2; ++j)
#pragma unroll
            for (int ks = 0; ks < 8; ++ks) pf[j][ks] = *(const bf16x8*)(Pf + (size_t)(32 * wave + 16 * j + i) * 256 + 32 * ks + 8 * kb);
        v4u nx = *(const v4u*)(proj + ((size_t)tokrow(b, lr) + (lp >> 1)) * 512 + 8 * (lp & 1));
        for (int mt = 0; mt < 17; ++mt) {
            LAS unsigned char* ub = ubuf + (mt & 1) * 8448;
            *(LAS v4u*)(ub + lr * 528 + lp * 16) = nx;
            { const int mtn = mt < 16 ? mt + 1 : 16; nx = *(const v4u*)(proj + ((size_t)tokrow(b, 16 * mtn + lr) + (lp >> 1)) * 512 + 8 * (lp & 1)); }
            __syncthreads();
            pg8::f32x4 acc0 = {0.f, 0.f, 0.f, 0.f}, acc1 = {0.f, 0.f, 0.f, 0.f};
#pragma unroll
            for (int ks = 0; ks < 8; ++ks) { const bf16x8 af = *(const LAS bf16x8*)(ub + i * 528 + (32 * ks + 8 * kb) * 2);
                acc0 = __builtin_amdgcn_mfma_f32_16x16x32_bf16(af, pf[0][ks], acc0, 0, 0, 0); acc1 = __builtin_amdgcn_mfma_f32_16x16x32_bf16(af, pf[1][ks], acc1, 0, 0, 0); }
#pragma unroll
            for (int r = 0; r < 4; ++r) { float* sp = Sscr + (size_t)(16 * mt + 4 * kb + r) * 256 + 32 * wave + i; sp[0] = acc0[r]; sp[16] = acc1[r]; }
        }
    }
    __syncthreads();
    if (wave < 2) {
        const int dir = wave, n = lane; const float* A16 = (const float*)(a.ws + WS_A16) + (((layer * 32 + g) * 2 + dir) * 64 + n) * 2;
        const float ar = A16[0], ai = A16[1]; float hr = 0.f, hi = 0.f;
        const float* sb = Sscr + dir * 128 + n; bf16* hb = Hin + dir * 128 + n;
        float sr[16], si[16], tr[16], ti[16];
#pragma unroll
        for (int j = 0; j < 16; ++j) { const int c = dir == 0 ? j : 15 - j; sr[j] = sb[(size_t)c * 256]; si[j] = sb[(size_t)c * 256 + 64]; }
        for (int s0 = 0; s0 < 272; s0 += 16) {
            const int s1 = s0 + 16 < 272 ? s0 + 16 : s0;
#pragma unroll
            for (int j = 0; j < 16; ++j) { const int st = s1 + j; const int c = dir == 0 ? st : (st < 16 ? 15 - st : 287 - st); tr[j] = sb[(size_t)c * 256]; ti[j] = sb[(size_t)c * 256 + 64]; }
#pragma unroll
            for (int j = 0; j < 16; ++j) { const int st = s0 + j; const int c = dir == 0 ? st : (st < 16 ? 15 - st : 287 - st);
                hb[(size_t)c * 256] = (bf16)(pk2(hr, 0.f) & 0xffffu); hb[(size_t)c * 256 + 64] = (bf16)(pk2(hi, 0.f) & 0xffffu);
                const float nr = ar * hr - ai * hi + sr[j], ni = ar * hi + ai * hr + si[j]; hr = nr; hi = ni; }
#pragma unroll
            for (int j = 0; j < 16; ++j) { sr[j] = tr[j]; si[j] = ti[j]; }
        }
    }
    __syncthreads();
    {
        bf16x8 mf[2][16];
#pragma unroll
        for (int j = 0; j < 2; ++j)
#pragma unroll
            for (int ks = 0; ks < 16; ++ks) mf[j][ks] = *(const bf16x8*)(Mt + (size_t)(32 * wave + 16 * j + i) * 512 + 32 * ks + 8 * kb);
        v4u nx = *(const v4u*)(proj + ((size_t)tokrow(b, lr) + (lp >> 1)) * 512 + 8 * (lp & 1));
        v4u nh = *(const v4u*)(Hin + (size_t)lr * 256 + 8 * lp);
        for (int mt = 0; mt < 17; ++mt) {
            LAS unsigned char* ub = ubuf + (mt & 1) * 8448; LAS unsigned char* hb2 = hbuf + (mt & 1) * 8448;
            *(LAS v4u*)(ub + lr * 528 + lp * 16) = nx; *(LAS v4u*)(hb2 + lr * 528 + lp * 16) = nh;
            { const int mtn = mt < 16 ? mt + 1 : 16; nx = *(const v4u*)(proj + ((size_t)tokrow(b, 16 * mtn + lr) + (lp >> 1)) * 512 + 8 * (lp & 1));
              nh = *(const v4u*)(Hin + (size_t)(16 * mtn + lr) * 256 + 8 * lp); }
            __syncthreads();
            const size_t rb = (size_t)tokrow(b, 16 * mt + i);
            pg8::f32x4 acc0 = {0.f, 0.f, 0.f, 0.f}, acc1 = {0.f, 0.f, 0.f, 0.f};
#pragma unroll
            for (int ks = 0; ks < 16; ++ks) { const bf16x8 af = ks < 8 ? *(const LAS bf16x8*)(ub + i * 528 + (32 * ks + 8 * kb) * 2) : *(const LAS bf16x8*)(hb2 + i * 528 + (32 * (ks - 8) + 8 * kb) * 2);
                acc0 = __builtin_amdgcn_mfma_f32_16x16x32_bf16(mf[0][ks], af, acc0, 0, 0, 0); acc1 = __builtin_amdgcn_mfma_f32_16x16x32_bf16(mf[1][ks], af, acc1, 0, 0, 0); }
            bf16* zp = Z + (rb + 2 * wave) * 512 + 16 * g + 4 * kb;
            { v2u o; o.x = pk2(gelu_tanh(acc0[0]), gelu_tanh(acc0[1])); o.y = pk2(gelu_tanh(acc0[2]), gelu_tanh(acc0[3])); *(v2u*)zp = o; }
            { v2u o; o.x = pk2(gelu_tanh(acc1[0]), gelu_tanh(acc1[1])); o.y = pk2(gelu_tanh(acc1[2]), gelu_tanh(acc1[3])); *(v2u*)(zp + 512) = o; }
        }
    }
    __syncthreads();
}

__device__ __forceinline__ void merge_rows(const Args& a, int layer, int lane, int gw, int NGW, int row_lo, int nrows) {
    const bf16* qo = (const bf16*)(a.ws + WS_O); const bf16* so = (const bf16*)(a.ws + WS_SSMO); bf16* xn = (bf16*)(a.ws + WS_XN);
    const float* gn = a.in[20] + layer * 1024;
    for (int row = row_lo + gw; row < nrows; row += NGW) {
#pragma unroll
        for (int h = 0; h < 2; ++h) {
            const v4u w = *(const v4u*)((h == 0 ? qo : so) + (size_t)row * 512 + 8 * lane);
            float v[8] = {bflo(w.x), bfhi(w.x), bflo(w.y), bfhi(w.y), bflo(w.z), bfhi(w.z), bflo(w.w), bfhi(w.w)};
            float s = 0.f;
#pragma unroll
            for (int k = 0; k < 8; ++k) s += v[k] * v[k];
            const float rstd = __builtin_amdgcn_rsqf(wave_sum(s) * (1.f / 512.f) + 1e-6f);
            const float* gp = gn + h * 512 + 8 * lane;
            v4u o; o.x = pk2(v[0] * rstd * gp[0], v[1] * rstd * gp[1]); o.y = pk2(v[2] * rstd * gp[2], v[3] * rstd * gp[3]);
            o.z = pk2(v[4] * rstd * gp[4], v[5] * rstd * gp[5]); o.w = pk2(v[6] * rstd * gp[6], v[7] * rstd * gp[7]);
            *(v4u*)(xn + (size_t)row * 1024 + h * 512 + 8 * lane) = o;
        }
    }
}

__device__ __forceinline__ void fix_phase(const Args& a, int layer, int tid) {
    bf16* hf = (bf16*)(a.ws + WS_HFFN); const float* side = (const float*)(a.ws + WS_SIDE);
    const float* cw = a.in[24] + (size_t)layer * 3 * DFF2;
    for (int it = obid() * 512 + tid; it < 60 * 2 * 704; it += ogrid() * 512) {
        const int c = (it % 704) * 4, r = it / 704, kind = r & 1, bi = r >> 1, pm = (bi / 15) * 16 + (bi % 15) + 1;
        pg8::f32x4 oa, og; size_t row;
        if (kind == 0) { const float* pf = side + ((size_t)pm * 4 + 1) * 5632; const float* rl = side + ((size_t)(pm - 1) * 4 + 2) * 5632; row = (size_t)pm * 256;
            oa = *(const pg8::f32x4*)(pf + c) + *(const pg8::f32x4*)(cw + c) * *(const pg8::f32x4*)(rl + c);
            og = *(const pg8::f32x4*)(pf + 2816 + c) + *(const pg8::f32x4*)(cw + 2816 + c) * *(const pg8::f32x4*)(rl + 2816 + c); }
        else { const float* pl = side + ((size_t)(pm - 1) * 4 + 3) * 5632; const float* rf = side + ((size_t)pm * 4 + 0) * 5632; row = (size_t)pm * 256 - 1;
            oa = *(const pg8::f32x4*)(pl + c) + *(const pg8::f32x4*)(cw + 2 * 5632 + c) * *(const pg8::f32x4*)(rf + c);
            og = *(const pg8::f32x4*)(pl + 2816 + c) + *(const pg8::f32x4*)(cw + 2 * 5632 + 2816 + c) * *(const pg8::f32x4*)(rf + 2816 + c); }
        v2u o; o.x = pk2(silu_f(og[0]) * oa[0], silu_f(og[1]) * oa[1]); o.y = pk2(silu_f(og[2]) * oa[2], silu_f(og[3]) * oa[3]);
        *(v2u*)(hf + row * DFF + c) = o;
    }
}

__device__ __forceinline__ void fix_tile(const Args& a, int layer, int pm, int tid) {
    bf16* hf = (bf16*)(a.ws + WS_HFFN); const float* side = (const float*)(a.ws + WS_SIDE);
    const float* cw = a.in[24] + (size_t)layer * 3 * DFF2;
    for (int it = tid; it < 2 * 704; it += 512) {
        const int c = (it % 704) * 4, kind = it / 704;
        if (kind == 0 ? (pm & 15) == 0 : (pm & 15) == 15) continue;
        pg8::f32x4 oa, og; size_t row;
        if (kind == 0) { const float* pf = side + ((size_t)pm * 4 + 1) * 5632; const float* rl = side + ((size_t)(pm - 1) * 4 + 2) * 5632; row = (size_t)pm * 256;
            oa = *(const pg8::f32x4*)(pf + c) + *(const pg8::f32x4*)(cw + c) * *(const pg8::f32x4*)(rl + c);
            og = *(const pg8::f32x4*)(pf + 2816 + c) + *(const pg8::f32x4*)(cw + 2816 + c) * *(const pg8::f32x4*)(rl + 2816 + c); }
        else { const float* pl = side + ((size_t)pm * 4 + 3) * 5632; const float* rf = side + ((size_t)(pm + 1) * 4 + 0) * 5632; row = (size_t)pm * 256 + 255;
            oa = *(const pg8::f32x4*)(pl + c) + *(const pg8::f32x4*)(cw + 2 * 5632 + c) * *(const pg8::f32x4*)(rf + c);
            og = *(const pg8::f32x4*)(pl + 2816 + c) + *(const pg8::f32x4*)(cw + 2 * 5632 + 2816 + c) * *(const pg8::f32x4*)(rf + 2816 + c); }
        v2u o; o.x = pk2(silu_f(og[0]) * oa[0], silu_f(og[1]) * oa[1]); o.y = pk2(silu_f(og[2]) * oa[2], silu_f(og[3]) * oa[3]);
        *(v2u*)(hf + row * DFF + c) = o;
    }
    asm volatile("s_waitcnt vmcnt(0)" ::: "memory"); __syncthreads();
}

#define RLX_AGENT __ATOMIC_RELAXED, __HIP_MEMORY_SCOPE_AGENT
#define XB_TMO      128
#define XB_XCNT(j)  (256  + 64 * (j))
#define XB_XSUB(j)  (1280 + 64 * (j))
#define XB_XGEN(j)  (2304 + 64 * (j))
#define XB_TOP      3328
#define XB_TOPGEN   3392
#define XCD_BAR_WORDS 3456
#define XB_SPIN_CAP (1u << 18)

__device__ __forceinline__ unsigned xb_ld(unsigned* p)              { return __hip_atomic_load(p, __ATOMIC_RELAXED, __HIP_MEMORY_SCOPE_AGENT); }
__device__ __forceinline__ unsigned xb_add(unsigned* p, unsigned v) { return __hip_atomic_fetch_add(p, v, __ATOMIC_RELAXED, __HIP_MEMORY_SCOPE_AGENT); }
__device__ __forceinline__ unsigned xb_xcc_id() { return (unsigned)__builtin_amdgcn_s_getreg((3 << 11) | 20) & 0xFu; }
#define XB_SPIN(cond, bar) do { unsigned _sp = 0; while (cond) { __builtin_amdgcn_s_sleep(1); \
    if ((++_sp & 255u) == 0u) { if (xb_ld(&(bar)[XB_TMO])) break; if (_sp > XB_SPIN_CAP) { atomicAdd(&(bar)[XB_TMO], 1u); break; } } } } while (0)

struct XcdBarrier {
    unsigned* bar; unsigned x;
    volatile LAS unsigned* st;
};

__device__ __forceinline__ XcdBarrier xcd_barrier_post(unsigned* bar, volatile LAS unsigned* st) {
    XcdBarrier b; b.bar = bar; b.x = xb_xcc_id(); b.st = st;
    if (otid() == 0) (void)xb_add(&bar[XB_XCNT(b.x)], 1u);
    return b;
}
__device__ __forceinline__ void xcd_barrier_complete(unsigned* bar, unsigned x, unsigned& nloc, unsigned& nx) {
    const unsigned G = (unsigned)ogrid();
    unsigned sum, cnt, mine, sp = 0u;
    for (;;) {
        sum = 0u; cnt = 0u; mine = 0u;
#pragma unroll
        for (unsigned j = 0; j < 16; ++j) { const unsigned c = xb_ld(&bar[XB_XCNT(j)]); sum += c; cnt += (c > 0u) ? 1u : 0u; mine = (j == x) ? c : mine; }
        if (sum == G) break;
        __builtin_amdgcn_s_sleep(1);
        if ((++sp & 255u) == 0u) { if (xb_ld(&bar[XB_TMO])) break; if (sp > XB_SPIN_CAP) { atomicAdd(&bar[XB_TMO], 1u); break; } }
    }
    nloc = mine > 0u ? mine : 1u; nx = cnt > 0u ? cnt : 1u;
}

__device__ __forceinline__ void xcd_barrier(const XcdBarrier& b) {
    asm volatile("s_waitcnt vmcnt(0)" ::: "memory");
    __syncthreads();
    if (otid() == 0) {
        unsigned* bar = b.bar;
        __builtin_amdgcn_s_waitcnt(0);
        unsigned nloc = b.st[0], nx = b.st[1];
        if (nloc == 0u) { xcd_barrier_complete(bar, b.x, nloc, nx); b.st[0] = nloc; b.st[1] = nx; }
        const unsigned old = xb_add(&bar[XB_XSUB(b.x)], 1u);
        const unsigned gen = old / nloc;
        if (old + 1u == (gen + 1u) * nloc) {
            __builtin_amdgcn_fence(__ATOMIC_RELEASE, "agent");
            asm volatile("s_waitcnt vmcnt(0)" ::: "memory");
            const unsigned og = xb_add(&bar[XB_TOP], 1u);
            const unsigned tg = og / nx;
            if (og + 1u == (tg + 1u) * nx) xb_add(&bar[XB_TOPGEN], 1u);
            else XB_SPIN(xb_ld(&bar[XB_TOPGEN]) == tg, bar);
            __builtin_amdgcn_fence(__ATOMIC_ACQUIRE, "agent");
            xb_add(&bar[XB_XGEN(b.x)], 1u);
            asm volatile("s_waitcnt vmcnt(0)" ::: "memory");
        } else {
            XB_SPIN(xb_ld(&bar[XB_XGEN(b.x)]) == gen, bar);
            __builtin_amdgcn_fence(__ATOMIC_ACQUIRE, "agent");
            asm volatile("s_waitcnt vmcnt(0)" ::: "memory");
        }
    }
    __syncthreads();
}

__device__ __forceinline__ void merge_rows8(const Args& a, int layer, int lane, int row0) {
    const bf16* qo = (const bf16*)(a.ws + WS_O); const bf16* so = (const bf16*)(a.ws + WS_SSMO); bf16* xn = (bf16*)(a.ws + WS_XN);
    const float* gn = a.in[20] + layer * 1024;
    v4u w[8][2];
#pragma unroll
    for (int r = 0; r < 8; ++r) { w[r][0] = *(const v4u*)(qo + (size_t)(row0 + r) * 512 + 8 * lane); w[r][1] = *(const v4u*)(so + (size_t)(row0 + r) * 512 + 8 * lane); }
    float g[2][8];
#pragma unroll
    for (int h = 0; h < 2; ++h)
#pragma unroll
        for (int k = 0; k < 8; ++k) g[h][k] = gn[h * 512 + 8 * lane + k];
#pragma unroll
    for (int r = 0; r < 8; ++r)
#pragma unroll
        for (int h = 0; h < 2; ++h) { const v4u ww = w[r][h];
            const float v[8] = {bflo(ww.x), bfhi(ww.x), bflo(ww.y), bfhi(ww.y), bflo(ww.z), bfhi(ww.z), bflo(ww.w), bfhi(ww.w)};
            float s = 0.f;
#pragma unroll
            for (int k = 0; k < 8; ++k) s += v[k] * v[k];
            const float rstd = __builtin_amdgcn_rsqf(wave_sum(s) * (1.f / 512.f) + 1e-6f);
            v4u o; o.x = pk2(v[0] * rstd * g[h][0], v[1] * rstd * g[h][1]); o.y = pk2(v[2] * rstd * g[h][2], v[3] * rstd * g[h][3]);
            o.z = pk2(v[4] * rstd * g[h][4], v[5] * rstd * g[h][5]); o.w = pk2(v[6] * rstd * g[h][6], v[7] * rstd * g[h][7]);
            *(v4u*)(xn + (size_t)(row0 + r) * 1024 + h * 512 + 8 * lane) = o; }
}
__device__ __forceinline__ void publish(unsigned* word) {
    asm volatile("s_waitcnt vmcnt(0)" ::: "memory"); __syncthreads();
    if (otid() == 0) { __builtin_amdgcn_fence(__ATOMIC_RELEASE, "agent"); asm volatile("s_waitcnt vmcnt(0)" ::: "memory"); __hip_atomic_fetch_add(word, 1u, __ATOMIC_RELAXED, __HIP_MEMORY_SCOPE_AGENT); }
}
__device__ __forceinline__ void publish_wt(unsigned* word) {
    asm volatile("s_waitcnt vmcnt(0)" ::: "memory"); __syncthreads();
    if (otid() == 0) __hip_atomic_fetch_add(word, 1u, __ATOMIC_RELAXED, __HIP_MEMORY_SCOPE_AGENT);
}
__device__ __forceinline__ void await(unsigned* word, unsigned target) {
    if (otid() == 0) { unsigned sp = 0; while (__hip_atomic_load(word, __ATOMIC_RELAXED, __HIP_MEMORY_SCOPE_AGENT) < target) { __builtin_amdgcn_s_sleep(80); if (++sp > (1u << 22)) break; }
        __builtin_amdgcn_fence(__ATOMIC_ACQUIRE, "agent"); asm volatile("s_waitcnt vmcnt(0)" ::: "memory"); }
    __syncthreads();
}
__device__ __forceinline__ void mix_phase(const Args& a, unsigned char* lds, int layer, bool ctx_out, int tid, int lane, int wave) {
    unsigned* ctr = (unsigned*)(a.ws + WS_CTL) + 8192 + (size_t)layer * 512;
    volatile LAS unsigned* qs = (volatile LAS unsigned*)((LAS unsigned char*)lds + QS_OFF);
    const int L3 = layer & 3, nmt = ctx_out ? 68 : 64; const int NCMB = L3 > 0 ? 64 : 0, NDN = L3 > 0 ? 528 : 0; const int NIN = 340;
    const int nattn = 640 + (ctx_out ? 32 : 0), i_glu = nattn, i_mrg = i_glu + 2 * nmt, nitems = i_mrg + 8 * nmt;
    const attn_body::bf16* qo = (const attn_body::bf16*)(a.ws + WS_QO); const attn_body::bf16* kall = (const attn_body::bf16*)(a.ws + WS_KALL); const attn_body::bf16* vall = (const attn_body::bf16*)(a.ws + WS_VALL);
    for (;;) {
        __syncthreads();
        if (otid() == 0) qs[0] = atomicAdd(ctr, 1u);
        __syncthreads();
        const int itq = __builtin_amdgcn_readfirstlane((int)qs[0]);
        if (itq >= NCMB + nitems + NIN + NDN) break;
        if (itq < NCMB) {
            const int t2 = otid(), w2 = __builtin_amdgcn_readfirstlane(t2 >> 6);
            for (int k = 0; k < 2; ++k) combine_row(a, L3, itq * 16 + w2 * 2 + k, t2 & 63);
            publish(ctr + 452); continue; }
        if (itq >= NCMB + nitems + NIN) {
            const int t2 = otid(), w2 = __builtin_amdgcn_readfirstlane(t2 >> 6), j = itq - (NCMB + nitems + NIN);
            transposes_range(a, (LAS unsigned char*)lds, L3, 1280 + j * 8, 1280 + j * 8 + 8, w2, 8, t2 & 63, w2); __syncthreads(); continue; }
        const int it0 = itq - NCMB;
        if (it0 < NIN) { const int b = it0 / 85, r = it0 % 85, t = r / 5, pn = r % 5, pm = t < 16 ? 16 * b + t : 64 + b;
            pg8::Gemm g{(const bf16*)(a.ws + WS_XN), (const bf16*)(a.ws + WS_WIN), NTOK, INC, 1024, 1024}; pg8::OneUnit S{pm, pn};
            pg8::EpiIn E{(bf16*)(a.ws + WS_QO), (bf16*)(a.ws + WS_KALL), (bf16*)(a.ws + WS_VALL), (bf16*)(a.ws + WS_PROJ), a.in[8] + L3 * 64, a.in[9] + L3 * 64, (const float*)(a.ws + WS_ROPE),
                          (const float*)(a.ws + WS_SSQ1), (const float*)(a.ws + WS_BIASIN) + (size_t)L3 * 5 * 1280};
            if (NCMB && t == 16) await(ctr + 452, 64u);
            pg8::gemm_phase<pg8::EpiIn, pg8::OneUnit, true, true>((LAS unsigned char*)lds, g, S, E); publish(ctr + 448 + b); continue; }
        const int it = it0 - NIN;
        if (it < 128) { await(ctr + 448 + (it >> 5), 85u); ssm_unit(a, (LAS unsigned char*)lds, L3, it >> 5, it & 31); publish(ctr + 64); }
        else if (it < 640) { const int r = it - 128, hq = r & 3, qb = (r >> 2) & 15, bk = r >> 6, b = bk >> 1, h = (bk & 1) * 4 + hq;
            await(ctr + 448 + b, 85u);
            attn_body::attn_unit<8>((long)b * 4096 + qb * 256, (long)b * 4352, h, 68, qo, kall, vall, (attn_body::bf16*)(a.ws + WS_O), (char*)lds); publish_wt(ctr + 128 + b * 16 + qb); }
        else if (it < nattn) { const int r = it - 640, b = r >> 3, h = r & 7;
            await(ctr + 448 + b, 85u);
            attn_body::attn_unit<8>((long)NLAT + b * 256, (long)b * 4352, h, 4, qo, kall, vall, (attn_body::bf16*)(a.ws + WS_O), (char*)lds); publish_wt(ctr + 128 + 64 + b); }
        else if (it < i_mrg) {
            const int r = it - i_glu; await(ctr + 64, 128u);
            pg8::Gemm g{(const bf16*)(a.ws + WS_Z), (const bf16*)(a.ws + WS_WGLU), NTOK, 512, 512, 512}; pg8::OneUnit S{r >> 1, r & 1};
            pg8::EpiGlu E{(const bf16*)(a.ws + WS_Z), (bf16*)(a.ws + WS_SSMO), a.in[19] + L3 * 512};
            pg8::gemm_phase<pg8::EpiGlu, pg8::OneUnit, true, true>((LAS unsigned char*)lds, g, S, E); publish(ctr + 128 + (r >> 1));
        }
        else {
            int r = it - i_mrg, pm0, npm;
            if (r < 32 * 8) { pm0 = 0; npm = 32; } else { r -= 32 * 8; pm0 = 32; npm = nmt - 32; }
            if (r < 4 * npm) { const int pm = pm0 + (r >> 2); await(ctr + 128 + pm, 10u);
                { const int t2 = otid(); merge_rows8(a, L3, t2 & 63, pm * 256 + (r & 3) * 64 + __builtin_amdgcn_readfirstlane(t2 >> 6) * 8); }
                publish(ctr + 256 + pm); }
            else { r -= 4 * npm; const int pm = pm0 + (r >> 2), pn = r & 3; await(ctr + 256 + pm, 4u);
                pg8::Gemm g{(const bf16*)(a.ws + WS_XN), (const bf16*)(a.ws + WS_WOUT), NTOK, 1024, 1024, 1024}; pg8::OneUnit S{pm, pn};
                pg8::EpiRes E{a.out, (float*)(a.ws + WS_XC), (const float*)(a.ws + WS_MOD) + (size_t)L3 * 5 * 6144 + 2048, (bf16*)(a.ws + WS_XT2), (const float*)(a.ws + WS_CS) + (size_t)(L3 * 2 + 1) * 5 * 1024, (float*)(a.ws + WS_SSQ2)};
                pg8::gemm_phase<pg8::EpiRes, pg8::OneUnit, true, true>((LAS unsigned char*)lds, g, S, E); }
        }
    }
}

typedef const __attribute__((address_space(4))) Args* KArgsP;
__device__ __forceinline__ KArgsP launder(KArgsP p) { asm volatile("" : "+s"(p)); return p; }
__global__ void __launch_bounds__(512, 2) mk_fwd(Args a_unused) {
    unsigned char* const lds = lds_dyn;
    const KArgsP ap0 = (KArgsP)__builtin_amdgcn_kernarg_segment_ptr();
    LAS unsigned char* L = (LAS unsigned char*)lds;
    const int ph_lo = launder(ap0)->ph_lo, ph_hi = launder(ap0)->ph_hi;
    { if ((threadIdx.x & 63) == 0) ((volatile LAS int*)((LAS unsigned char*)lds + WTAB_OFF))[hw_slot()] = (int)(threadIdx.x >> 6);
      __syncthreads(); }
    { volatile LAS unsigned* st = (volatile LAS unsigned*)((LAS unsigned char*)lds + QS_OFF + 64);
      if (otid() < 2) st[otid()] = 0u;
      __syncthreads();
      (void)xcd_barrier_post((unsigned*)(launder(ap0)->ws + WS_CTL) + 4096, st); }
#define XBAR() do { XcdBarrier xb_; xb_.bar = (unsigned*)(launder(ap0)->ws + WS_CTL) + 4096; xb_.x = xb_xcc_id(); xb_.st = (volatile LAS unsigned*)((LAS unsigned char*)lds + QS_OFF + 64); xcd_barrier(xb_); } while (0)
    if (ph_lo == 0) {
#if defined(__HIP_DEVICE_COMPILE__)
        const Args a = *launder(ap0);
#else
        const Args a = a_unused;
#endif
        if (PHON(13)) p0_phase(a, L, otid());
        if (ph_hi < 0) { __syncthreads(); cg::this_grid().sync(); }
        XBAR();
        if (PHON(13)) p1_phase(a, L, otid());
        { const int tid = otid(); prep_phase(a, L, 0, tid, tid & 63, __builtin_amdgcn_readfirstlane(tid >> 6)); }
        XBAR();
    }
    for (int ph = (ph_lo < 3 ? 3 : ph_lo); ph < ph_hi; ++ph) {
      const int nrep_ = 1;
      for (int rep = 0; rep < nrep_; ++rep) {
#if defined(__HIP_DEVICE_COMPILE__)
        const Args& a = *(const Args*)launder(ap0);
#else
        const Args& a = a_unused;
#endif
        const int G = ogrid(), c = obid();
        bf16* xn = (bf16*)(a.ws + WS_XN); float* xc = (float*)(a.ws + WS_XC);
        {
            const int l = (ph - 3) / NSTAGE, s = (ph - 3) % NSTAGE; const bool last = (l == DEPTH - 1); const int nrows = last ? NLAT : NTOK;
            const float* mod = (const float*)(a.ws + WS_MOD) + (size_t)l * 5 * 6144; const float* cs = (const float*)(a.ws + WS_CS);
            bf16* xt2 = (bf16*)(a.ws + WS_XT2); float* ssq1 = (float*)(a.ws + WS_SSQ1); float* ssq2 = (float*)(a.ws + WS_SSQ2);
            if (s == 0) { if (PHON(1)) { const int tid = otid(); mix_phase(a, lds, l + 4 * rep, !last, tid, tid & 63, __builtin_amdgcn_readfirstlane(tid >> 6)); } }
            else if (s == 1) { if (PHON(2)) { pg8::Gemm g{xt2, (const bf16*)(a.ws + WS_WUP), nrows, DFF2, 1024, 1024}; pg8::StaticOrder S; S.init(nrows, DFF2, G, c);
                pg8::EpiConv E{(bf16*)(a.ws + WS_HFFN), a.in[24] + (size_t)l * 3 * DFF2, a.in[25] + (size_t)l * DFF2, (float*)(a.ws + WS_SIDE), (LAS float*)(L + 131072),
                               ssq2, (const float*)(a.ws + WS_BIASUP) + (size_t)l * 5 * 5632, (LAS float*)(L + 136192)};
                pg8::gemm_phase<pg8::EpiConv, pg8::StaticOrder, true, true>(L, g, S, E);
                if (!last) { const int t2 = otid(), w2 = __builtin_amdgcn_readfirstlane(t2 >> 6); transposes_range(a, L, l + 1, 0, 1280, c * 8 + w2, G * 8, t2 & 63, w2); } } }
            else if (PHON(3)) { pg8::Gemm g{(const bf16*)(a.ws + WS_HFFN), (const bf16*)(a.ws + WS_WDN), NLAT, 1024, DFF, DFF}; pg8::StaticOrder S; S.init(NLAT, 1024, G, c);
                if (G == 256) { pg8::Unit u0; if (S.next(0, u0)) fix_tile(a, l, u0.pm, otid()); } else { fix_phase(a, l, otid()); XBAR(); }
                pg8::EpiRes E{a.out, xc, mod + 5120, last ? (bf16*)nullptr : xn, cs + (size_t)((l + 1) * 2) * 5 * 1024, ssq1}; pg8::gemm_phase<pg8::EpiRes, pg8::StaticOrder, true, true>(L, g, S, E);
                if (!last) { pg8::Gemm g2{(const bf16*)(a.ws + WS_HFFN) + (size_t)NLAT * DFF, (const bf16*)(a.ws + WS_WDN), 1024, 1024, 256, DFF}; pg8::SliceOrder S2{G, c};
                    pg8::EpiPart E2{(float*)(a.ws + WS_PART)}; pg8::gemm_phase<pg8::EpiPart, pg8::SliceOrder, true, true>(L, g2, S2, E2); } }
        }
        if (ph + 1 < ph_hi || rep + 1 < nrep_) { XBAR(); for (int q_ = 0; q_ < REP_SYNC; ++q_) XBAR(); }
      }
    }
}

#ifndef MK_MULTI
#define MK_MULTI 0
#endif
extern "C" void kernel_launch(void* const* d_in, const int* in_sizes, int n_in, void* d_out, int out_size, void* d_ws, size_t ws_size, hipStream_t stream) {
    static int grid = 0;
    if (grid == 0) {
        if (n_in != 27 || ws_size < WS_END) { fprintf(stderr, "kernel_launch: bad shapes/workspace (n_in %d ws %zu need %zu)\n", n_in, ws_size, (size_t)WS_END); grid = -1; return; }
        int dev = 0, cus = 0, per_cu = 0;
        hipGetDevice(&dev); hipDeviceGetAttribute(&cus, hipDeviceAttributeMultiprocessorCount, dev);
        if (hipFuncSetAttribute((const void*)mk_fwd, hipFuncAttributeMaxDynamicSharedMemorySize, LDS_BYTES) != hipSuccess) { fprintf(stderr, "kernel_launch: hipFuncSetAttribute failed\n"); grid = -1; return; }
        if (hipOccupancyMaxActiveBlocksPerMultiprocessor(&per_cu, (const void*)mk_fwd, 512, LDS_BYTES) != hipSuccess || per_cu < 1) { fprintf(stderr, "kernel_launch: occupancy query says %d\n", per_cu); per_cu = 1; }
        (void)hipGetLastError();
        grid = cus * (per_cu > 1 ? 1 : per_cu);
        if (grid < 1) grid = 256;
    }
    if (grid < 0) return;
    (void)hipMemsetAsync((char*)d_ws + WS_CTL, 0, 65536, stream);
    Args a{};
    for (int i = 0; i < 27; ++i) a.in[i] = (const float*)d_in[i];
    a.out = (float*)d_out; a.ws = (unsigned char*)d_ws;
#if MK_MULTI
    for (int ph = 0; ph < NPHASE; ++ph) { a.ph_lo = ph; a.ph_hi = ph + 1; a.coop = 0; hipLaunchKernelGGL(mk_fwd, dim3(grid), dim3(512), LDS_BYTES, stream, a); }
#else
    a.ph_lo = 0; a.ph_hi = NPHASE; a.coop = 1;
    void* args[] = {&a};
    hipError_t e = hipLaunchCooperativeKernel((const void*)mk_fwd, dim3(grid), dim3(512), args, LDS_BYTES, stream);
    if (e != hipSuccess) fprintf(stderr, "cooperative launch failed: %s (grid %d)\n", hipGetErrorString(e), grid);
#endif
}
```

```cpp
#include <hip/hip_runtime.h>
#include <hip/hip_cooperative_groups.h>
#include <hip/hip_bf16.h>
#include <cstdio>
#include <cstdint>
#include <cmath>
namespace cg = cooperative_groups;
__device__ __forceinline__ int olane() { unsigned z = 0u; asm volatile("" : "+v"(z)); return (int)__builtin_amdgcn_mbcnt_hi(~0u, __builtin_amdgcn_mbcnt_lo(~0u, z)); }
extern __shared__ __attribute__((aligned(16))) unsigned char lds_dyn[];
constexpr int WTAB_OFF = 135168 + 256;
__device__ __forceinline__ int hw_slot() { return (int)__builtin_amdgcn_s_getreg((5 << 11) | (0 << 6) | 4); }
__device__ __forceinline__ int otid() {
    const int w = __builtin_amdgcn_readfirstlane(((volatile __attribute__((address_space(3))) int*)((__attribute__((address_space(3))) unsigned char*)lds_dyn + WTAB_OFF))[hw_slot()]);
    int t = w * 64 + olane(); asm volatile("" : "+v"(t)); return t;
}
template <int M> __device__ __forceinline__ float shx(float v) {
    if constexpr (M == 32) { auto rr = __builtin_amdgcn_permlane32_swap(__builtin_bit_cast(unsigned, v), __builtin_bit_cast(unsigned, v), false, false);
        const bool hi = (olane() & 32) != 0; return __builtin_bit_cast(float, hi ? rr[0] : rr[1]); }
    else return __builtin_bit_cast(float, __builtin_amdgcn_ds_swizzle(__builtin_bit_cast(int, v), (M << 10) | 0x1f));
}
__device__ __forceinline__ int obid() { int t = blockIdx.x; asm volatile("" : "+s"(t)); return t; }
__device__ __forceinline__ int ogrid() { int t = gridDim.x; asm volatile("" : "+s"(t)); return t; }
namespace pg8 {
#define PG8_LAS __attribute__((address_space(3)))
typedef unsigned short bf16_t;
typedef short bf16x8 __attribute__((ext_vector_type(8)));
typedef float f32x4 __attribute__((ext_vector_type(4)));
typedef unsigned u32x4 __attribute__((ext_vector_type(4)));
typedef unsigned u32x2 __attribute__((ext_vector_type(2)));
constexpr int BM = 256, BK = 64, HALF = 128, HTB = HALF * BK * 2  , STAGE_BYTES = 8 * HTB, NXCD = 8, WGM = 8;

__host__ __device__ __forceinline__ int lds_byte(int r, int c) { const int st = (r >> 4) * 2 + (c >> 5), rr = r & 15, cc = c & 31, ob = rr * 64 + cc * 2; return st * 1024 + (ob ^ (((ob >> 9) & 1) << 5)); }
__host__ __device__ __forceinline__ void stage_rc(int b, int& R, int& C) { const int st = b / 1024, sb = b % 1024, swz = sb ^ (((sb >> 9) & 1) << 5); R = (st >> 1) * 16 + swz / 64; C = (st & 1) * 32 + (swz % 64) / 2; }
__host__ __device__ __forceinline__ int perm32(int rho) { const int n = rho >> 4, i = rho & 15; return 8 * (i >> 2) + 4 * n + (i & 3); }

struct Unit { int pm, pn, kofs, ks; };
struct Gemm { const bf16_t* A; const bf16_t* Bt; int M, N, K, ld; };

struct StaticOrder {
    int nM, nN, nwg, G, c;
    __host__ __device__ void init(int M, int N, int G_, int c_) { nM = M / BM; nN = N / BM; nwg = nM * nN; G = G_; c = c_; }
    __host__ __device__ bool next(int i, Unit& u) const {
        const long L = (long)i * G + c; if (L >= nwg) return false;
        int wgid = (int)L; { const int q = nwg / NXCD, r = nwg % NXCD, xcd = wgid % NXCD, off = wgid / NXCD; wgid = (xcd < r ? xcd * (q + 1) : r * (q + 1) + (xcd - r) * q) + off; }
        const int nig = WGM * nN, gid = wgid / nig, fm = gid * WGM, gsz = (nM - fm) < WGM ? (nM - fm) : WGM;
        u.pm = fm + ((wgid % nig) % gsz); u.pn = (wgid % nig) / gsz; u.kofs = 0; u.ks = i & 1; return true;
    }
    __device__ __forceinline__ void a_ready(const Unit&) const {}
    __device__ __forceinline__ void done(const Unit&) const {}
};

__device__ __forceinline__ unsigned cvt_pk_bf16(float lo, float hi) { unsigned r; asm volatile("v_cvt_pk_bf16_f32 %0, %1, %2" : "=v"(r) : "v"(lo), "v"(hi)); return r; }
typedef float f32x2 __attribute__((ext_vector_type(2)));
struct EpiStore { static constexpr bool ROWPERM = false; static constexpr bool PREROWS = false;
    static constexpr bool PERM = true, AFTER_DRAIN = false;
    bf16_t* O; int ldc;
    __device__ __forceinline__ void operator()(const f32x4 (&acc)[2][2][4][2], const Unit& u, int wr, int wc, int fr, int fq) const {
        const int row0 = u.pm * BM + wr * 64 + fr; const int col0 = u.pn * BM + wc * 32 + 8 * fq;
#pragma unroll
        for (int ai = 0; ai < 2; ++ai)
#pragma unroll
            for (int m = 0; m < 4; ++m) { bf16_t* rowp = O + (size_t)(row0 + ai * HALF + m * 16) * ldc + col0;
#pragma unroll
                for (int bj = 0; bj < 2; ++bj) { const f32x4 v0 = acc[ai][bj][m][0], v1 = acc[ai][bj][m][1];
                    u32x4 w; w.x = cvt_pk_bf16(v0[0], v0[1]); w.y = cvt_pk_bf16(v0[2], v0[3]); w.z = cvt_pk_bf16(v1[0], v1[1]); w.w = cvt_pk_bf16(v1[2], v1[3]);
                    *(u32x4*)(rowp + bj * HALF) = w; } }
    }
};
__device__ __forceinline__ float bf_lo(unsigned w) { return __uint_as_float(w << 16); }
__device__ __forceinline__ float bf_hi(unsigned w) { return __uint_as_float(w & 0xffff0000u); }
__device__ __forceinline__ float sigm(float x) { return __builtin_amdgcn_rcpf(1.0f + __builtin_amdgcn_exp2f(-1.4426950408889634f * x)); }
struct EpiGlu { static constexpr bool ROWPERM = false; static constexpr bool PREROWS = false;
    static constexpr bool PERM = true, AFTER_DRAIN = false;
    const bf16_t* Z; bf16_t* O; const float* bias;
    __device__ __forceinline__ void operator()(const f32x4 (&acc)[2][2][4][2], const Unit& u, int wr, int wc, int fr, int fq) const {
        const int row0 = u.pm * BM + wr * 64 + fr; const int col0 = u.pn * BM + wc * 32 + 8 * fq;
        f32x4 bv[2][2];
#pragma unroll
        for (int bj = 0; bj < 2; ++bj)
#pragma unroll
            for (int n = 0; n < 2; ++n) bv[bj][n] = *(const f32x4*)(bias + col0 + bj * HALF + 4 * n);
#pragma unroll
        for (int ai = 0; ai < 2; ++ai) {
            u32x4 zv[4][2];
#pragma unroll
            for (int m = 0; m < 4; ++m)
#pragma unroll
                for (int bj = 0; bj < 2; ++bj) zv[m][bj] = *(const u32x4*)(Z + (size_t)(row0 + ai * HALF + m * 16) * 512 + col0 + bj * HALF);
            asm volatile("" ::: "memory");
#pragma unroll
            for (int m = 0; m < 4; ++m) { const size_t off = (size_t)(row0 + ai * HALF + m * 16) * 512 + col0;
#pragma unroll
                for (int bj = 0; bj < 2; ++bj) { const u32x4 zz = zv[m][bj];
                    const f32x4 v0 = acc[ai][bj][m][0] + bv[bj][0], v1 = acc[ai][bj][m][1] + bv[bj][1];
                    u32x4 w;
                    w.x = cvt_pk_bf16(bf_lo(zz.x) * sigm(v0[0]), bf_hi(zz.x) * sigm(v0[1])); w.y = cvt_pk_bf16(bf_lo(zz.y) * sigm(v0[2]), bf_hi(zz.y) * sigm(v0[3]));
                    w.z = cvt_pk_bf16(bf_lo(zz.z) * sigm(v1[0]), bf_hi(zz.z) * sigm(v1[1])); w.w = cvt_pk_bf16(bf_lo(zz.w) * sigm(v1[2]), bf_hi(zz.w) * sigm(v1[3]));
                    *(u32x4*)(O + off + bj * HALF) = w; } }
            asm volatile("" ::: "memory"); }
    }
};
struct EpiRes { static constexpr bool ROWPERM = false; static constexpr bool PREROWS = false;
    static constexpr bool PERM = true, AFTER_DRAIN = false;
    float* xlat; float* xctx; const float* gate; bf16_t* xt; const float* cscale; float* ssq;
    __device__ __forceinline__ void operator()(const f32x4 (&acc)[2][2][4][2], const Unit& u, int wr, int wc, int fr, int fq) const {
        const int rowt = u.pm * BM;
        float* xb = rowt < 16384 ? xlat + (size_t)rowt * 1024 : xctx + (size_t)(rowt - 16384) * 1024;
        const int v = rowt < 16384 ? (rowt >> 12) : 4;
        const int col0 = u.pn * BM + wc * 32 + 8 * fq;
        f32x4 gv[2][2], cv[2][2];
#pragma unroll
        for (int bj = 0; bj < 2; ++bj)
#pragma unroll
            for (int n = 0; n < 2; ++n) { gv[bj][n] = *(const f32x4*)(gate + v * 6144 + col0 + bj * HALF + n * 4); cv[bj][n] = xt ? *(const f32x4*)(cscale + v * 1024 + col0 + bj * HALF + n * 4) : (f32x4){0.f, 0.f, 0.f, 0.f}; }
#pragma unroll
        for (int hb = 0; hb < 4; ++hb) { const int ai = hb >> 1, m0 = (hb & 1) * 2;
            f32x4 xv[2][2][2];
#pragma unroll
            for (int mm = 0; mm < 2; ++mm)
#pragma unroll
                for (int bj = 0; bj < 2; ++bj)
#pragma unroll
                    for (int n = 0; n < 2; ++n) xv[mm][bj][n] = *(const f32x4*)(xb + (size_t)(ai * HALF + wr * 64 + (m0 + mm) * 16 + fr) * 1024 + col0 + bj * HALF + n * 4);
            asm volatile("" ::: "memory");
#pragma unroll
            for (int mm = 0; mm < 2; ++mm) { const int m = m0 + mm; const int rl = ai * HALF + wr * 64 + m * 16 + fr; float* rp = xb + (size_t)rl * 1024 + col0; float ss = 0.f;
#pragma unroll
                for (int bj = 0; bj < 2; ++bj)
#pragma unroll
                    for (int n = 0; n < 2; ++n) { f32x4 x = xv[mm][bj][n] + gv[bj][n] * acc[ai][bj][m][n]; *(f32x4*)(rp + bj * HALF + n * 4) = x;
                        if (xt) { ss += (x[0] * x[0] + x[1] * x[1]) + (x[2] * x[2] + x[3] * x[3]); const f32x4 y = x * cv[bj][n];
                            u32x2 w; w.x = cvt_pk_bf16(y[0], y[1]); w.y = cvt_pk_bf16(y[2], y[3]); *(u32x2*)(xt + (size_t)(rowt + rl) * 1024 + col0 + bj * HALF + n * 4) = w; } }
                if (xt) { ss += shx<16>(ss); ss += shx<32>(ss); if (fq == 0) ssq[(size_t)(rowt + rl) * 16 + u.pn * 4 + wc] = ss; } }
            asm volatile("" ::: "memory"); }
    }
};
__device__ __forceinline__ float row_rstd(const float* ssq, int row, int fq) {
    const f32x4 a = ((const f32x4*)(ssq + (size_t)row * 16))[fq];
    float s = (a[0] + a[1]) + (a[2] + a[3]); s += shx<16>(s); s += shx<32>(s);
    return __builtin_amdgcn_rsqf(s * (1.f / 1024.f) + 1e-6f);
}
__device__ __forceinline__ float dpp_shr1(float v) { return __builtin_bit_cast(float, __builtin_amdgcn_update_dpp(0, __builtin_bit_cast(int, v), 0x111, 0xf, 0xf, true)); }
__device__ __forceinline__ float dpp_shl1(float v) { return __builtin_bit_cast(float, __builtin_amdgcn_update_dpp(0, __builtin_bit_cast(int, v), 0x101, 0xf, 0xf, true)); }
__device__ __forceinline__ float silu_e(float x) { return x * __builtin_amdgcn_rcpf(1.0f + __builtin_amdgcn_exp2f(-1.4426950408889634f * x)); }
struct EpiConv { static constexpr bool ROWPERM = true; static constexpr bool PREROWS = true;
    static constexpr bool PERM = true, AFTER_DRAIN = false;
    bf16_t* H; const float* cw; const float* cb; float* side; PG8_LAS float* xl; const float* ssq; const float* bias; PG8_LAS float* rt;
    __device__ __forceinline__ void prerows(const Unit& u) const {
        const int t = otid();
        if (t < 256) { const f32x4* p = (const f32x4*)(ssq + (size_t)(u.pm * BM + t) * 16); const f32x4 a = p[0], b = p[1], c = p[2], d = p[3];
            const float sum = ((a[0] + a[1]) + (a[2] + a[3])) + ((b[0] + b[1]) + (b[2] + b[3])) + ((c[0] + c[1]) + (c[2] + c[3])) + ((d[0] + d[1]) + (d[2] + d[3]));
            rt[t] = __builtin_amdgcn_rsqf(sum * (1.f / 1024.f) + 1e-6f);
            const int v = (u.pm * BM) < 16384 ? ((u.pm * BM) >> 12) : 4;
            rt[256 + t] = bias[v * 5632 + (t >> 7) * 2816 + 128 * u.pn + (t & 127)]; }
        PG8_LAS float* wt = rt + 512 + (u.ks & 1) * 1024;
        for (int idx = t; idx < 1024; idx += 512) { const int k = idx >> 7, c = 128 * u.pn + (idx & 127);
            wt[idx] = k < 3 ? cw[k * 5632 + c] : (k == 3 ? cb[c] : (k < 7 ? cw[(k - 4) * 5632 + 2816 + c] : cb[2816 + c])); }
    }
    __device__ __forceinline__ void operator()(f32x4 (&acc)[2][2][4][2], const Unit& u, int wr, int wc, int fr, int fq) const {
        { const int rowt = u.pm * BM; const int v = rowt < 16384 ? (rowt >> 12) : 4; const int cc = 128 * u.pn + 32 * wc + 8 * fq;
          f32x4 bv[2][2];
#pragma unroll
          for (int bj = 0; bj < 2; ++bj)
#pragma unroll
              for (int n = 0; n < 2; ++n) bv[bj][n] = *(const PG8_LAS f32x4*)(rt + 256 + bj * 128 + 32 * wc + 8 * fq + 4 * n);
#pragma unroll
          for (int ai = 0; ai < 2; ++ai)
#pragma unroll
              for (int m = 0; m < 4; ++m) { const float rs = rt[128 * wr + 8 * fr + 4 * ai + m];
#pragma unroll
                  for (int bj = 0; bj < 2; ++bj)
#pragma unroll
                      for (int n = 0; n < 2; ++n) acc[ai][bj][m][n] = acc[ai][bj][m][n] * rs + bv[bj][n]; } }
        const int xb = ((wr * 4 + wc) * 4 + fq) * 16;
        if (fr == 0) {
#pragma unroll
            for (int bj = 0; bj < 2; ++bj)
#pragma unroll
                for (int n = 0; n < 2; ++n) *(PG8_LAS f32x4*)(xl + xb + bj * 8 + n * 4) = acc[0][bj][0][n]; }
        if (fr == 15) {
#pragma unroll
            for (int bj = 0; bj < 2; ++bj)
#pragma unroll
                for (int n = 0; n < 2; ++n) *(PG8_LAS f32x4*)(xl + 512 + xb + bj * 8 + n * 4) = acc[1][bj][3][n]; }
        asm volatile("s_waitcnt lgkmcnt(0)" ::: "memory"); __builtin_amdgcn_s_barrier(); asm volatile("" ::: "memory");
        const int ch0 = 128 * u.pn + 32 * wc + 8 * fq;
        const size_t t0 = (size_t)u.pm * BM + 128 * wr + 8 * fr;
        const bool sfirst = (fr == 0 && wr == 0), slast = (fr == 15 && wr == 1);
        float* sd = side + (size_t)u.pm * 4 * 5632;
#pragma unroll
        for (int n = 0; n < 2; ++n) {
            f32x4 prv[2], nxt[2];
#pragma unroll
            for (int bj = 0; bj < 2; ++bj) {
#pragma unroll
                for (int j = 0; j < 4; ++j) { prv[bj][j] = dpp_shr1(acc[1][bj][3][n][j]); nxt[bj][j] = dpp_shl1(acc[0][bj][0][n][j]); }
                if (fr == 0 && wr == 1) prv[bj] = *(const PG8_LAS f32x4*)(xl + 512 + ((0 * 4 + wc) * 4 + fq) * 16 + bj * 8 + n * 4);
                if (fr == 15 && wr == 0) nxt[bj] = *(const PG8_LAS f32x4*)(xl + ((1 * 4 + wc) * 4 + fq) * 16 + bj * 8 + n * 4); }
            const int c = ch0 + 4 * n;
            const PG8_LAS float* wt = rt + 512 + (u.ks & 1) * 1024 + 32 * wc + 8 * fq + 4 * n;
            const f32x4 w0a = *(const PG8_LAS f32x4*)(wt), w1a = *(const PG8_LAS f32x4*)(wt + 128), w2a = *(const PG8_LAS f32x4*)(wt + 256), ba = *(const PG8_LAS f32x4*)(wt + 384);
            const f32x4 w0g = *(const PG8_LAS f32x4*)(wt + 512), w1g = *(const PG8_LAS f32x4*)(wt + 640), w2g = *(const PG8_LAS f32x4*)(wt + 768), bg = *(const PG8_LAS f32x4*)(wt + 896);
#pragma unroll
            for (int k = 0; k < 8; ++k) {
                const f32x4 ap = k == 0 ? prv[0] : acc[(k - 1) >> 2][0][(k - 1) & 3][n], ac = acc[k >> 2][0][k & 3][n], an = k == 7 ? nxt[0] : acc[(k + 1) >> 2][0][(k + 1) & 3][n];
                const f32x4 gp = k == 0 ? prv[1] : acc[(k - 1) >> 2][1][(k - 1) & 3][n], gc = acc[k >> 2][1][k & 3][n], gn = k == 7 ? nxt[1] : acc[(k + 1) >> 2][1][(k + 1) & 3][n];
                const f32x4 oa = w0a * ap + w1a * ac + w2a * an + ba, og = w0g * gp + w1g * gc + w2g * gn + bg;
                u32x2 w; w.x = cvt_pk_bf16(silu_e(og[0]) * oa[0], silu_e(og[1]) * oa[1]); w.y = cvt_pk_bf16(silu_e(og[2]) * oa[2], silu_e(og[3]) * oa[3]);
                *(u32x2*)(H + (t0 + k) * 2816 + c) = w;
                if (k == 0 && sfirst) { *(f32x4*)(sd + 0 * 5632 + c) = ac; *(f32x4*)(sd + 0 * 5632 + 2816 + c) = gc; *(f32x4*)(sd + 1 * 5632 + c) = oa; *(f32x4*)(sd + 1 * 5632 + 2816 + c) = og; }
                if (k == 7 && slast) { *(f32x4*)(sd + 2 * 5632 + c) = ac; *(f32x4*)(sd + 2 * 5632 + 2816 + c) = gc; *(f32x4*)(sd + 3 * 5632 + c) = oa; *(f32x4*)(sd + 3 * 5632 + 2816 + c) = og; }
            }
        }
    }
};
struct EpiIn { static constexpr bool ROWPERM = false; static constexpr bool PREROWS = true;
    static constexpr bool PERM = false, AFTER_DRAIN = false;
    bf16_t* QO; bf16_t* KA; bf16_t* VA; bf16_t* UB; const float* qg; const float* kg; const float* rt; const float* ssq; const float* bias; PG8_LAS float* lt;
    __device__ __forceinline__ void prerows(const Unit& u) const {
        const int t = otid();
        if (t < 256) { const f32x4* p = (const f32x4*)(ssq + (size_t)(u.pm * BM + t) * 16); const f32x4 a = p[0], b = p[1], c = p[2], d = p[3];
            const float sum = ((a[0] + a[1]) + (a[2] + a[3])) + ((b[0] + b[1]) + (b[2] + b[3])) + ((c[0] + c[1]) + (c[2] + c[3])) + ((d[0] + d[1]) + (d[2] + d[3]));
            lt[t] = __builtin_amdgcn_rsqf(sum * (1.f / 1024.f) + 1e-6f); }
        if (u.pn < 3) { *(PG8_LAS f32x4*)(lt + 256 + 4 * t) = *(const f32x4*)(rt + 4 * t); }
    }
    __device__ __forceinline__ void operator()(const f32x4 (&acc)[2][2][4][2], const Unit& u, int wr, int wc, int fr, int fq) const {
        const int rowt = u.pm * BM + wr * 64 + fr;
        const int vb = (u.pm * BM) < 16384 ? ((u.pm * BM) >> 12) : 4;
        const int sbase = u.pn >= 3 ? 768 + (u.pn - 3) * 256 + 32 * wc : (u.pn < 2 ? (4 * u.pn + wc) * 64 : (wc < 2 ? 512 + wc * 64 : 640 + (wc - 2) * 64));
        const int sbj = u.pn >= 3 ? 128 : 32;
        f32x4 bsv[2][2];
#pragma unroll
        for (int bj = 0; bj < 2; ++bj)
#pragma unroll
            for (int n = 0; n < 2; ++n) bsv[bj][n] = *(const f32x4*)(bias + vb * 1280 + sbase + sbj * bj + 16 * n + 4 * fq);
        float rsv[2][4];
#pragma unroll
        for (int ai = 0; ai < 2; ++ai)
#pragma unroll
            for (int m = 0; m < 4; ++m) rsv[ai][m] = lt[wr * 64 + fr + ai * HALF + m * 16];
        if (u.pn >= 3) {
#pragma unroll
            for (int ai = 0; ai < 2; ++ai)
#pragma unroll
                for (int m = 0; m < 4; ++m) { bf16_t* rp = UB + (size_t)(rowt + ai * HALF + m * 16) * 512 + (u.pn - 3) * 256 + wc * 32 + 4 * fq; const float rs = rsv[ai][m];
#pragma unroll
                    for (int bj = 0; bj < 2; ++bj)
#pragma unroll
                        for (int n = 0; n < 2; ++n) { const f32x4 v = acc[ai][bj][m][n] * rs + bsv[bj][n]; u32x2 w; w.x = cvt_pk_bf16(v[0], v[1]); w.y = cvt_pk_bf16(v[2], v[3]); *(u32x2*)(rp + bj * HALF + n * 16) = w; } }
            return;
        }
        const bool isv = (u.pn == 2 && wc >= 2), isq = u.pn < 2;
        const float* gsrc = isq ? qg : kg;
        f32x4 gn[2][2];
#pragma unroll
        for (int bj = 0; bj < 2; ++bj)
#pragma unroll
            for (int n = 0; n < 2; ++n) gn[bj][n] = *(const f32x4*)(gsrc + 32 * bj + 16 * n + 4 * fq);
        const float osc = isq ? 0.125f * 1.4426950408889634f : 1.0f;
#pragma unroll
        for (int ai = 0; ai < 2; ++ai)
#pragma unroll
            for (int m = 0; m < 4; ++m) {
                const int row = rowt + ai * HALF + m * 16; const bool lat = row < 16384; const int sidx = row & 4095;
                const size_t kvrow = lat ? (size_t)(row >> 12) * 4352 + 256 + sidx : (size_t)((row - 16384) >> 8) * 4352 + ((row - 16384) & 255);
                f32x4 y[2][2]; const float rs = rsv[ai][m];
#pragma unroll
                for (int bj = 0; bj < 2; ++bj)
#pragma unroll
                    for (int n = 0; n < 2; ++n) y[bj][n] = acc[ai][bj][m][n] * rs + bsv[bj][n];
                if (!isv) {
                    float ss = 0.f;
#pragma unroll
                    for (int bj = 0; bj < 2; ++bj)
#pragma unroll
                        for (int n = 0; n < 2; ++n) { const f32x4 v = y[bj][n]; ss += (v[0] * v[0] + v[1] * v[1]) + (v[2] * v[2] + v[3] * v[3]); }
                    ss += shx<16>(ss); ss += shx<32>(ss);
                    const float rstd = __builtin_amdgcn_rsqf(ss * (1.f / 64.f) + 1e-6f);
#pragma unroll
                    for (int bj = 0; bj < 2; ++bj) {
                        f32x4 t1 = y[bj][0] * rstd * gn[bj][0], t2 = y[bj][1] * rstd * gn[bj][1];
                        if (lat) { const int p = bj == 0 ? (sidx >> 6) : (sidx & 63);
                            const f32x4 cs = *(const PG8_LAS f32x4*)(lt + 256 + p * 16 + 4 * fq), sn = *(const PG8_LAS f32x4*)(lt + 256 + 1024 + p * 16 + 4 * fq);
                            const f32x4 o1 = t1 * cs - t2 * sn, o2 = t2 * cs + t1 * sn; t1 = o1; t2 = o2; }
                        y[bj][0] = t1 * osc; y[bj][1] = t2 * osc; }
                }
                bf16_t* dst = isq ? QO + (size_t)row * 512 + (4 * u.pn + wc) * 64 : (isv ? VA + kvrow * 128 + (wc - 2) * 64 : KA + kvrow * 128 + wc * 64);
#pragma unroll
                for (int bj = 0; bj < 2; ++bj)
#pragma unroll
                    for (int n = 0; n < 2; ++n) { const f32x4 v = y[bj][n]; u32x2 w; w.x = cvt_pk_bf16(v[0], v[1]); w.y = cvt_pk_bf16(v[2], v[3]); *(u32x2*)(dst + 32 * bj + 16 * n + 4 * fq) = w; }
            }
    }
};

struct SliceOrder {
    int G, c;
    __host__ __device__ bool next(int i, Unit& u) const { const int L = i * G + c; if (L >= 176) return false; u.ks = L >> 4; u.kofs = u.ks * 256; u.pm = (L >> 2) & 3; u.pn = L & 3; return true; }
    __device__ __forceinline__ void a_ready(const Unit&) const {}
    __device__ __forceinline__ void done(const Unit&) const {}
};
struct EpiPart { static constexpr bool ROWPERM = false; static constexpr bool PREROWS = false;
    static constexpr bool PERM = true, AFTER_DRAIN = false;
    float* P;
    __device__ __forceinline__ void operator()(const f32x4 (&acc)[2][2][4][2], const Unit& u, int wr, int wc, int fr, int fq) const {
        float* base = P + ((size_t)u.ks * 1024 + u.pm * BM + wr * 64 + fr) * 1024 + u.pn * BM + wc * 32 + 8 * fq;
#pragma unroll
        for (int ai = 0; ai < 2; ++ai)
#pragma unroll
            for (int m = 0; m < 4; ++m)
#pragma unroll
                for (int bj = 0; bj < 2; ++bj)
#pragma unroll
                    for (int n = 0; n < 2; ++n) *(f32x4*)(base + (size_t)(ai * HALF + m * 16) * 1024 + bj * HALF + n * 4) = acc[ai][bj][m][n];
    }
};

struct OneUnit { int pm, pn;
    __host__ __device__ bool next(int i, Unit& u) const { if (i > 0) return false; u.pm = pm; u.pn = pn; u.kofs = 0; u.ks = 0; return true; }
    __device__ __forceinline__ void a_ready(const Unit&) const {}
    __device__ __forceinline__ void done(const Unit&) const {}
};
template <class Epi, class Sched, bool ALIGN_EPI = false, bool SP2 = false>
__device__ __forceinline__ void gemm_phase(PG8_LAS unsigned char* lds, const Gemm g, const Sched& S, const Epi& E) {
    const int tid = otid(), wid = __builtin_amdgcn_readfirstlane(tid >> 6), lane = tid & 63, wr = wid >> 2, wc = wid & 3, fr = lane & 15, fq = lane >> 4;
    const int K = g.ld, nt = g.K / BK;
    unsigned voffA[2], voffB[2];
#pragma unroll
    for (int i = 0; i < 2; ++i) { int R, C; stage_rc(tid * 16 + i * 8192, R, C); const int Rb = Epi::PERM ? ((R & ~31) + perm32(R & 31)) : R;
        const int Ra = Epi::ROWPERM ? (128 * (R >> 6) + 8 * (R & 15) + ((R >> 4) & 3)) : R;
        voffA[i] = (unsigned)(Ra * K + C) * 2u; voffB[i] = (unsigned)(Rb * K + C) * 2u; }
    const size_t hstepA = Epi::ROWPERM ? (size_t)4 * K * 2 : (size_t)HALF * K * 2;
    const size_t kstep = (size_t)(BK * 2);
    const size_t hstep = (size_t)HALF * K * 2;
    const size_t tstep = 2 * hstep;
    const unsigned ldsw = (unsigned)wid * 1024u;
    const int aoff = lds_byte(wr * 64 + fr, fq * 8), boff = lds_byte(wc * 32 + fr, fq * 8);
#define PG8_SA(b, h) (((b) * 2 + (h)) * HTB)
#define PG8_SB(b, h) ((4 + (b) * 2 + (h)) * HTB)
#define PG8_STAGE(bufoff, gbase, voff) do { _Pragma("unroll") for (int _i = 0; _i < 2; ++_i) \
        __builtin_amdgcn_global_load_lds((const unsigned*)((const char*)(gbase) + (voff)[_i]), (PG8_LAS unsigned*)(lds + (bufoff) + ldsw + _i * 8192), 16, 0, 0); } while (0)
#define PG8_LDA(dst, b, h) do { _Pragma("unroll") for (int m = 0; m < 4; ++m) _Pragma("unroll") for (int k = 0; k < 2; ++k) dst[m][k] = *(const PG8_LAS bf16x8*)(lds + PG8_SA(b, h) + aoff + m * 2048 + k * 1024); } while (0)
#define PG8_LDB(dst, b, h) do { _Pragma("unroll") for (int n = 0; n < 2; ++n) _Pragma("unroll") for (int k = 0; k < 2; ++k) dst[n][k] = *(const PG8_LAS bf16x8*)(lds + PG8_SB(b, h) + boff + n * 2048 + k * 1024); } while (0)
#define PG8_MMA(ai, bj, At, Bt) do { __builtin_amdgcn_s_setprio(1); _Pragma("unroll") for (int m = 0; m < 4; ++m) _Pragma("unroll") for (int n = 0; n < 2; ++n) _Pragma("unroll") for (int k = 0; k < 2; ++k) \
        acc[ai][bj][m][n] = __builtin_amdgcn_mfma_f32_16x16x32_bf16(Bt[n][k], At[m][k], acc[ai][bj][m][n], 0, 0, 0); __builtin_amdgcn_s_setprio(0); } while (0)
#define PG8_WAIT_V(n) asm volatile("s_waitcnt vmcnt(" #n ")" ::: "memory")
#define PG8_WAIT_L(n) asm volatile("s_waitcnt lgkmcnt(" #n ")" ::: "memory")
#define PG8_BAR __builtin_amdgcn_s_barrier()
#define PG8_SCHED __builtin_amdgcn_sched_barrier(0)
    Unit cur, nxt; int ui = 0;
    if (!S.next(0, cur)) return;
    if constexpr (Epi::PREROWS) E.prerows(cur);
    f32x4 acc[2][2][4][2];
#pragma unroll
    for (int a = 0; a < 2; ++a)
#pragma unroll
        for (int b = 0; b < 2; ++b)
#pragma unroll
            for (int m = 0; m < 4; ++m)
#pragma unroll
                for (int n = 0; n < 2; ++n) acc[a][b][m][n] = (f32x4){0.f, 0.f, 0.f, 0.f};
    bf16x8 At[4][2], B0[2][2], B1[2][2];
    const char* cA = (const char*)g.A + (size_t)cur.pm * tstep + (size_t)cur.kofs * 2; const char* cB = (const char*)g.Bt + (size_t)cur.pn * tstep + (size_t)cur.kofs * 2;
    S.a_ready(cur);
    if constexpr (SP2) {
        PG8_STAGE(PG8_SB(0, 0), cB, voffB); PG8_STAGE(PG8_SB(0, 1), cB + hstep, voffB); PG8_STAGE(PG8_SA(0, 0), cA, voffA); PG8_STAGE(PG8_SA(0, 1), cA + hstepA, voffA);
        if (wr == 1) PG8_BAR;
        PG8_WAIT_V(2); PG8_BAR;
        PG8_STAGE(PG8_SB(1, 0), cB + kstep, voffB); PG8_STAGE(PG8_SA(1, 0), cA + kstep, voffA); PG8_STAGE(PG8_SB(1, 1), cB + hstep + kstep, voffB);
        PG8_WAIT_V(6); PG8_BAR;
    } else {
        PG8_STAGE(PG8_SB(0, 0), cB, voffB); PG8_STAGE(PG8_SA(0, 0), cA, voffA); PG8_STAGE(PG8_SB(0, 1), cB + hstep, voffB); PG8_STAGE(PG8_SA(0, 1), cA + hstepA, voffA);
        if (wr == 1) PG8_BAR;
        PG8_WAIT_V(4); PG8_BAR;
        PG8_STAGE(PG8_SB(1, 0), cB + kstep, voffB); PG8_STAGE(PG8_SA(1, 0), cA + kstep, voffA); PG8_STAGE(PG8_SB(1, 1), cB + hstep + kstep, voffB);
        PG8_WAIT_V(6); PG8_BAR;
    }
    for (;;) {
        const bool has_next = S.next(ui + 1, nxt);
        const char* nA = has_next ? (const char*)g.A + (size_t)nxt.pm * tstep + (size_t)nxt.kofs * 2 : cA; const char* nB = has_next ? (const char*)g.Bt + (size_t)nxt.pn * tstep + (size_t)nxt.kofs * 2 : cB;
        for (int t = 0; t < nt; t += 2) {
            const bool last = (t == nt - 2);
            const char* a1 = cA + (size_t)(t + 1) * kstep;
            const char* a2 = last ? nA : cA + (size_t)(t + 2) * kstep; const char* b2 = last ? nB : cB + (size_t)(t + 2) * kstep;
            const char* a3 = a2 + kstep; const char* b3 = b2 + kstep;
            if (last && has_next) S.a_ready(nxt);
            if constexpr (SP2) {
            PG8_LDB(B0, 0, 0); PG8_LDB(B1, 0, 1); PG8_SCHED; PG8_LDA(At, 0, 0); PG8_STAGE(PG8_SA(1, 1), a1 + hstepA, voffA);
            PG8_WAIT_V(8); PG8_WAIT_L(0); PG8_BAR; PG8_MMA(0, 0, At, B0); PG8_MMA(0, 1, At, B1); PG8_BAR; PG8_SCHED;
            PG8_LDA(At, 0, 1); PG8_STAGE(PG8_SB(0, 0), b2, voffB); PG8_STAGE(PG8_SB(0, 1), b2 + hstep, voffB); PG8_STAGE(PG8_SA(0, 0), a2, voffA);
            PG8_WAIT_V(8); PG8_WAIT_L(0); PG8_BAR; PG8_MMA(1, 0, At, B0); PG8_MMA(1, 1, At, B1); PG8_BAR; PG8_SCHED;
            PG8_LDB(B0, 1, 0); PG8_LDB(B1, 1, 1); PG8_SCHED; PG8_LDA(At, 1, 0); PG8_STAGE(PG8_SA(0, 1), a2 + hstepA, voffA);
            PG8_WAIT_V(8); PG8_WAIT_L(0); PG8_BAR; PG8_MMA(0, 0, At, B0); PG8_MMA(0, 1, At, B1); PG8_BAR; PG8_SCHED;
            PG8_LDA(At, 1, 1); PG8_STAGE(PG8_SB(1, 0), b3, voffB); PG8_STAGE(PG8_SB(1, 1), b3 + hstep, voffB); PG8_STAGE(PG8_SA(1, 0), a3, voffA);
            PG8_WAIT_V(8); PG8_WAIT_L(0); PG8_BAR; PG8_MMA(1, 0, At, B0); PG8_MMA(1, 1, At, B1); PG8_BAR; PG8_SCHED;
            } else {
            PG8_LDB(B0, 0, 0); PG8_SCHED; PG8_LDA(At, 0, 0); PG8_STAGE(PG8_SA(1, 1), a1 + hstepA, voffA);
            PG8_WAIT_L(8); PG8_BAR; PG8_WAIT_L(0); PG8_MMA(0, 0, At, B0); PG8_BAR; PG8_SCHED;
            PG8_LDB(B1, 0, 1); PG8_STAGE(PG8_SB(0, 0), b2, voffB);
            PG8_BAR; PG8_WAIT_L(0); PG8_MMA(0, 1, At, B1); PG8_BAR;
            PG8_LDA(At, 0, 1); PG8_STAGE(PG8_SA(0, 0), a2, voffA);
            PG8_BAR; PG8_WAIT_L(0); PG8_MMA(1, 0, At, B0); PG8_BAR; PG8_SCHED;
            PG8_STAGE(PG8_SB(0, 1), b2 + hstep, voffB);
            PG8_WAIT_V(6); PG8_BAR; PG8_MMA(1, 1, At, B1); PG8_BAR;
            PG8_LDB(B0, 1, 0); PG8_SCHED; PG8_LDA(At, 1, 0); PG8_STAGE(PG8_SA(0, 1), a2 + hstepA, voffA);
            PG8_WAIT_L(8); PG8_BAR; PG8_WAIT_L(0); PG8_MMA(0, 0, At, B0); PG8_BAR; PG8_SCHED;
            PG8_LDB(B1, 1, 1); PG8_STAGE(PG8_SB(1, 0), b3, voffB);
            PG8_BAR; PG8_WAIT_L(0); PG8_MMA(0, 1, At, B1); PG8_BAR;
            PG8_LDA(At, 1, 1); PG8_STAGE(PG8_SA(1, 0), a3, voffA);
            PG8_BAR; PG8_WAIT_L(0); PG8_MMA(1, 0, At, B0); PG8_BAR; PG8_SCHED;
            PG8_STAGE(PG8_SB(1, 1), b3 + hstep, voffB);
            PG8_WAIT_V(6); PG8_BAR; PG8_MMA(1, 1, At, B1); PG8_BAR;
            }
        }
        if constexpr (ALIGN_EPI) { if (wr == 0) PG8_BAR; }
        if constexpr (!Epi::AFTER_DRAIN) { int l2 = olane(); asm volatile("" : "+v"(l2)); const int fr2 = l2 & 15, fq2 = l2 >> 4; E(acc, cur, wr, wc, fr2, fq2); S.done(cur); }
        if (!has_next) break;
        if constexpr (Epi::PREROWS) E.prerows(nxt);
#pragma unroll
        for (int a = 0; a < 2; ++a)
#pragma unroll
            for (int b = 0; b < 2; ++b)
#pragma unroll
                for (int m = 0; m < 4; ++m)
#pragma unroll
                    for (int n = 0; n < 2; ++n) acc[a][b][m][n] = (f32x4){0.f, 0.f, 0.f, 0.f};
        cur = nxt; cA = nA; cB = nB; ++ui;
        if constexpr (ALIGN_EPI) { if (wr == 1) PG8_BAR; }
    }
    PG8_WAIT_V(0);
    if constexpr (!ALIGN_EPI) { if (wr == 0) PG8_BAR; }
    PG8_BAR;
    if constexpr (Epi::AFTER_DRAIN) { E.fused(acc, cur, wr, wc, fr, fq, lds, wid, lane); S.done(cur); }
#undef PG8_SA
#undef PG8_SB
#undef PG8_STAGE
#undef PG8_LDA
#undef PG8_LDB
#undef PG8_MMA
#undef PG8_WAIT_V
#undef PG8_WAIT_L
#undef PG8_BAR
#undef PG8_SCHED
}
}
#include <hip/hip_bf16.h>
namespace attn_body {
using bf16=__hip_bfloat16;
using bf16x8=__attribute__((ext_vector_type(8)))short;
using s16x4=__attribute__((ext_vector_type(4)))short;
using f32x16=__attribute__((ext_vector_type(16)))float;
using u32x4=__attribute__((ext_vector_type(4)))unsigned;
constexpr int D=64,QP=512,KP=128;
constexpr int NW=8,QBLK=32,QB=QBLK*NW,KVBLK=64;
__device__ __forceinline__ int crow(int r,int hi){return (r&3)+8*(r>>2)+4*hi;}
#define SBAR() __builtin_amdgcn_sched_barrier(0)
__device__ __forceinline__ void cmask(f32x16&p0,f32x16&p1,int jb,int qrel,int hi){
  const float NEG=-INFINITY; int kb=64*jb+4*hi;
  #pragma unroll
  for(int r=0;r<16;++r){int kv=kb+(r&3)+8*(r>>2); if(kv>qrel)p0[r]=NEG; if(kv+32>qrel)p1[r]=NEG;}
}

constexpr int NSLOT=3, SLOTB=8192;
constexpr int LDS_K=0, LDS_V=NSLOT*SLOTB, LDS_WS=2*NSLOT*SLOTB, LDS_OST=LDS_WS+NW*64*4, LDS_BYTES=LDS_OST+NW*4096;
constexpr float C2=0.125f*1.4426950408889634f;
__device__ __forceinline__ void glds16(const void*gsrc,unsigned lds_dst){unsigned keep;
  asm volatile("s_mov_b32 %0, m0\n\ts_mov_b32 m0, %2\n\ts_nop 0\n\tglobal_load_lds_dwordx4 %1, off\n\ts_mov_b32 m0, %0":"=&s"(keep):"v"(gsrc),"s"(lds_dst):"memory");}
__device__ __forceinline__ float max3f(float a,float b,float c){float r;asm("v_max3_f32 %0, %1, %2, %3":"=v"(r):"v"(a),"v"(b),"v"(c));return r;}
__device__ __forceinline__ float max2f(float a,float b){float r;asm("v_max_f32_e32 %0, %1, %2":"=v"(r):"v"(a),"v"(b));return r;}
__device__ __forceinline__ float fadd_s(float a,float b){float r;asm("v_add_f32_e32 %0, %1, %2":"=v"(r):"v"(a),"v"(b));return r;}
__device__ __forceinline__ float fsub_s(float a,float b){float r;asm("v_sub_f32_e32 %0, %1, %2":"=v"(r):"v"(a),"v"(b));return r;}
typedef float f32x2_t __attribute__((ext_vector_type(2))); typedef __bf16 bf16x2_t __attribute__((ext_vector_type(2)));
__device__ __forceinline__ unsigned cvtpk_s(float lo,float hi){f32x2_t v={lo,hi};bf16x2_t b=__builtin_convertvector(v,bf16x2_t);return __builtin_bit_cast(unsigned,b);}
#define WAIT_BAR(N) asm volatile("s_waitcnt vmcnt(" #N ") lgkmcnt(0)\n\ts_barrier":::"memory")

__device__ __forceinline__ void qkt(f32x16&p0,f32x16&p1,const char*Kslot,const bf16x8*qr,const f32x16&negm,int r32,int hi){
  const char*kb=Kslot+hi*1024+r32*16;
  #pragma unroll
  for(int d0=0;d0<4;++d0){
    const bf16x8 b0=*reinterpret_cast<const bf16x8*>(kb+d0*2048);
    const bf16x8 b1=*reinterpret_cast<const bf16x8*>(kb+d0*2048+512);
    if(d0==0){p0=__builtin_amdgcn_mfma_f32_32x32x16_bf16(b0,qr[0],negm,0,0,0);p1=__builtin_amdgcn_mfma_f32_32x32x16_bf16(b1,qr[0],negm,0,0,0);}
    else{p0=__builtin_amdgcn_mfma_f32_32x32x16_bf16(b0,qr[d0],p0,0,0,0);p1=__builtin_amdgcn_mfma_f32_32x32x16_bf16(b1,qr[d0],p1,0,0,0);}}
}
typedef __attribute__((address_space(3))) const char* lds_cptr;
typedef short v4i16_t __attribute__((ext_vector_type(4)));
__device__ __forceinline__ void kload8(bf16x8*kf,lds_cptr kp){
  kf[0]=*(const __attribute__((address_space(3))) bf16x8*)(kp);      kf[1]=*(const __attribute__((address_space(3))) bf16x8*)(kp+512);
  kf[2]=*(const __attribute__((address_space(3))) bf16x8*)(kp+2048); kf[3]=*(const __attribute__((address_space(3))) bf16x8*)(kp+2560);
  kf[4]=*(const __attribute__((address_space(3))) bf16x8*)(kp+4096); kf[5]=*(const __attribute__((address_space(3))) bf16x8*)(kp+4608);
  kf[6]=*(const __attribute__((address_space(3))) bf16x8*)(kp+6144); kf[7]=*(const __attribute__((address_space(3))) bf16x8*)(kp+6656);
}
__device__ __forceinline__ void kload2(bf16x8*kf,lds_cptr kp,int j){ kf[2*j]=*(const __attribute__((address_space(3))) bf16x8*)(kp+j*2048); kf[2*j+1]=*(const __attribute__((address_space(3))) bf16x8*)(kp+j*2048+512); }
__device__ __forceinline__ s16x4 vtr(lds_cptr p){ return __builtin_bit_cast(s16x4,__builtin_amdgcn_ds_read_tr16_b64_v4i16((__attribute__((address_space(3))) v4i16_t*)p)); }
__device__ __forceinline__ float rowmax(const f32x16&p0,const f32x16&p1){
  float a=max3f(p0[0],p0[1],p1[0]),b=max3f(p0[2],p0[3],p1[1]);a=max3f(a,p1[2],p1[3]);
  #pragma unroll
  for(int r=4;r<16;r+=4){a=max3f(a,p0[r],p0[r+1]);b=max3f(b,p0[r+2],p0[r+3]);a=max3f(a,p1[r],p1[r+1]);b=max3f(b,p1[r+2],p1[r+3]);}
  const float m=max2f(a,b);
  auto rr=__builtin_amdgcn_permlane32_swap(__float_as_uint(m),__float_as_uint(m),false,false);
  return max2f(__uint_as_float(rr[0]),__uint_as_float(rr[1]));
}
__device__ __forceinline__ void pv(f32x16*o,int vb,bf16x8 pa0,bf16x8 pa1,bf16x8 pa2,bf16x8 pa3){
  #pragma unroll
  for(int d0=0;d0<2;++d0){s16x4 lo[4],hi[4];
    #pragma unroll
    for(int ks=0;ks<4;++ks){
      asm volatile("ds_read_b64_tr_b16 %0,%1 offset:%c2":"=&v"(lo[ks]):"v"(vb),"i"(d0*4096+ks*1024):"memory");
      asm volatile("ds_read_b64_tr_b16 %0,%1 offset:%c2":"=&v"(hi[ks]):"v"(vb),"i"(d0*4096+ks*1024+512):"memory");}
    asm volatile("s_waitcnt lgkmcnt(0)":::"memory");SBAR();
    #define PK(k) (bf16x8){lo[k][0],lo[k][1],lo[k][2],lo[k][3],hi[k][0],hi[k][1],hi[k][2],hi[k][3]}
    o[d0]=__builtin_amdgcn_mfma_f32_32x32x16_bf16(pa0,PK(0),o[d0],0,0,0);
    o[d0]=__builtin_amdgcn_mfma_f32_32x32x16_bf16(pa1,PK(1),o[d0],0,0,0);
    o[d0]=__builtin_amdgcn_mfma_f32_32x32x16_bf16(pa2,PK(2),o[d0],0,0,0);
    o[d0]=__builtin_amdgcn_mfma_f32_32x32x16_bf16(pa3,PK(3),o[d0],0,0,0);
    #undef PK
  }
}

#ifndef ATTN_STORE16
#define ATTN_STORE16(p,v) do{ unsigned long long* p8_=(unsigned long long*)(p); const u32x4 v_=(v); __hip_atomic_store(p8_,(unsigned long long)v_.x|((unsigned long long)v_.y<<32),__ATOMIC_RELAXED,__HIP_MEMORY_SCOPE_AGENT); __hip_atomic_store(p8_+1,(unsigned long long)v_.z|((unsigned long long)v_.w<<32),__ATOMIC_RELAXED,__HIP_MEMORY_SCOPE_AGENT); }while(0)
#endif
template<int THRL> __device__ __forceinline__ void attn_unit(long qrow0,long kvrow0,int h,int NT,const bf16*Q,const bf16*__restrict__ K,const bf16*__restrict__ V,bf16*O,char*shm){
  const int tid=otid(),lane=tid&63,r32=lane&31,hi=lane>>5; const int wid=__builtin_amdgcn_readfirstlane(tid>>6);
  const bf16*Qw=Q+(qrow0+wid*QBLK)*QP+h*D;
  const bf16*Kh=K+kvrow0*KP+(h>>2)*D,*Vh=V+kvrow0*KP+(h>>2)*D;
  const unsigned lds0=(unsigned)(uintptr_t)shm;
  float*wsf=(float*)(shm+LDS_WS)+wid*64;
  const bf16*ksrc=Kh+(long)lane*KP+wid*8;
  const bf16*vsrc=Vh+(long)(16*(wid&3)+(lane>>2))*KP+(wid>>2)*32+(lane&3)*8;
  const unsigned kdst=lds0+LDS_K+wid*1024, vdst=lds0+LDS_V+wid*1024;
  #define DMA_K(t,slot) glds16(ksrc+(long)(t)*KVBLK*KP,(unsigned)__builtin_amdgcn_readfirstlane(kdst+(slot)))
  #define DMA_V(t,slot) glds16(vsrc+(long)(t)*KVBLK*KP,(unsigned)__builtin_amdgcn_readfirstlane(vdst+(slot)))
  const int vb0=(int)(lds0+LDS_V)+((lane>>4)&1)*32+(lane&3)*8+(4*hi+((lane&15)>>2))*64;
  const char*Kbase=shm+LDS_K; bf16x8 kf[8];
  const lds_cptr shm3=(lds_cptr)shm; const lds_cptr kp0=shm3+LDS_K+hi*1024+r32*16; const lds_cptr vp0=shm3+LDS_V+((lane>>4)&1)*32+(lane&3)*8+(4*hi+((lane&15)>>2))*64;
  DMA_K(0,0);DMA_V(0,0);DMA_K(1,SLOTB);
  bf16x8 qr[4];
  #pragma unroll
  for(int d0=0;d0<4;++d0)qr[d0]=*reinterpret_cast<const bf16x8*>(&Qw[(long)r32*QP+d0*16+hi*8]);
  float mhat=0.f,l_reg=0.f;f32x16 o[2];o[0]=f32x16{};o[1]=f32x16{};f32x16 negm=f32x16{};asm volatile("":"+v"(negm));
  #define CMASK(P0,P1,t) do{}while(0)
  bool resc=false;
  #define START(P0,P1) do{ const float rm=rowmax(P0,P1); resc=false; \
    { const float dl=rm; mhat=fadd_s(mhat,dl); \
      _Pragma("unroll") for(int r=0;r<16;++r){P0[r]=fsub_s(P0[r],dl);P1[r]=fsub_s(P1[r],dl);} \
      _Pragma("unroll") for(int r=0;r<16;++r)negm[r]=-mhat; asm volatile("":"+v"(negm)); } \
    _Pragma("unroll") for(int r=0;r<16;++r)P0[r]=__builtin_amdgcn_exp2f(P0[r]); }while(0)
  #define RESC() do{ if(resc){ asm volatile("s_waitcnt lgkmcnt(0)":::"memory"); \
      _Pragma("unroll") for(int d_=0;d_<2;++d_) _Pragma("unroll") for(int r=0;r<16;++r)o[d_][r]*=wsf[crow(r,hi)]; } }while(0)
  f32x16 pA0,pA1,pB0,pB1;
  int sl_prev=0,sl_cur=0,sl_next=SLOTB;
  #define ROT() do{sl_prev=sl_cur;sl_cur=sl_next;sl_next=(sl_next==(NSLOT-1)*SLOTB)?0:sl_next+SLOTB;}while(0)
  DMA_K(2,2*SLOTB);
  WAIT_BAR(3);
  qkt(pA0,pA1,Kbase,qr,negm,r32,hi);asm volatile("s_nop 15\n\ts_nop 7":"+v"(pA0),"+v"(pA1));CMASK(pA0,pA1,0);
  START(pA0,pA1);
  _Pragma("unroll") for(int r=0;r<16;++r)pA1[r]=__builtin_amdgcn_exp2f(pA1[r]);
  WAIT_BAR(0);
  DMA_K(3,0);DMA_V(1,SLOTB);
  ROT();
  kload8(kf,kp0+sl_cur);
  WAIT_BAR(2);
  s16x4 vlo[8],vhi[8]; u32x4 pw0,pw1,pw2,pw3;
  #define PKW(P,B) cvtpk_s(P[B],P[B+1])
  #define PAF(k) __builtin_bit_cast(bf16x8,pw##k)
  #define VFR(i) (bf16x8){vlo[i][0],vlo[i][1],vlo[i][2],vlo[i][3],vhi[i][0],vhi[i][1],vhi[i][2],vhi[i][3]}
  #define PIN(x) asm volatile("":"+v"(x))
  #define MX3(a,b,c) __builtin_fmaxf(__builtin_fmaxf((a),(b)),(c))
  #define GAPA(MF,A0,A1,A2,A3,W0,W1,PW) do{ MF; sacc+=A0; sacc+=A1; sacc+=A2; sacc+=A3; PIN(sacc); W0; W1; PIN(PW); SBAR(); }while(0)
  #define EX(v) __builtin_amdgcn_exp2f(v)
  #define GAPB(MF,X,B) do{ MF; X[B]=EX(X[B]); X[B+1]=EX(X[B+1]); X[B+2]=EX(X[B+2]); X[B+3]=EX(X[B+3]); PIN(X); SBAR(); }while(0)
  #define VRD(i) do{ vlo[i]=vtr(vp_+(((i)>>2)*4096+((i)&3)*1024)); vhi[i]=vtr(vp_+(((i)>>2)*4096+((i)&3)*1024+512)); }while(0)
  #define KRD(G,j) do{ if(G){ kload2(kf,kp0+sl_next,j); SBAR(); } }while(0)
  #define STEP(C0,C1,P0,P1,t,GK,GV,GL) do{ SBAR(); \
    const lds_cptr vp_=vp0+sl_prev; \
    VRD(0); SBAR(); float sacc=(P0[0]+P0[1]); \
    GAPA(C0=__builtin_amdgcn_mfma_f32_32x32x16_bf16(kf[0],qr[0],negm,0,0,0), P0[2],P0[3],P0[4],P0[5],     pw0[0]=PKW(P0,0), pw0[1]=PKW(P0,2), pw0); \
    VRD(4); SBAR(); GAPA(C1=__builtin_amdgcn_mfma_f32_32x32x16_bf16(kf[1],qr[0],negm,0,0,0), P0[6],P0[7],P0[8],P0[9],     pw0[2]=PKW(P0,4), pw0[3]=PKW(P0,6), pw0); \
    VRD(1); SBAR(); GAPA(C0=__builtin_amdgcn_mfma_f32_32x32x16_bf16(kf[2],qr[1],C0,0,0,0),   P0[10],P0[11],P0[12],P0[13], pw1[0]=PKW(P0,8), pw1[1]=PKW(P0,10), pw1); \
    VRD(5); SBAR(); GAPA(C1=__builtin_amdgcn_mfma_f32_32x32x16_bf16(kf[3],qr[1],C1,0,0,0),   P0[14],P0[15],P1[0],P1[1],   pw1[2]=PKW(P0,12),pw1[3]=PKW(P0,14), pw1); \
    VRD(2); SBAR(); GAPA(C0=__builtin_amdgcn_mfma_f32_32x32x16_bf16(kf[4],qr[2],C0,0,0,0),   P1[2],P1[3],P1[4],P1[5],     pw2[0]=PKW(P1,0), pw2[1]=PKW(P1,2), pw2); \
    VRD(6); SBAR(); GAPA(C1=__builtin_amdgcn_mfma_f32_32x32x16_bf16(kf[5],qr[2],C1,0,0,0),   P1[6],P1[7],P1[8],P1[9],     pw2[2]=PKW(P1,4), pw2[3]=PKW(P1,6), pw2); \
    VRD(3); SBAR(); GAPA(C0=__builtin_amdgcn_mfma_f32_32x32x16_bf16(kf[6],qr[3],C0,0,0,0),   P1[10],P1[11],P1[12],P1[13], pw3[0]=PKW(P1,8), pw3[1]=PKW(P1,10), pw3); \
    VRD(7); SBAR(); GAPA(C1=__builtin_amdgcn_mfma_f32_32x32x16_bf16(kf[7],qr[3],C1,0,0,0),   P1[14],P1[15],0.f,0.f,       pw3[2]=PKW(P1,12),pw3[3]=PKW(P1,14), pw3); \
    l_reg+=sacc; \
    if(GK){DMA_K((t)+3,sl_cur);} if(GV){DMA_V((t)+1,sl_next);} \
    CMASK(C0,C1,t); \
    { float a=MX3(C0[0],C0[1],C1[0]),b=MX3(C0[2],C0[3],C1[1]); a=MX3(a,C1[2],C1[3]); \
      _Pragma("unroll") for(int r=4;r<16;r+=4){a=MX3(a,C0[r],C0[r+1]);b=MX3(b,C0[r+2],C0[r+3]);a=MX3(a,C1[r],C1[r+1]);b=MX3(b,C1[r+2],C1[r+3]);} \
      float rm=__builtin_fmaxf(a,b); { auto rr=__builtin_amdgcn_permlane32_swap(__float_as_uint(rm),__float_as_uint(rm),false,false); rm=__builtin_fmaxf(__uint_as_float(rr[0]),__uint_as_float(rr[1])); } \
      resc=false; \
      if(__builtin_expect(__any(rm>(float)THRL),0)){ const float dl=__builtin_fmaxf(rm,0.f); mhat+=dl; \
        _Pragma("unroll") for(int r=0;r<16;++r){C0[r]-=dl;C1[r]-=dl;} \
        _Pragma("unroll") for(int r=0;r<16;++r)negm[r]=-mhat; asm volatile("":"+v"(negm)); \
        const float f=__builtin_amdgcn_exp2f(-dl); l_reg*=f; if(hi==0)wsf[r32]=f; resc=true; } } \
    SBAR(); \
    GAPB(o[0]=__builtin_amdgcn_mfma_f32_32x32x16_bf16(PAF(0),VFR(0),o[0],0,0,0), C0,0); \
    GAPB(o[1]=__builtin_amdgcn_mfma_f32_32x32x16_bf16(PAF(0),VFR(4),o[1],0,0,0), C0,4); \
    KRD(GL,0); GAPB(o[0]=__builtin_amdgcn_mfma_f32_32x32x16_bf16(PAF(1),VFR(1),o[0],0,0,0), C0,8); \
    KRD(GL,1); GAPB(o[1]=__builtin_amdgcn_mfma_f32_32x32x16_bf16(PAF(1),VFR(5),o[1],0,0,0), C0,12); \
    KRD(GL,2); GAPB(o[0]=__builtin_amdgcn_mfma_f32_32x32x16_bf16(PAF(2),VFR(2),o[0],0,0,0), C1,0); \
    KRD(GL,3); GAPB(o[1]=__builtin_amdgcn_mfma_f32_32x32x16_bf16(PAF(2),VFR(6),o[1],0,0,0), C1,4); \
    GAPB(o[0]=__builtin_amdgcn_mfma_f32_32x32x16_bf16(PAF(3),VFR(3),o[0],0,0,0), C1,8); \
    GAPB(o[1]=__builtin_amdgcn_mfma_f32_32x32x16_bf16(PAF(3),VFR(7),o[1],0,0,0), C1,12); \
    }while(0)
  int t=1;
  #undef CMASK
  #define CMASK(P0,P1,t) do{}while(0)
  for(;t+5<NT;t+=2){
    STEP(pB0,pB1,pA0,pA1,t,true,true,true);     WAIT_BAR(2); RESC(); ROT();
    STEP(pA0,pA1,pB0,pB1,t+1,true,true,true);   WAIT_BAR(2); RESC(); ROT();
  }
  #undef CMASK
  #define CMASK(P0,P1,t) do{}while(0)
  #define ENDW(tt) do{ if((tt)+3<NT){WAIT_BAR(2);} else if((tt)+2<NT){WAIT_BAR(1);} else {WAIT_BAR(0);} }while(0)
  for(;t+1<NT;t+=2){
    STEP(pB0,pB1,pA0,pA1,t,(t+3<NT),(t+1<NT),(t+1<NT));       ENDW(t);   RESC(); ROT();
    STEP(pA0,pA1,pB0,pB1,t+1,(t+4<NT),(t+2<NT),(t+2<NT));     ENDW(t+1); RESC(); ROT();
  }
  STEP(pB0,pB1,pA0,pA1,NT-1,false,false,false); RESC();
  { float sacc=pB0[0]+pB0[1]; _Pragma("unroll") for(int r=2;r<16;++r)sacc+=pB0[r]; _Pragma("unroll") for(int r=0;r<16;++r)sacc+=pB1[r]; l_reg+=sacc;
    pw0=(u32x4){PKW(pB0,0),PKW(pB0,2),PKW(pB0,4),PKW(pB0,6)};pw1=(u32x4){PKW(pB0,8),PKW(pB0,10),PKW(pB0,12),PKW(pB0,14)};pw2=(u32x4){PKW(pB1,0),PKW(pB1,2),PKW(pB1,4),PKW(pB1,6)};pw3=(u32x4){PKW(pB1,8),PKW(pB1,10),PKW(pB1,12),PKW(pB1,14)};
    SBAR(); pv(o,vb0+sl_cur,PAF(0),PAF(1),PAF(2),PAF(3)); }
  #undef PKW
  #undef PAF
  #undef VFR
  #undef PIN
  #undef MX3
  #undef GAPA
  #undef GAPB
  #undef EX
  #undef VRD
  #undef KRD
  #undef STEP
  #undef ENDW
  {auto rr=__builtin_amdgcn_permlane32_swap(__float_as_uint(l_reg),__float_as_uint(l_reg),false,false);l_reg=__uint_as_float(rr[0])+__uint_as_float(rr[1]);}
  if(hi==0)wsf[32+r32]=l_reg;asm volatile("s_waitcnt lgkmcnt(0)":::"memory");
  float rli[16];
  #pragma unroll
  for(int r=0;r<16;++r)rli[r]=__builtin_amdgcn_rcpf(wsf[32+crow(r,hi)]);
  bf16*Ow=O+(qrow0+wid*QBLK)*QP+h*D;
  { bf16*stg=(bf16*)(shm+LDS_OST)+wid*2048;
    #pragma unroll
    for(int r=0;r<16;++r){const int orow=crow(r,hi);
      #pragma unroll
      for(int d0=0;d0<2;++d0)stg[orow*64+d0*32+r32]=__float2bfloat16(o[d0][r]*rli[r]);}
    asm volatile("s_waitcnt lgkmcnt(0)":::"memory");
    #pragma unroll
    for(int i=0;i<4;++i){const int row=i*8+(lane>>3),ch=lane&7; const u32x4 v=*(const u32x4*)(stg+row*64+ch*8); ATTN_STORE16(Ow+(long)row*QP+ch*8,v);} }
  asm volatile("s_waitcnt lgkmcnt(0)\n\ts_barrier":::"memory");
  #undef DMA_K
  #undef DMA_V
  #undef CMASK
  #undef START
  #undef RESC
  #undef ROT
}
constexpr int ATTN_LDS_BYTES=LDS_BYTES;
#undef SBAR
#undef WAIT_BAR
}
#define GAS __attribute__((address_space(1)))
#define LAS __attribute__((address_space(3)))
typedef unsigned short bf16;
typedef unsigned v4u __attribute__((ext_vector_type(4)));
typedef unsigned v2u __attribute__((ext_vector_type(2)));
typedef float f32x4 __attribute__((ext_vector_type(4)));
typedef short bf16x8 __attribute__((ext_vector_type(8)));

constexpr int NTOK = 17408, NLAT = 16384, DMOD = 1024, INC = 1280, DFF = 2816, DFF2 = 5632, DEPTH = 4;
constexpr int NSTAGE = 3, NPHASE = 3 + DEPTH * NSTAGE;
constexpr size_t MiB = 1u << 20;
constexpr size_t WS_CTL = 0, WS_MOD = 1 * MiB, WS_XC = 2 * MiB, WS_ROPE = 6 * MiB, WS_A16 = 7 * MiB;
constexpr size_t WS_WIN = 8 * MiB, WS_WGLU = 11 * MiB, WS_WOUT = 12 * MiB, WS_WUP = 14 * MiB, WS_WDN = 25 * MiB;
constexpr size_t WS_PFPR = 31 * MiB, WS_MTOT = 47 * MiB, WS_XN = 79 * MiB, WS_R = 113 * MiB;
constexpr size_t WS_PROJ = WS_R, WS_QO = WS_R + 43 * MiB, WS_KALL = WS_R + 60 * MiB, WS_VALL = WS_R + 65 * MiB, WS_Z = WS_R + 70 * MiB,
                 WS_SSMO = WS_R + 87 * MiB, WS_SSCR = WS_R + 104 * MiB, WS_HIN = WS_R + 138 * MiB, WS_O = WS_R + 155 * MiB;
constexpr size_t WS_HFFN = WS_R, WS_SIDE = WS_R + 94 * MiB, WS_XT2 = WS_R + 172 * MiB, WS_SSQ1 = WS_R + 206 * MiB, WS_SSQ2 = WS_R + 208 * MiB, WS_END = WS_R + 210 * MiB, WS_PART = WS_R + 104 * MiB;
constexpr size_t WS_CS = 1 * MiB + 512 * 1024, WS_BIASIN = 7 * MiB + 256 * 1024, WS_BIASUP = 7 * MiB + 512 * 1024;
constexpr int LDS_BYTES = 147456, QS_OFF = 135168;
#ifndef PHM
#define PHM 0xffff
#endif
#define PHON(k) ((PHM >> (k)) & 1)
#ifndef REP_STAGE
#define REP_STAGE -1
#endif
#ifndef REP_SYNC
#define REP_SYNC 0
#endif
constexpr float C2Q = 0.125f * 1.4426950408889634f;

struct Args { const float* in[27]; float* out; unsigned char* ws; int ph_lo, ph_hi, coop, pad; };

__device__ __forceinline__ unsigned pk2(float lo, float hi) { return pg8::cvt_pk_bf16(lo, hi); }
__device__ __forceinline__ float bflo(unsigned w) { return __uint_as_float(w << 16); }
__device__ __forceinline__ float bfhi(unsigned w) { return __uint_as_float(w & 0xffff0000u); }
__device__ __forceinline__ float wave_sum(float v) {
    v += shx<1>(v); v += shx<2>(v); v += shx<4>(v); v += shx<8>(v); v += shx<16>(v); v += shx<32>(v);
    return v;
}
__device__ __forceinline__ float silu_f(float x) { return x * __builtin_amdgcn_rcpf(1.0f + __builtin_amdgcn_exp2f(-1.4426950408889634f * x)); }
__device__ __forceinline__ float gelu_tanh(float y) { const float u = 0.7978845608028654f * (y + 0.044715f * y * y * y); return y * __builtin_amdgcn_rcpf(1.0f + __builtin_amdgcn_exp2f(-2.8853900817779268f * u)); }

__device__ __forceinline__ void transpose_item(const float* W, int K, int N, bf16* WT, LAS float* scr, int item, int lane, int rmap = 0) {
    const int nblk = N / 32, kb = item / nblk, nb = item % nblk, k0 = 64 * kb, n0 = 32 * nb;
    const int r0 = rmap == 2 ? (n0 >= 768 ? n0 : ((n0 >> 6) < 8 ? ((n0 >> 6) >> 2) * 256 + ((n0 >> 6) & 3) * 32 : 512 + ((n0 >> 6) - 8) * 32) + 128 * ((n0 >> 5) & 1)) : rmap == 0 ? n0 : (n0 < 2816 ? (n0 >> 7) * 256 + (n0 & 127) : ((n0 - 2816) >> 7) * 256 + 128 + ((n0 - 2816) & 127));
#pragma unroll 8
    for (int i = 0; i < 32; ++i) { const int kk = 2 * i + (lane >> 5); scr[kk * 33 + (lane & 31)] = W[(size_t)(k0 + kk) * N + n0 + (lane & 31)]; }
    asm volatile("s_waitcnt lgkmcnt(0)" ::: "memory");
    const int c = lane & 7;
#pragma unroll
    for (int j = 0; j < 4; ++j) { const int n = (lane >> 3) + 8 * j; const LAS float* s = scr + (8 * c) * 33 + n;
        v4u o; o.x = pk2(s[0 * 33], s[1 * 33]); o.y = pk2(s[2 * 33], s[3 * 33]); o.z = pk2(s[4 * 33], s[5 * 33]); o.w = pk2(s[6 * 33], s[7 * 33]);
        *(v4u*)(WT + (size_t)(r0 + n) * K + k0 + 8 * c) = o; }
    asm volatile("s_waitcnt lgkmcnt(0)" ::: "memory");
}

__device__ __forceinline__ float* xrow(float* xlat, float* xctx, int row) { return row < NLAT ? xlat + (size_t)row * DMOD : xctx + (size_t)(row - NLAT) * DMOD; }
__device__ __forceinline__ int modv(int row) { return row < NLAT ? (row >> 12) : 4; }

__device__ __forceinline__ void norm_row(const float* src, float* dstcopy, bf16* xn, const float* g, const float* shift, const float* scale, int lane) {
    const f32x4* xr = (const f32x4*)src + lane;
    f32x4 v[4]; float s = 0.f;
#pragma unroll
    for (int j = 0; j < 4; ++j) { v[j] = xr[64 * j]; s += (v[j].x * v[j].x + v[j].y * v[j].y) + (v[j].z * v[j].z + v[j].w * v[j].w); }
    if (dstcopy) {
#pragma unroll
        for (int j = 0; j < 4; ++j) ((f32x4*)dstcopy + lane)[64 * j] = v[j];
    }
    const float rstd = __builtin_amdgcn_rsqf(wave_sum(s) * (1.f / DMOD) + 1e-6f);
    unsigned long long* o8 = (unsigned long long*)xn + lane;
#pragma unroll
    for (int j = 0; j < 4; ++j) {
        const f32x4 gg = ((const f32x4*)g + lane)[64 * j], sh = ((const f32x4*)shift + lane)[64 * j], sc = ((const f32x4*)scale + lane)[64 * j];
        const f32x4 y = (v[j] * rstd) * gg * (sc + 1.0f) + sh;
        o8[64 * j] = (unsigned long long)pk2(y.x, y.y) | ((unsigned long long)pk2(y.z, y.w) << 32);
    }
}
__device__ __forceinline__ void ssm_tables(const Args& a, LAS unsigned char* lds, int layer, int g, int tid) {
    LAS float* pw = (LAS float*)lds;
    LAS float* bbs = pw + 4352;
    LAS float* cs = bbs + 4096;
    LAS float* G = cs + 4096;
    if (tid < 128) {
        const int dir = tid >> 6, n = tid & 63; const int gi = (layer * 2 + dir) * 32 + g; const int idx = gi * 64 + n;
        const float lr = a.in[10][idx], li = a.in[11][idx], dt = expf(a.in[12][gi]);
        for (int e = 0; e <= 16; ++e) { const float mag = expf(lr * dt * (float)e), ang = li * dt * (float)e;
            pw[((dir * 17 + e) * 64 + n) * 2] = mag * cosf(ang); pw[((dir * 17 + e) * 64 + n) * 2 + 1] = mag * sinf(ang); }
        const float mag1 = expf(lr * dt); const float are = mag1 * cosf(li * dt), aim = mag1 * sinf(li * dt), den = lr * lr + li * li;
        const float fre = ((are - 1.f) * lr + aim * li) / den, fim = (aim * lr - (are - 1.f) * li) / den;
        for (int q = 0; q < 16; ++q) { const float br = a.in[13][(size_t)idx * 16 + q], bi = a.in[14][(size_t)idx * 16 + q];
            bbs[((dir * 64 + n) * 16 + q) * 2] = fre * br - fim * bi; bbs[((dir * 64 + n) * 16 + q) * 2 + 1] = fre * bi + fim * br; }
    }
    for (int i = tid; i < 2048; i += 512) { const int dir = i >> 10, p = (i >> 6) & 15, n = i & 63; const size_t src = ((size_t)((layer * 2 + dir) * 32 + g) * 16 + p) * 64 + n;
        cs[2 * i] = a.in[15][src]; cs[2 * i + 1] = a.in[16][src]; }
    __syncthreads();
    for (int i = tid; i < 8192; i += 512) { const int dir = i >> 12, l = (i >> 8) & 15, p = (i >> 4) & 15, q = i & 15; float sum = 0.f;
        for (int n = 0; n < 64; ++n) { const float cr = cs[((dir * 16 + p) * 64 + n) * 2], ci = cs[((dir * 16 + p) * 64 + n) * 2 + 1];
            const float ar = pw[((dir * 17 + l) * 64 + n) * 2], ai = pw[((dir * 17 + l) * 64 + n) * 2 + 1];
            const float br = bbs[((dir * 64 + n) * 16 + q) * 2], bi = bbs[((dir * 64 + n) * 16 + q) * 2 + 1];
            const float zr = cr * ar - ci * ai, zi = cr * ai + ci * ar; sum += zr * br - zi * bi; }
        G[i] = sum; }
    __syncthreads();
    bf16* Mt = (bf16*)(a.ws + WS_MTOT) + (size_t)(layer * 32 + g) * 256 * 512;
    for (int i = tid; i < 16384; i += 512) { const int row = i >> 6, k0 = (i & 63) * 8, t = row >> 4, p = row & 15; float v[8];
        if (k0 < 256) { const int sp = k0 >> 4, q0 = k0 & 15;
#pragma unroll
            for (int jj = 0; jj < 8; ++jj) { const int q = q0 + jj; float x = 0.f;
                if (sp <= t) x += G[((0 * 16 + (t - sp)) * 16 + p) * 16 + q];
                if (sp >= t) x += G[((1 * 16 + (sp - t)) * 16 + p) * 16 + q];
                if (sp == t && p == q) x += a.in[17][(layer * 32 + g) * 16 + p];
                v[jj] = x; }
        } else {
#pragma unroll
            for (int jj = 0; jj < 8; ++jj) { const int nn = k0 - 256 + jj, dir = nn >> 7, comp = (nn >> 6) & 1, n = nn & 63, e = dir == 0 ? t + 1 : 16 - t;
                const float cr = cs[((dir * 16 + p) * 64 + n) * 2], ci = cs[((dir * 16 + p) * 64 + n) * 2 + 1];
                const float ar = pw[((dir * 17 + e) * 64 + n) * 2], ai = pw[((dir * 17 + e) * 64 + n) * 2 + 1];
                v[jj] = comp == 0 ? (cr * ar - ci * ai) : -(cr * ai + ci * ar); }
        }
        v4u o; o.x = pk2(v[0], v[1]); o.y = pk2(v[2], v[3]); o.z = pk2(v[4], v[5]); o.w = pk2(v[6], v[7]);
        *(v4u*)(Mt + (size_t)row * 512 + k0) = o; }
    bf16* Pf = (bf16*)(a.ws + WS_PFPR) + (size_t)(layer * 32 + g) * 256 * 256;
    for (int i = tid; i < 8192; i += 512) { const int nn = i >> 5, k0 = (i & 31) * 8, sp = k0 >> 4, q0 = k0 & 15, dir = nn >> 7, comp = (nn >> 6) & 1, n = nn & 63, e = dir == 0 ? 15 - sp : sp;
        const float ar = pw[((dir * 17 + e) * 64 + n) * 2], ai = pw[((dir * 17 + e) * 64 + n) * 2 + 1]; float v[8];
#pragma unroll
        for (int jj = 0; jj < 8; ++jj) { const float br = bbs[((dir * 64 + n) * 16 + q0 + jj) * 2], bi = bbs[((dir * 64 + n) * 16 + q0 + jj) * 2 + 1];
            v[jj] = comp == 0 ? (ar * br - ai * bi) : (ar * bi + ai * br); }
        v4u o; o.x = pk2(v[0], v[1]); o.y = pk2(v[2], v[3]); o.z = pk2(v[4], v[5]); o.w = pk2(v[6], v[7]);
        *(v4u*)(Pf + (size_t)nn * 256 + k0) = o; }
    if (tid < 128) { const int dir = tid >> 6, n = tid & 63; float* A16 = (float*)(a.ws + WS_A16);
        A16[(((layer * 32 + g) * 2 + dir) * 64 + n) * 2] = pw[((dir * 17 + 16) * 64 + n) * 2]; A16[(((layer * 32 + g) * 2 + dir) * 64 + n) * 2 + 1] = pw[((dir * 17 + 16) * 64 + n) * 2 + 1]; }
    __syncthreads();
}

__device__ __forceinline__ void gemv_item(const float* W, int N, int n0, const LAS float* sv, LAS float* red, float* out, int ostride, const float* badd, int tid) {
    typedef float f32x2 __attribute__((ext_vector_type(2)));
    const int lane = tid & 63, wave = tid >> 6; const float* Wp = W + (size_t)(wave * 128) * N + n0 + 2 * lane;
    float acc[5][2];
#pragma unroll
    for (int v = 0; v < 5; ++v) { acc[v][0] = 0.f; acc[v][1] = 0.f; }
    for (int k0 = 0; k0 < 128; k0 += 16) {
        f32x2 w[16];
#pragma unroll
        for (int j = 0; j < 16; ++j) w[j] = *(const f32x2*)(Wp + (size_t)(k0 + j) * N);
#pragma unroll
        for (int j = 0; j < 16; ++j)
#pragma unroll
            for (int v = 0; v < 5; ++v) { const float sx = sv[v * 1024 + wave * 128 + k0 + j]; acc[v][0] += sx * w[j].x; acc[v][1] += sx * w[j].y; }
    }
#pragma unroll
    for (int v = 0; v < 5; ++v) { red[(wave * 5 + v) * 128 + 2 * lane] = acc[v][0]; red[(wave * 5 + v) * 128 + 2 * lane + 1] = acc[v][1]; }
    __syncthreads();
    for (int i = tid; i < 5 * 128; i += 512) { const int v = i >> 7, c = i & 127; float sum = badd ? badd[n0 + c] : 0.f;
#pragma unroll
        for (int w8 = 0; w8 < 8; ++w8) sum += red[(w8 * 5 + v) * 128 + c];
        out[(size_t)v * ostride + n0 + c] = sum; }
    __syncthreads();
}
__device__ __forceinline__ void p0_phase(const Args& a, LAS unsigned char* lds, int tid) {
    LAS float* sv = (LAS float*)lds;
    LAS float* red = sv + 5 * 1024;
    for (int i = tid; i < 5 * 1024; i += 512) { const int v = i >> 10, k = i & 1023; const float x = v < 4 ? a.in[1][v * 1024 + k] : a.in[3][k]; sv[i] = silu_f(x); }
    __syncthreads();
    float* mod = (float*)(a.ws + WS_MOD);
    const int G0 = ogrid(), half0 = G0 >= 256 ? 128 : 0;
    if (obid() < half0 || half0 == 0) { for (int it = obid(); it < DEPTH * 32; it += (half0 ? half0 : G0)) ssm_tables(a, lds + 49152, it >> 5, it & 31, tid); }
    for (int it = (half0 ? obid() - half0 : obid()); it >= 0 && it < DEPTH * 48; it += (half0 ? G0 - half0 : G0)) {
        const int l = it / 48, n0 = (it % 48) * 128;
        gemv_item(a.in[4] + (size_t)l * 1024 * 6144, 6144, n0, sv, red, mod + (size_t)l * 5 * 6144, 6144, a.in[5] + l * 6144, tid);
    }
    if (obid() == ogrid() - 1) {
        float* rt = (float*)(a.ws + WS_ROPE);
        for (int i = tid; i < 1024; i += 512) { const int p = i >> 4, f = i & 15; const float fr = powf(10000.0f, -(float)f / 16.0f); const float ang = (float)p * fr;
            rt[i] = cosf(ang); rt[1024 + i] = sinf(ang); }
    }
}

__device__ __forceinline__ void p1_phase(const Args& a, LAS unsigned char* lds, int tid) {
    LAS float* sv = (LAS float*)lds;
    LAS float* red = sv + 5 * 1024;
    const float* mod = (const float*)(a.ws + WS_MOD); float* cs = (float*)(a.ws + WS_CS);
    for (int i = obid() * 512 + tid; i < DEPTH * 2 * 5 * 1024; i += ogrid() * 512) { const int k = i & 1023, v = (i >> 10) % 5, which = (i / 5120) & 1, l = i / 10240;
        const float g = which == 0 ? a.in[6][l * 1024 + k] : a.in[22][l * 1024 + k]; cs[i] = g * (1.0f + mod[((size_t)l * 5 + v) * 6144 + (which == 0 ? 1024 : 4096) + k]); }
    for (int it = obid(); it < DEPTH * 54; it += ogrid()) {
        const int l = it / 54, r = it % 54; const bool up = r >= 10; const int n0 = (up ? r - 10 : r) * 128, N = up ? 5632 : 1280;
        for (int i = tid; i < 5 * 1024; i += 512) sv[i] = mod[((size_t)l * 5 + (i >> 10)) * 6144 + (up ? 3072 : 0) + (i & 1023)];
        __syncthreads();
        float* bo = up ? (float*)(a.ws + WS_BIASUP) + (size_t)l * 5 * 5632 : (float*)(a.ws + WS_BIASIN) + (size_t)l * 5 * 1280;
        gemv_item(up ? a.in[23] + (size_t)l * 1024 * 5632 : a.in[7] + (size_t)l * 1024 * 1280, N, n0, sv, red, bo, N, nullptr, tid);
    }
}

__device__ __forceinline__ void prep_row(const float* src, float* dstcopy, bf16* xt, const float* gnorm, const float* scl, float* ssq, int lane) {
    const f32x4* xr = (const f32x4*)src + lane; f32x4 v[4]; float s = 0.f;
#pragma unroll
    for (int j = 0; j < 4; ++j) { v[j] = xr[64 * j]; s += (v[j].x * v[j].x + v[j].y * v[j].y) + (v[j].z * v[j].z + v[j].w * v[j].w); }
#pragma unroll
    for (int j = 0; j < 4; ++j) ((f32x4*)dstcopy + lane)[64 * j] = v[j];
    s = wave_sum(s);
    if (lane < 16) ssq[lane] = lane == 0 ? s : 0.f;
    unsigned long long* o8 = (unsigned long long*)xt + lane;
#pragma unroll
    for (int j = 0; j < 4; ++j) { const f32x4 y = v[j] * (((const f32x4*)gnorm + lane)[64 * j] * (((const f32x4*)scl + lane)[64 * j] + 1.0f)); o8[64 * j] = (unsigned long long)pk2(y.x, y.y) | ((unsigned long long)pk2(y.z, y.w) << 32); }
}
__device__ __forceinline__ void transposes_range(const Args& a, LAS unsigned char* lds, int layer, int lo, int hi, int gw, int NGW, int lane, int wave) {
    LAS float* scr = (LAS float*)(lds + wave * 16384);
    constexpr int I_IN = 16 * 40, I_GLU = 8 * 16, I_OUT = 16 * 32, I_UP = 16 * 176;
    for (int it = lo + gw; it < hi; it += NGW) {
        int r = it;
        if (r < I_IN) { transpose_item(a.in[7] + (size_t)layer * 1024 * 1280, 1024, 1280, (bf16*)(a.ws + WS_WIN), scr, r, lane, 2); continue; } r -= I_IN;
        if (r < I_GLU) { transpose_item(a.in[18] + (size_t)layer * 512 * 512, 512, 512, (bf16*)(a.ws + WS_WGLU), scr, r, lane); continue; } r -= I_GLU;
        if (r < I_OUT) { transpose_item(a.in[21] + (size_t)layer * 1024 * 1024, 1024, 1024, (bf16*)(a.ws + WS_WOUT), scr, r, lane); continue; } r -= I_OUT;
        if (r < I_UP) { transpose_item(a.in[23] + (size_t)layer * 1024 * 5632, 1024, 5632, (bf16*)(a.ws + WS_WUP), scr, r, lane, 1); continue; } r -= I_UP;
        transpose_item(a.in[26] + (size_t)layer * 2816 * 1024, 2816, 1024, (bf16*)(a.ws + WS_WDN), scr, r, lane);
    }
}
__device__ __forceinline__ void combine_row(const Args& a, int layer, int r, int lane) {
    float* xc = (float*)(a.ws + WS_XC); bf16* xn = (bf16*)(a.ws + WS_XN) + (size_t)NLAT * DMOD; float* ssq = (float*)(a.ws + WS_SSQ1) + (size_t)NLAT * 16;
    const float* csv = (const float*)(a.ws + WS_CS) + ((size_t)(layer * 2) * 5 + 4) * 1024; const float* gate = (const float*)(a.ws + WS_MOD) + ((size_t)(layer - 1) * 5 + 4) * 6144 + 5120;
    const float* P = (const float*)(a.ws + WS_PART);
    float s = 0.f;
#pragma unroll
    for (int j = 0; j < 4; ++j) { const int col = 4 * lane + 256 * j; f32x4 p = *(const f32x4*)(P + (size_t)r * 1024 + col);
#pragma unroll
        for (int ks = 1; ks < 11; ++ks) p = p + *(const f32x4*)(P + ((size_t)ks * 1024 + r) * 1024 + col);
        f32x4 x = *(const f32x4*)(xc + (size_t)r * 1024 + col) + *(const f32x4*)(gate + col) * p; *(f32x4*)(xc + (size_t)r * 1024 + col) = x;
        s += (x.x * x.x + x.y * x.y) + (x.z * x.z + x.w * x.w); const f32x4 y = x * *(const f32x4*)(csv + col);
        *(unsigned long long*)(xn + (size_t)r * 1024 + col) = (unsigned long long)pk2(y.x, y.y) | ((unsigned long long)pk2(y.z, y.w) << 32); }
    s = wave_sum(s);
    if (lane < 16) ssq[(size_t)r * 16 + lane] = lane == 0 ? s : 0.f;
}
__device__ __forceinline__ void prep_phase(const Args& a, LAS unsigned char* lds, int layer, int tid, int lane, int wave) {
    const int gw = obid() * 8 + wave, NGW = ogrid() * 8;
    transposes_range(a, lds, layer, 0, 5504, gw, NGW, lane, wave);
    float* xc = (float*)(a.ws + WS_XC); bf16* xn = (bf16*)(a.ws + WS_XN); float* ssq = (float*)(a.ws + WS_SSQ1);
    for (int row = gw; row < NTOK; row += NGW) {
        const float* src = row < NLAT ? a.in[0] + (size_t)row * DMOD : a.in[2] + (size_t)(row - NLAT) * DMOD;
        prep_row(src, xrow(a.out, xc, row), xn + (size_t)row * DMOD, a.in[6], (const float*)(a.ws + WS_MOD) + (size_t)modv(row) * 6144 + 1024, ssq + (size_t)row * 16, lane);
    }
}

__device__ __forceinline__ int tokrow(int b, int c) { return c < 16 ? NLAT + b * 256 + 16 * c : b * 4096 + 16 * (c - 16); }
__device__ __forceinline__ void ssm_unit(const Args& a, LAS unsigned char* lds3, int layer, int b, int g) {
    const int tid = otid(), lane = tid & 63, wave = __builtin_amdgcn_readfirstlane(tid >> 6);
    const bf16* proj = (const bf16*)(a.ws + WS_PROJ) + 16 * g;
    const bf16* Pf = (const bf16*)(a.ws + WS_PFPR) + (size_t)(layer * 32 + g) * 256 * 256;
    const bf16* Mt = (const bf16*)(a.ws + WS_MTOT) + (size_t)(layer * 32 + g) * 256 * 512;
    const int unit = b * 32 + g;
    float* Sscr = (float*)(a.ws + WS_SSCR) + (size_t)unit * 272 * 256;
    bf16* Hin = (bf16*)(a.ws + WS_HIN) + (size_t)unit * 272 * 256;
    bf16* Z = (bf16*)(a.ws + WS_Z);
    const int i = lane & 15, kb = lane >> 4, sp_lo = kb >> 1, q0 = 8 * (kb & 1);
    const int lr = tid >> 5, lp = tid & 31;
    LAS unsigned char* ubuf = lds3;
    LAS unsigned char* hbuf = lds3 + 2 * 8448;
    {
        bf16x8 pf[2][8];
#pragma unroll
        for (int j = 0; j < 2; ++j)
#pragma unroll
            for (int ks = 0; ks < 8; ++ks) pf[j][ks] = *(const bf16x8*)(Pf + (size_t)(32 * wave + 16 * j + i) * 256 + 32 * ks + 8 * kb);
        v4u nx = *(const v4u*)(proj + ((size_t)tokrow(b, lr) + (lp >> 1)) * 512 + 8 * (lp & 1));
        for (int mt = 0; mt < 17; ++mt) {
            LAS unsigned char* ub = ubuf + (mt & 1) * 8448;
            *(LAS v4u*)(ub + lr * 528 + lp * 16) = nx;
            { const int mtn = mt < 16 ? mt + 1 : 16; nx = *(const v4u*)(proj + ((size_t)tokrow(b, 16 * mtn + lr) + (lp >> 1)) * 512 + 8 * (lp & 1)); }
            __syncthreads();
            pg8::f32x4 acc0 = {0.f, 0.f, 0.f, 0.f}, acc1 = {0.f, 0.f, 0.f, 0.f};
#pragma unroll
            for (int ks = 0; ks < 8; ++ks) { const bf16x8 af = *(const LAS bf16x8*)(ub + i * 528 + (32 * ks + 8 * kb) * 2);
                acc0 = __builtin_amdgcn_mfma_f32_16x16x32_bf16(af, pf[0][ks], acc0, 0, 0, 0); acc1 = __builtin_amdgcn_mfma_f32_16x16x32_bf16(af, pf[1][ks], acc1, 0, 0, 0); }
#pragma unroll
            for (int r = 0; r < 4; ++r) { float* sp = Sscr + (size_t)(16 * mt + 4 * kb + r) * 256 + 32 * wave + i; sp[0] = acc0[r]; sp[16] = acc1[r]; }
        }
    }
    __syncthreads();
    if (wave < 2) {
        const int dir = wave, n = lane; const float* A16 = (const float*)(a.ws + WS_A16) + (((layer * 32 + g) * 2 + dir) * 64 + n) * 2;
        const float ar = A16[0], ai = A16[1]; float hr = 0.f, hi = 0.f;
        const float* sb = Sscr + dir * 128 + n; bf16* hb = Hin + dir * 128 + n;
        float sr[16], si[16], tr[16], ti[16];
#pragma unroll
        for (int j = 0; j < 16; ++j) { const int c = dir == 0 ? j : 15 - j; sr[j] = sb[(size_t)c * 256]; si[j] = sb[(size_t)c * 256 + 64]; }
        for (int s0 = 0; s0 < 272; s0 += 16) {
            const int s1 = s0 + 16 < 272 ? s0 + 16 : s0;
#pragma unroll
            for (int j = 0; j < 16; ++j) { const int st = s1 + j; const int c = dir == 0 ? st : (st < 16 ? 15 - st : 287 - st); tr[j] = sb[(size_t)c * 256]; ti[j] = sb[(size_t)c * 256 + 64]; }
#pragma unroll
            for (int j = 0; j < 16; ++j) { const int st = s0 + j; const int c = dir == 0 ? st : (st < 16 ? 15 - st : 287 - st);
                hb[(size_t)c * 256] = (bf16)(pk2(hr, 0.f) & 0xffffu); hb[(size_t)c * 256 + 64] = (bf16)(pk2(hi, 0.f) & 0xffffu);
                const float nr = ar * hr - ai * hi + sr[j], ni = ar * hi + ai * hr + si[j]; hr = nr; hi = ni; }
#pragma unroll
            for (int j = 0; j < 16; ++j) { sr[j] = tr[j]; si[j] = ti[j]; }
        }
    }
    __syncthreads();
    {
        bf16x8 mf[2][16];
#pragma unroll
        for (int j = 0; j < 2; ++j)
#pragma unroll
            for (int ks = 0; ks < 16; ++ks) mf[j][ks] = *(const bf16x8*)(Mt + (size_t)(32 * wave + 16 * j + i) * 512 + 32 * ks + 8 * kb);
        v4u nx = *(const v4u*)(proj + ((size_t)tokrow(b, lr) + (lp >> 1)) * 512 + 8 * (lp & 1));
        v4u nh = *(const v4u*)(Hin + (size_t)lr * 256 + 8 * lp);
        for (int mt = 0; mt < 17; ++mt) {
            LAS unsigned char* ub = ubuf + (mt & 1) * 8448; LAS unsigned char* hb2 = hbuf + (mt & 1) * 8448;
            *(LAS v4u*)(ub + lr * 528 + lp * 16) = nx; *(LAS v4u*)(hb2 + lr * 528 + lp * 16) = nh;
            { const int mtn = mt < 16 ? mt + 1 : 16; nx = *(const v4u*)(proj + ((size_t)tokrow(b, 16 * mtn + lr) + (lp >> 1)) * 512 + 8 * (lp & 1));
              nh = *(const v4u*)(Hin + (size_t)(16 * mtn + lr) * 256 + 8 * lp); }
            __syncthreads();
            const size_t rb = (size_t)tokrow(b, 16 * mt + i);
            pg8::f32x4 acc0 = {0.f, 0.f, 0.f, 0.f}, acc1 = {0.f, 0.f, 0.f, 0.f};
#pragma unroll
            for (int ks = 0; ks < 16; ++ks) { const bf16x8 af = ks < 8 ? *(const LAS bf16x8*)(ub + i * 528 + (32 * ks + 8 * kb) * 2) : *(const LAS bf16x8*)(hb2 + i * 528 + (32 * (ks - 8) + 8 * kb) * 2);
                acc0 = __builtin_amdgcn_mfma_f32_16x16x32_bf16(mf[0][ks], af, acc0, 0, 0, 0); acc1 = __builtin_amdgcn_mfma_f32_16x16x32_bf16(mf[1][ks], af, acc1, 0, 0, 0); }
            bf16* zp = Z + (rb + 2 * wave) * 512 + 16 * g + 4 * kb;
            { v2u o; o.x = pk2(gelu_tanh(acc0[0]), gelu_tanh(acc0[1])); o.y = pk2(gelu_tanh(acc0[2]), gelu_tanh(acc0[3])); *(v2u*)zp = o; }
            { v2u o; o.x = pk2(gelu_tanh(acc1[0]), gelu_tanh(acc1[1])); o.y = pk2(gelu_tanh(acc1[2]), gelu_tanh(acc1[3])); *(v2u*)(zp + 512) = o; }
        }
    }
    __syncthreads();
}

__device__ __forceinline__ void merge_rows(const Args& a, int layer, int lane, int gw, int NGW, int row_lo, int nrows) {
    const bf16* qo = (const bf16*)(a.ws + WS_O); const bf16* so = (const bf16*)(a.ws + WS_SSMO); bf16* xn = (bf16*)(a.ws + WS_XN);
    const float* gn = a.in[20] + layer * 1024;
    for (int row = row_lo + gw; row < nrows; row += NGW) {
#pragma unroll
        for (int h = 0; h < 2; ++h) {
            const v4u w = *(const v4u*)((h == 0 ? qo : so) + (size_t)row * 512 + 8 * lane);
            float v[8] = {bflo(w.x), bfhi(w.x), bflo(w.y), bfhi(w.y), bflo(w.z), bfhi(w.z), bflo(w.w), bfhi(w.w)};
            float s = 0.f;
#pragma unroll
            for (int k = 0; k < 8; ++k) s += v[k] * v[k];
            const float rstd = __builtin_amdgcn_rsqf(wave_sum(s) * (1.f / 512.f) + 1e-6f);
            const float* gp = gn + h * 512 + 8 * lane;
            v4u o; o.x = pk2(v[0] * rstd * gp[0], v[1] * rstd * gp[1]); o.y = pk2(v[2] * rstd * gp[2], v[3] * rstd * gp[3]);
            o.z = pk2(v[4] * rstd * gp[4], v[5] * rstd * gp[5]); o.w = pk2(v[6] * rstd * gp[6], v[7] * rstd * gp[7]);
            *(v4u*)(xn + (size_t)row * 1024 + h * 512 + 8 * lane) = o;
        }
    }
}

__device__ __forceinline__ void fix_phase(const Args& a, int layer, int tid) {
    bf16* hf = (bf16*)(a.ws + WS_HFFN); const float* side = (const float*)(a.ws + WS_SIDE);
    const float* cw = a.in[24] + (size_t)layer * 3 * DFF2;
    for (int it = obid() * 512 + tid; it < 60 * 2 * 704; it += ogrid() * 512) {
        const int c = (it % 704) * 4, r = it / 704, kind = r & 1, bi = r >> 1, pm = (bi / 15) * 16 + (bi % 15) + 1;
        pg8::f32x4 oa, og; size_t row;
        if (kind == 0) { const float* pf = side + ((size_t)pm * 4 + 1) * 5632; const float* rl = side + ((size_t)(pm - 1) * 4 + 2) * 5632; row = (size_t)pm * 256;
            oa = *(const pg8::f32x4*)(pf + c) + *(const pg8::f32x4*)(cw + c) * *(const pg8::f32x4*)(rl + c);
            og = *(const pg8::f32x4*)(pf + 2816 + c) + *(const pg8::f32x4*)(cw + 2816 + c) * *(const pg8::f32x4*)(rl + 2816 + c); }
        else { const float* pl = side + ((size_t)(pm - 1) * 4 + 3) * 5632; const float* rf = side + ((size_t)pm * 4 + 0) * 5632; row = (size_t)pm * 256 - 1;
            oa = *(const pg8::f32x4*)(pl + c) + *(const pg8::f32x4*)(cw + 2 * 5632 + c) * *(const pg8::f32x4*)(rf + c);
            og = *(const pg8::f32x4*)(pl + 2816 + c) + *(const pg8::f32x4*)(cw + 2 * 5632 + 2816 + c) * *(const pg8::f32x4*)(rf + 2816 + c); }
        v2u o; o.x = pk2(silu_f(og[0]) * oa[0], silu_f(og[1]) * oa[1]); o.y = pk2(silu_f(og[2]) * oa[2], silu_f(og[3]) * oa[3]);
        *(v2u*)(hf + row * DFF + c) = o;
    }
}

__device__ __forceinline__ void fix_tile(const Args& a, int layer, int pm, int tid) {
    bf16* hf = (bf16*)(a.ws + WS_HFFN); const float* side = (const float*)(a.ws + WS_SIDE);
    const float* cw = a.in[24] + (size_t)layer * 3 * DFF2;
    for (int it = tid; it < 2 * 704; it += 512) {
        const int c = (it % 704) * 4, kind = it / 704;
        if (kind == 0 ? (pm & 15) == 0 : (pm & 15) == 15) continue;
        pg8::f32x4 oa, og; size_t row;
        if (kind == 0) { const float* pf = side + ((size_t)pm * 4 + 1) * 5632; const float* rl = side + ((size_t)(pm - 1) * 4 + 2) * 5632; row = (size_t)pm * 256;
            oa = *(const pg8::f32x4*)(pf + c) + *(const pg8::f32x4*)(cw + c) * *(const pg8::f32x4*)(rl + c);
            og = *(const pg8::f32x4*)(pf + 2816 + c) + *(const pg8::f32x4*)(cw + 2816 + c) * *(const pg8::f32x4*)(rl + 2816 + c); }
        else { const float* pl = side + ((size_t)pm * 4 + 3) * 5632; const float* rf = side + ((size_t)(pm + 1) * 4 + 0) * 5632; row = (size_t)pm * 256 + 255;
            oa = *(const pg8::f32x4*)(pl + c) + *(const pg8::f32x4*)(cw + 2 * 5632 + c) * *(const pg8::f32x4*)(rf + c);
            og = *(const pg8::f32x4*)(pl + 2816 + c) + *(const pg8::f32x4*)(cw + 2 * 5632 + 2816 + c) * *(const pg8::f32x4*)(rf + 2816 + c); }
        v2u o; o.x = pk2(silu_f(og[0]) * oa[0], silu_f(og[1]) * oa[1]); o.y = pk2(silu_f(og[2]) * oa[2], silu_f(og[3]) * oa[3]);
        *(v2u*)(hf + row * DFF + c) = o;
    }
    asm volatile("s_waitcnt vmcnt(0)" ::: "memory"); __syncthreads();
}

#define RLX_AGENT __ATOMIC_RELAXED, __HIP_MEMORY_SCOPE_AGENT
#define XB_TMO      128
#define XB_XCNT(j)  (256  + 64 * (j))
#define XB_XSUB(j)  (1280 + 64 * (j))
#define XB_XGEN(j)  (2304 + 64 * (j))
#define XB_TOP      3328
#define XB_TOPGEN   3392
#define XCD_BAR_WORDS 3456
#define XB_SPIN_CAP (1u << 18)

__device__ __forceinline__ unsigned xb_ld(unsigned* p)              { return __hip_atomic_load(p, __ATOMIC_RELAXED, __HIP_MEMORY_SCOPE_AGENT); }
__device__ __forceinline__ unsigned xb_add(unsigned* p, unsigned v) { return __hip_atomic_fetch_add(p, v, __ATOMIC_RELAXED, __HIP_MEMORY_SCOPE_AGENT); }
__device__ __forceinline__ unsigned xb_xcc_id() { return (unsigned)__builtin_amdgcn_s_getreg((3 << 11) | 20) & 0xFu; }
#define XB_SPIN(cond, bar) do { unsigned _sp = 0; while (cond) { __builtin_amdgcn_s_sleep(1); \
    if ((++_sp & 255u) == 0u) { if (xb_ld(&(bar)[XB_TMO])) break; if (_sp > XB_SPIN_CAP) { atomicAdd(&(bar)[XB_TMO], 1u); break; } } } } while (0)

struct XcdBarrier {
    unsigned* bar; unsigned x;
    volatile LAS unsigned* st;
};

__device__ __forceinline__ XcdBarrier xcd_barrier_post(unsigned* bar, volatile LAS unsigned* st) {
    XcdBarrier b; b.bar = bar; b.x = xb_xcc_id(); b.st = st;
    if (otid() == 0) (void)xb_add(&bar[XB_XCNT(b.x)], 1u);
    return b;
}
__device__ __forceinline__ void xcd_barrier_complete(unsigned* bar, unsigned x, unsigned& nloc, unsigned& nx) {
    const unsigned G = (unsigned)ogrid();
    unsigned sum, cnt, mine, sp = 0u;
    for (;;) {
        sum = 0u; cnt = 0u; mine = 0u;
#pragma unroll
        for (unsigned j = 0; j < 16; ++j) { const unsigned c = xb_ld(&bar[XB_XCNT(j)]); sum += c; cnt += (c > 0u) ? 1u : 0u; mine = (j == x) ? c : mine; }
        if (sum == G) break;
        __builtin_amdgcn_s_sleep(1);
        if ((++sp & 255u) == 0u) { if (xb_ld(&bar[XB_TMO])) break; if (sp > XB_SPIN_CAP) { atomicAdd(&bar[XB_TMO], 1u); break; } }
    }
    nloc = mine > 0u ? mine : 1u; nx = cnt > 0u ? cnt : 1u;
}

__device__ __forceinline__ void xcd_barrier(const XcdBarrier& b) {
    asm volatile("s_waitcnt vmcnt(0)" ::: "memory");
    __syncthreads();
    if (otid() == 0) {
        unsigned* bar = b.bar;
        __builtin_amdgcn_s_waitcnt(0);
        unsigned nloc = b.st[0], nx = b.st[1];
        if (nloc == 0u) { xcd_barrier_complete(bar, b.x, nloc, nx); b.st[0] = nloc; b.st[1] = nx; }
        const unsigned old = xb_add(&bar[XB_XSUB(b.x)], 1u);
        const unsigned gen = old / nloc;
        if (old + 1u == (gen + 1u) * nloc) {
            __builtin_amdgcn_fence(__ATOMIC_RELEASE, "agent");
            asm volatile("s_waitcnt vmcnt(0)" ::: "memory");
            const unsigned og = xb_add(&bar[XB_TOP], 1u);
            const unsigned tg = og / nx;
            if (og + 1u == (tg + 1u) * nx) xb_add(&bar[XB_TOPGEN], 1u);
            else XB_SPIN(xb_ld(&bar[XB_TOPGEN]) == tg, bar);
            __builtin_amdgcn_fence(__ATOMIC_ACQUIRE, "agent");
            xb_add(&bar[XB_XGEN(b.x)], 1u);
            asm volatile("s_waitcnt vmcnt(0)" ::: "memory");
        } else {
            XB_SPIN(xb_ld(&bar[XB_XGEN(b.x)]) == gen, bar);
            __builtin_amdgcn_fence(__ATOMIC_ACQUIRE, "agent");
            asm volatile("s_waitcnt vmcnt(0)" ::: "memory");
        }
    }
    __syncthreads();
}

__device__ __forceinline__ void merge_rows8(const Args& a, int layer, int lane, int row0) {
    const bf16* qo = (const bf16*)(a.ws + WS_O); const bf16* so = (const bf16*)(a.ws + WS_SSMO); bf16* xn = (bf16*)(a.ws + WS_XN);
    const float* gn = a.in[20] + layer * 1024;
    v4u w[8][2];
#pragma unroll
    for (int r = 0; r < 8; ++r) { w[r][0] = *(const v4u*)(qo + (size_t)(row0 + r) * 512 + 8 * lane); w[r][1] = *(const v4u*)(so + (size_t)(row0 + r) * 512 + 8 * lane); }
    float g[2][8];
#pragma unroll
    for (int h = 0; h < 2; ++h)
#pragma unroll
        for (int k = 0; k < 8; ++k) g[h][k] = gn[h * 512 + 8 * lane + k];
#pragma unroll
    for (int r = 0; r < 8; ++r)
#pragma unroll
        for (int h = 0; h < 2; ++h) { const v4u ww = w[r][h];
            const float v[8] = {bflo(ww.x), bfhi(ww.x), bflo(ww.y), bfhi(ww.y), bflo(ww.z), bfhi(ww.z), bflo(ww.w), bfhi(ww.w)};
            float s = 0.f;
#pragma unroll
            for (int k = 0; k < 8; ++k) s += v[k] * v[k];
            const float rstd = __builtin_amdgcn_rsqf(wave_sum(s) * (1.f / 512.f) + 1e-6f);
            v4u o; o.x = pk2(v[0] * rstd * g[h][0], v[1] * rstd * g[h][1]); o.y = pk2(v[2] * rstd * g[h][2], v[3] * rstd * g[h][3]);
            o.z = pk2(v[4] * rstd * g[h][4], v[5] * rstd * g[h][5]); o.w = pk2(v[6] * rstd * g[h][6], v[7] * rstd * g[h][7]);
            *(v4u*)(xn + (size_t)(row0 + r) * 1024 + h * 512 + 8 * lane) = o; }
}
__device__ __forceinline__ void publish(unsigned* word) {
    asm volatile("s_waitcnt vmcnt(0)" ::: "memory"); __syncthreads();
    if (otid() == 0) { __builtin_amdgcn_fence(__ATOMIC_RELEASE, "agent"); asm volatile("s_waitcnt vmcnt(0)" ::: "memory"); __hip_atomic_fetch_add(word, 1u, __ATOMIC_RELAXED, __HIP_MEMORY_SCOPE_AGENT); }
}
__device__ __forceinline__ void publish_wt(unsigned* word) {
    asm volatile("s_waitcnt vmcnt(0)" ::: "memory"); __syncthreads();
    if (otid() == 0) __hip_atomic_fetch_add(word, 1u, __ATOMIC_RELAXED, __HIP_MEMORY_SCOPE_AGENT);
}
__device__ __forceinline__ void await(unsigned* word, unsigned target) {
    if (otid() == 0) { unsigned sp = 0; while (__hip_atomic_load(word, __ATOMIC_RELAXED, __HIP_MEMORY_SCOPE_AGENT) < target) { __builtin_amdgcn_s_sleep(80); if (++sp > (1u << 22)) break; }
        __builtin_amdgcn_fence(__ATOMIC_ACQUIRE, "agent"); asm volatile("s_waitcnt vmcnt(0)" ::: "memory"); }
    __syncthreads();
}
__device__ __forceinline__ void mix_phase(const Args& a, unsigned char* lds, int layer, bool ctx_out, int tid, int lane, int wave) {
    unsigned* ctr = (unsigned*)(a.ws + WS_CTL) + 8192 + (size_t)layer * 512;
    volatile LAS unsigned* qs = (volatile LAS unsigned*)((LAS unsigned char*)lds + QS_OFF);
    const int L3 = layer & 3, nmt = ctx_out ? 68 : 64; const int NCMB = L3 > 0 ? 64 : 0, NDN = L3 > 0 ? 528 : 0; const int NIN = 340;
    const int nattn = 640 + (ctx_out ? 32 : 0), i_glu = nattn, i_mrg = i_glu + 2 * nmt, nitems = i_mrg + 8 * nmt;
    const attn_body::bf16* qo = (const attn_body::bf16*)(a.ws + WS_QO); const attn_body::bf16* kall = (const attn_body::bf16*)(a.ws + WS_KALL); const attn_body::bf16* vall = (const attn_body::bf16*)(a.ws + WS_VALL);
    for (;;) {
        __syncthreads();
        if (otid() == 0) qs[0] = atomicAdd(ctr, 1u);
        __syncthreads();
        const int itq = __builtin_amdgcn_readfirstlane((int)qs[0]);
        if (itq >= NCMB + nitems + NIN + NDN) break;
        if (itq < NCMB) {
            const int t2 = otid(), w2 = __builtin_amdgcn_readfirstlane(t2 >> 6);
            for (int k = 0; k < 2; ++k) combine_row(a, L3, itq * 16 + w2 * 2 + k, t2 & 63);
            publish(ctr + 452); continue; }
        if (itq >= NCMB + nitems + NIN) {
            const int t2 = otid(), w2 = __builtin_amdgcn_readfirstlane(t2 >> 6), j = itq - (NCMB + nitems + NIN);
            transposes_range(a, (LAS unsigned char*)lds, L3, 1280 + j * 8, 1280 + j * 8 + 8, w2, 8, t2 & 63, w2); __syncthreads(); continue; }
        const int it0 = itq - NCMB;
        if (it0 < NIN) { const int b = it0 / 85, r = it0 % 85, t = r / 5, pn = r % 5, pm = t < 16 ? 16 * b + t : 64 + b;
            pg8::Gemm g{(const bf16*)(a.ws + WS_XN), (const bf16*)(a.ws + WS_WIN), NTOK, INC, 1024, 1024}; pg8::OneUnit S{pm, pn};
            pg8::EpiIn E{(bf16*)(a.ws + WS_QO), (bf16*)(a.ws + WS_KALL), (bf16*)(a.ws + WS_VALL), (bf16*)(a.ws + WS_PROJ), a.in[8] + L3 * 64, a.in[9] + L3 * 64, (const float*)(a.ws + WS_ROPE),
                          (const float*)(a.ws + WS_SSQ1), (const float*)(a.ws + WS_BIASIN) + (size_t)L3 * 5 * 1280, (LAS float*)((LAS unsigned char*)lds + 136192)};
            if (NCMB && t == 16) await(ctr + 452, 64u);
            pg8::gemm_phase<pg8::EpiIn, pg8::OneUnit, true, true>((LAS unsigned char*)lds, g, S, E); publish(ctr + 448 + b); continue; }
        const int it = it0 - NIN;
        if (it < 128) { await(ctr + 448 + (it >> 5), 85u); ssm_unit(a, (LAS unsigned char*)lds, L3, it >> 5, it & 31); publish(ctr + 64); }
        else if (it < 640) { const int r = it - 128, hq = r & 3, qb = (r >> 2) & 15, bk = r >> 6, b = bk >> 1, h = (bk & 1) * 4 + hq;
            await(ctr + 448 + b, 85u);
            attn_body::attn_unit<8>((long)b * 4096 + qb * 256, (long)b * 4352, h, 68, qo, kall, vall, (attn_body::bf16*)(a.ws + WS_O), (char*)lds); publish_wt(ctr + 128 + b * 16 + qb); }
        else if (it < nattn) { const int r = it - 640, b = r >> 3, h = r & 7;
            await(ctr + 448 + b, 85u);
            attn_body::attn_unit<8>((long)NLAT + b * 256, (long)b * 4352, h, 4, qo, kall, vall, (attn_body::bf16*)(a.ws + WS_O), (char*)lds); publish_wt(ctr + 128 + 64 + b); }
        else if (it < i_mrg) {
            const int r = it - i_glu; await(ctr + 64, 128u);
            pg8::Gemm g{(const bf16*)(a.ws + WS_Z), (const bf16*)(a.ws + WS_WGLU), NTOK, 512, 512, 512}; pg8::OneUnit S{r >> 1, r & 1};
            pg8::EpiGlu E{(const bf16*)(a.ws + WS_Z), (bf16*)(a.ws + WS_SSMO), a.in[19] + L3 * 512};
            pg8::gemm_phase<pg8::EpiGlu, pg8::OneUnit, true, true>((LAS unsigned char*)lds, g, S, E); publish(ctr + 128 + (r >> 1));
        }
        else {
            int r = it - i_mrg, pm0, npm;
            if (r < 32 * 8) { pm0 = 0; npm = 32; } else { r -= 32 * 8; pm0 = 32; npm = nmt - 32; }
            if (r < 4 * npm) { const int pm = pm0 + (r >> 2); await(ctr + 128 + pm, 10u);
                { const int t2 = otid(); merge_rows8(a, L3, t2 & 63, pm * 256 + (r & 3) * 64 + __builtin_amdgcn_readfirstlane(t2 >> 6) * 8); }
                publish(ctr + 256 + pm); }
            else { r -= 4 * npm; const int pm = pm0 + (r >> 2), pn = r & 3; await(ctr + 256 + pm, 4u);
                pg8::Gemm g{(const bf16*)(a.ws + WS_XN), (const bf16*)(a.ws + WS_WOUT), NTOK, 1024, 1024, 1024}; pg8::OneUnit S{pm, pn};
                pg8::EpiRes E{a.out, (float*)(a.ws + WS_XC), (const float*)(a.ws + WS_MOD) + (size_t)L3 * 5 * 6144 + 2048, (bf16*)(a.ws + WS_XT2), (const float*)(a.ws + WS_CS) + (size_t)(L3 * 2 + 1) * 5 * 1024, (float*)(a.ws + WS_SSQ2)};
                pg8::gemm_phase<pg8::EpiRes, pg8::OneUnit, true, true>((LAS unsigned char*)lds, g, S, E); }
        }
    }
}

typedef const __attribute__((address_space(4))) Args* KArgsP;
__device__ __forceinline__ KArgsP launder(KArgsP p) { asm volatile("" : "+s"(p)); return p; }
__global__ void __launch_bounds__(512, 2) mk_fwd(Args a_unused) {
    unsigned char* const lds = lds_dyn;
    const KArgsP ap0 = (KArgsP)__builtin_amdgcn_kernarg_segment_ptr();
    LAS unsigned char* L = (LAS unsigned char*)lds;
    const int ph_lo = launder(ap0)->ph_lo, ph_hi = launder(ap0)->ph_hi;
    { if ((threadIdx.x & 63) == 0) ((volatile LAS int*)((LAS unsigned char*)lds + WTAB_OFF))[hw_slot()] = (int)(threadIdx.x >> 6);
      __syncthreads(); }
    { volatile LAS unsigned* st = (volatile LAS unsigned*)((LAS unsigned char*)lds + QS_OFF + 64);
      if (otid() < 2) st[otid()] = 0u;
      __syncthreads();
      (void)xcd_barrier_post((unsigned*)(launder(ap0)->ws + WS_CTL) + 4096, st); }
#define XBAR() do { XcdBarrier xb_; xb_.bar = (unsigned*)(launder(ap0)->ws + WS_CTL) + 4096; xb_.x = xb_xcc_id(); xb_.st = (volatile LAS unsigned*)((LAS unsigned char*)lds + QS_OFF + 64); xcd_barrier(xb_); } while (0)
    if (ph_lo == 0) {
#if defined(__HIP_DEVICE_COMPILE__)
        const Args a = *launder(ap0);
#else
        const Args a = a_unused;
#endif
        if (PHON(13)) p0_phase(a, L, otid());
        if (ph_hi < 0) { __syncthreads(); cg::this_grid().sync(); }
        XBAR();
        if (PHON(13)) p1_phase(a, L, otid());
        { const int tid = otid(); prep_phase(a, L, 0, tid, tid & 63, __builtin_amdgcn_readfirstlane(tid >> 6)); }
        XBAR();
    }
    for (int ph = (ph_lo < 3 ? 3 : ph_lo); ph < ph_hi; ++ph) {
      const int nrep_ = 1;
      for (int rep = 0; rep < nrep_; ++rep) {
#if defined(__HIP_DEVICE_COMPILE__)
        const Args& a = *(const Args*)launder(ap0);
#else
        const Args& a = a_unused;
#endif
        const int G = ogrid(), c = obid();
        bf16* xn = (bf16*)(a.ws + WS_XN); float* xc = (float*)(a.ws + WS_XC);
        {
            const int l = (ph - 3) / NSTAGE, s = (ph - 3) % NSTAGE; const bool last = (l == DEPTH - 1); const int nrows = last ? NLAT : NTOK;
            const float* mod = (const float*)(a.ws + WS_MOD) + (size_t)l * 5 * 6144; const float* cs = (const float*)(a.ws + WS_CS);
            bf16* xt2 = (bf16*)(a.ws + WS_XT2); float* ssq1 = (float*)(a.ws + WS_SSQ1); float* ssq2 = (float*)(a.ws + WS_SSQ2);
            if (s == 0) { if (PHON(1)) { const int tid = otid(); mix_phase(a, lds, l + 4 * rep, !last, tid, tid & 63, __builtin_amdgcn_readfirstlane(tid >> 6)); } }
            else if (s == 1) { if (PHON(2)) { pg8::Gemm g{xt2, (const bf16*)(a.ws + WS_WUP), nrows, DFF2, 1024, 1024}; pg8::StaticOrder S; S.init(nrows, DFF2, G, c);
                pg8::EpiConv E{(bf16*)(a.ws + WS_HFFN), a.in[24] + (size_t)l * 3 * DFF2, a.in[25] + (size_t)l * DFF2, (float*)(a.ws + WS_SIDE), (LAS float*)(L + 131072),
                               ssq2, (const float*)(a.ws + WS_BIASUP) + (size_t)l * 5 * 5632, (LAS float*)(L + 136192)};
                pg8::gemm_phase<pg8::EpiConv, pg8::StaticOrder, true, true>(L, g, S, E);
                if (!last) { const int t2 = otid(), w2 = __builtin_amdgcn_readfirstlane(t2 >> 6); transposes_range(a, L, l + 1, 0, 1280, c * 8 + w2, G * 8, t2 & 63, w2); } } }
            else if (PHON(3)) { pg8::Gemm g{(const bf16*)(a.ws + WS_HFFN), (const bf16*)(a.ws + WS_WDN), NLAT, 1024, DFF, DFF}; pg8::StaticOrder S; S.init(NLAT, 1024, G, c);
                if (G == 256) { pg8::Unit u0; if (S.next(0, u0)) fix_tile(a, l, u0.pm, otid()); } else { fix_phase(a, l, otid()); XBAR(); }
                pg8::EpiRes E{a.out, xc, mod + 5120, last ? (bf16*)nullptr : xn, cs + (size_t)((l + 1) * 2) * 5 * 1024, ssq1}; pg8::gemm_phase<pg8::EpiRes, pg8::StaticOrder, true, true>(L, g, S, E);
                if (!last) { pg8::Gemm g2{(const bf16*)(a.ws + WS_HFFN) + (size_t)NLAT * DFF, (const bf16*)(a.ws + WS_WDN), 1024, 1024, 256, DFF}; pg8::SliceOrder S2{G, c};
                    pg8::EpiPart E2{(float*)(a.ws + WS_PART)}; pg8::gemm_phase<pg8::EpiPart, pg8::SliceOrder, true, true>(L, g2, S2, E2); } }
        }
        if (ph + 1 < ph_hi || rep + 1 < nrep_) { XBAR(); for (int q_ = 0; q_ < REP_SYNC; ++q_) XBAR(); }
      }
    }
}

#ifndef MK_MULTI
#define MK_MULTI 0
#endif
extern "C" void kernel_launch(void* const* d_in, const int* in_sizes, int n_in, void* d_out, int out_size, void* d_ws, size_t ws_size, hipStream_t stream) {
    static int grid = 0;
    if (grid == 0) {
        if (n_in != 27 || ws_size < WS_END) { fprintf(stderr, "kernel_launch: bad shapes/workspace (n_in %d ws %zu need %zu)\n", n_in, ws_size, (size_t)WS_END); grid = -1; return; }
        int dev = 0, cus = 0, per_cu = 0;
        hipGetDevice(&dev); hipDeviceGetAttribute(&cus, hipDeviceAttributeMultiprocessorCount, dev);
        if (hipFuncSetAttribute((const void*)mk_fwd, hipFuncAttributeMaxDynamicSharedMemorySize, LDS_BYTES) != hipSuccess) { fprintf(stderr, "kernel_launch: hipFuncSetAttribute failed\n"); grid = -1; return; }
        if (hipOccupancyMaxActiveBlocksPerMultiprocessor(&per_cu, (const void*)mk_fwd, 512, LDS_BYTES) != hipSuccess || per_cu < 1) { fprintf(stderr, "kernel_launch: occupancy query says %d\n", per_cu); per_cu = 1; }
        (void)hipGetLastError();
        grid = cus * (per_cu > 1 ? 1 : per_cu);
        if (grid < 1) grid = 256;
    }
    if (grid < 0) return;
    (void)hipMemsetAsync((char*)d_ws + WS_CTL, 0, 65536, stream);
    Args a{};
    for (int i = 0; i < 27; ++i) a.in[i] = (const float*)d_in[i];
    a.out = (float*)d_out; a.ws = (unsigned char*)d_ws;
#if MK_MULTI
    for (int ph = 0; ph < NPHASE; ++ph) { a.ph_lo = ph; a.ph_hi = ph + 1; a.coop = 0; hipLaunchKernelGGL(mk_fwd, dim3(grid), dim3(512), LDS_BYTES, stream, a); }
#else
    a.ph_lo = 0; a.ph_hi = NPHASE; a.coop = 1;
    void* args[] = {&a};
    hipError_t e = hipLaunchCooperativeKernel((const void*)mk_fwd, dim3(grid), dim3(512), args, LDS_BYTES, stream);
    if (e != hipSuccess) fprintf(stderr, "cooperative launch failed: %s (grid %d)\n", hipGetErrorString(e), grid);
#endif
}
```
